# Optimizing an MI355X kernel written in HIP

```python
import math
import jax, jax.numpy as jnp
from jax import lax
import numpy as np

D_MODEL = 1024
BATCH = 8
SEQ = 2048
DEPTH = 2

CHUNK = 64
N_MIXERS = 2
N_RGLRU_LAYERS = (DEPTH + 1) // 2
N_RWKV_LAYERS = DEPTH // 2

RG_WIDTH = ((4 * D_MODEL // 3 + 127) // 128) * 128
RG_HEADS = 16
RG_BLOCK = RG_WIDTH // RG_HEADS
RG_CONV = 4
RG_C = 8.0

RWKV_HEAD = 64
RWKV_HEADS = D_MODEL // RWKV_HEAD
RWKV_DECAY_LORA = 64
RWKV_AAA_LORA = 64
RWKV_GATE_LORA = 128
RWKV_GN_EPS = 64e-5
RWKV_L2_EPS = 1e-12

PEER_HEADS = 8
PEER_NKEYS = 128
PEER_EXPERTS = PEER_NKEYS * PEER_NKEYS
PEER_DKEY = 256
PEER_DHALF = PEER_DKEY // 2
PEER_TOPK = 16
PEER_BLOCK = 128

DEEPNORM_ALPHA = (2 * DEPTH) ** 0.25
DEEPNORM_BETA = (8 * DEPTH) ** -0.25
LN_EPS = 1e-5

kernel_name = "hybrid_rglru_rwkv7_peer_deepnorm"


def layer_norm(x, g, b):
    xf = x.astype(jnp.float32)
    mu = jnp.mean(xf, axis=-1, keepdims=True)
    var = jnp.mean(jnp.square(xf - mu), axis=-1, keepdims=True)
    return ((xf - mu) * lax.rsqrt(var + LN_EPS) * g + b).astype(x.dtype)


def causal_depthwise_conv(x, w, b):
    y = lax.conv_general_dilated(
        x, w[:, None, :], window_strides=(1,), padding=[(RG_CONV - 1, 0)],
        dimension_numbers=("NWC", "WIO", "NWC"), feature_group_count=x.shape[-1])
    return y + b


def _linear_recurrence_combine(left, right):
    a_l, b_l = left
    a_r, b_r = right
    return a_l * a_r, a_r * b_l + b_r


def rglru_mixer(x, w_in, conv_w, conv_b, w_a, b_a, w_x, b_x, lam, w_out):
    bsz, s, _ = x.shape
    h = x @ w_in
    gate_branch = jax.nn.gelu(h[..., :RG_WIDTH])
    xc = causal_depthwise_conv(h[..., RG_WIDTH:], conv_w, conv_b)
    xh = xc.reshape(bsz, s, RG_HEADS, RG_BLOCK).astype(jnp.float32)
    r = jax.nn.sigmoid(jnp.einsum("bshi,hij->bshj", xh, w_a.astype(jnp.float32)) + b_a)
    i = jax.nn.sigmoid(jnp.einsum("bshi,hij->bshj", xh, w_x.astype(jnp.float32)) + b_x)
    log_a = -RG_C * jax.nn.softplus(-lam.astype(jnp.float32)) * r
    a = jnp.exp(log_a)
    u = jnp.sqrt(-jnp.expm1(2.0 * log_a)) * (i * xh)
    _, hs = lax.associative_scan(_linear_recurrence_combine, (a, u), axis=1)
    y = (hs.reshape(bsz, s, RG_WIDTH) * gate_branch).astype(x.dtype)
    return y @ w_out


def _rwkv7_step(state, inp):
    r_t, w_t, k_t, v_t, a_t, b_t = inp
    sa = jnp.einsum("bhvk,bhk->bhv", state, a_t)
    state = (state * w_t[:, :, None, :] + sa[..., None] * b_t[:, :, None, :]
             + v_t[..., None] * k_t[:, :, None, :])
    return state, jnp.einsum("bhvk,bhk->bhv", state, r_t)


def rwkv7_time_mix(x, mix, w_r, w_k, w_v, w0, w1, w2, a0, a1, a2, g1, g2,
                   k_k, k_a, r_k, lnx_g, lnx_b, w_o):
    bsz, s, d = x.shape
    xx = jnp.pad(x, ((0, 0), (1, 0), (0, 0)))[:, :-1] - x
    xr, xw, xk, xv, xa, xg = (x + xx * mix[m] for m in range(6))
    r = xr @ w_r
    k = xk @ w_k
    v = xv @ w_v
    w_log = -jax.nn.softplus(-(w0 + jnp.tanh(xw @ w1) @ w2)) - 0.5
    a = jax.nn.sigmoid(a0 + (xa @ a1) @ a2)
    g = jax.nn.sigmoid(xg @ g1) @ g2

    def heads(t):
        return t.reshape(bsz, s, RWKV_HEADS, RWKV_HEAD).astype(jnp.float32)

    r, w_log, k, v, a = heads(r), heads(w_log), heads(k), heads(v), heads(a)
    kk = k * k_k.reshape(RWKV_HEADS, RWKV_HEAD).astype(jnp.float32)
    kk = kk / jnp.maximum(jnp.sqrt(jnp.sum(kk * kk, axis=-1, keepdims=True)), RWKV_L2_EPS)
    k = k * (1.0 + (a - 1.0) * k_a.reshape(RWKV_HEADS, RWKV_HEAD).astype(jnp.float32))
    decay = jnp.exp(-jnp.exp(w_log))
    seq = tuple(jnp.moveaxis(t, 1, 0) for t in (r, decay, k, v, -kk, kk * a))
    state0 = jnp.zeros((bsz, RWKV_HEADS, RWKV_HEAD, RWKV_HEAD), jnp.float32)
    _, o = lax.scan(_rwkv7_step, state0, seq)
    o = jnp.moveaxis(o, 0, 1)
    mu = jnp.mean(o, axis=-1, keepdims=True)
    var = jnp.mean(jnp.square(o - mu), axis=-1, keepdims=True)
    o = ((o - mu) * lax.rsqrt(var + RWKV_GN_EPS)).reshape(bsz, s, d) * lnx_g + lnx_b
    bonus = jnp.sum(r * k * r_k.astype(jnp.float32), axis=-1, keepdims=True) * v
    o = o + bonus.reshape(bsz, s, d)
    return (o * g).astype(x.dtype) @ w_o


def peer_channel_mix(x, w_q, sub_keys, u, v):
    bsz, s, d = x.shape
    n_tok = bsz * s
    n_blk = n_tok // PEER_BLOCK
    xt = x.reshape(n_tok, d)
    q = (xt @ w_q).reshape(n_blk, PEER_BLOCK, PEER_HEADS, 2, PEER_DHALF)
    keys = sub_keys.astype(jnp.float32)

    def block(args):
        xb, qb = args
        sc = jnp.einsum("thpd,hpnd->thpn", qb.astype(jnp.float32), keys)
        sv, si = lax.top_k(sc, PEER_TOPK)
        comb = (sv[:, :, 0, :, None] + sv[:, :, 1, None, :]).reshape(
            PEER_BLOCK, PEER_HEADS, PEER_TOPK * PEER_TOPK)
        cv, ci = lax.top_k(comb, PEER_TOPK)
        i0 = jnp.take_along_axis(si[:, :, 0], ci // PEER_TOPK, axis=-1)
        i1 = jnp.take_along_axis(si[:, :, 1], ci % PEER_TOPK, axis=-1)
        eid = i0 * PEER_NKEYS + i1
        gate = jax.nn.softmax(cv, axis=-1)
        u_sel = u[eid]
        v_sel = v[eid]
        act = jax.nn.gelu(jnp.einsum("td,thkd->thk", xb, u_sel).astype(jnp.float32))
        coef = (gate * act).astype(xb.dtype)
        return jnp.einsum("thk,thkd->td", coef, v_sel)

    y = lax.map(block, (xt.reshape(n_blk, PEER_BLOCK, d), q))
    return y.reshape(bsz, s, d)


def setup_inputs(seed: int = 0) -> dict:
    key = jax.random.key(seed)
    ks = jax.random.split(key, 40)
    f32 = jnp.float32
    D, W, H, Bk = D_MODEL, RG_WIDTH, RG_HEADS, RG_BLOCK
    nA, nB = N_RGLRU_LAYERS, N_RWKV_LAYERS
    nrm = lambda k, shape, scale: jax.random.normal(k, shape, f32) * scale

    x = jax.random.normal(ks[0], (BATCH, SEQ, D), f32)
    rg_w_in = nrm(ks[1], (nA, D, 2 * W), D ** -0.5)
    rg_conv_w = nrm(ks[2], (nA, RG_CONV, W), RG_CONV ** -0.5)
    rg_conv_b = nrm(ks[3], (nA, W), 0.01)
    rg_w_a = nrm(ks[4], (nA, H, Bk, Bk), Bk ** -0.5)
    rg_b_a = nrm(ks[5], (nA, H, Bk), 0.01)
    rg_w_x = nrm(ks[6], (nA, H, Bk, Bk), Bk ** -0.5)
    rg_b_x = nrm(ks[7], (nA, H, Bk), 0.01)
    a_pow = jax.random.uniform(ks[8], (nA, H, Bk), f32, 0.9, 0.999) ** (1.0 / RG_C)
    rg_lambda = jnp.log(a_pow) - jnp.log1p(-a_pow)
    rg_w_out = nrm(ks[9], (nA, W, D), DEEPNORM_BETA * W ** -0.5)
    rw_mix = jax.random.uniform(ks[10], (nB, 6, D), f32)
    rw_w_r = nrm(ks[11], (nB, D, D), D ** -0.5)
    rw_w_k = nrm(ks[12], (nB, D, D), D ** -0.5)
    rw_w_v = nrm(ks[13], (nB, D, D), D ** -0.5)
    rw_w0 = jax.random.uniform(ks[14], (nB, D), f32, -5.0, -0.5)
    rw_w1 = nrm(ks[15], (nB, D, RWKV_DECAY_LORA), D ** -0.5)
    rw_w2 = nrm(ks[16], (nB, RWKV_DECAY_LORA, D), 0.1 * RWKV_DECAY_LORA ** -0.5)
    rw_a0 = nrm(ks[17], (nB, D), 0.1)
    rw_a1 = nrm(ks[18], (nB, D, RWKV_AAA_LORA), D ** -0.5)
    rw_a2 = nrm(ks[19], (nB, RWKV_AAA_LORA, D), 0.5 * RWKV_AAA_LORA ** -0.5)
    rw_g1 = nrm(ks[20], (nB, D, RWKV_GATE_LORA), D ** -0.5)
    rw_g2 = nrm(ks[21], (nB, RWKV_GATE_LORA, D), RWKV_GATE_LORA ** -0.5)
    rw_k_k = 0.85 + nrm(ks[22], (nB, D), 0.05)
    rw_k_a = 1.0 + nrm(ks[23], (nB, D), 0.05)
    rw_r_k = nrm(ks[24], (nB, RWKV_HEADS, RWKV_HEAD), 0.1)
    rw_lnx_g = 1.0 + nrm(ks[25], (nB, D), 0.01)
    rw_lnx_b = nrm(ks[26], (nB, D), 0.01)
    rw_w_o = nrm(ks[27], (nB, D, D), DEEPNORM_BETA * D ** -0.5)
    peer_w_q = nrm(ks[28], (DEPTH, D, PEER_HEADS * PEER_DKEY), D ** -0.5)
    peer_sub_keys = nrm(ks[29], (DEPTH, PEER_HEADS, 2, PEER_NKEYS, PEER_DHALF), PEER_DHALF ** -0.5)
    peer_u = nrm(ks[30], (DEPTH, PEER_EXPERTS, D), D ** -0.5)
    peer_v = nrm(ks[31], (DEPTH, PEER_EXPERTS, D), DEEPNORM_BETA * PEER_HEADS ** -0.5)
    ln_g = 1.0 + nrm(ks[32], (DEPTH, 2, D), 0.01)
    ln_b = nrm(ks[33], (DEPTH, 2, D), 0.01)
    return {
        "x": x,
        "rg_w_in": rg_w_in, "rg_conv_w": rg_conv_w, "rg_conv_b": rg_conv_b,
        "rg_w_a": rg_w_a, "rg_b_a": rg_b_a, "rg_w_x": rg_w_x, "rg_b_x": rg_b_x,
        "rg_lambda": rg_lambda, "rg_w_out": rg_w_out,
        "rw_mix": rw_mix, "rw_w_r": rw_w_r, "rw_w_k": rw_w_k, "rw_w_v": rw_w_v,
        "rw_w0": rw_w0, "rw_w1": rw_w1, "rw_w2": rw_w2,
        "rw_a0": rw_a0, "rw_a1": rw_a1, "rw_a2": rw_a2,
        "rw_g1": rw_g1, "rw_g2": rw_g2, "rw_k_k": rw_k_k, "rw_k_a": rw_k_a,
        "rw_r_k": rw_r_k, "rw_lnx_g": rw_lnx_g, "rw_lnx_b": rw_lnx_b, "rw_w_o": rw_w_o,
        "peer_w_q": peer_w_q, "peer_sub_keys": peer_sub_keys, "peer_u": peer_u, "peer_v": peer_v,
        "ln_g": ln_g, "ln_b": ln_b,
    }


def reference(x, rg_w_in, rg_conv_w, rg_conv_b, rg_w_a, rg_b_a, rg_w_x, rg_b_x, rg_lambda, rg_w_out,
              rw_mix, rw_w_r, rw_w_k, rw_w_v, rw_w0, rw_w1, rw_w2, rw_a0, rw_a1, rw_a2,
              rw_g1, rw_g2, rw_k_k, rw_k_a, rw_r_k, rw_lnx_g, rw_lnx_b, rw_w_o,
              peer_w_q, peer_sub_keys, peer_u, peer_v, ln_g, ln_b):
    for i in range(DEPTH):
        j = i // N_MIXERS
        if i % N_MIXERS == 0:
            m = rglru_mixer(x, rg_w_in[j], rg_conv_w[j], rg_conv_b[j], rg_w_a[j], rg_b_a[j],
                            rg_w_x[j], rg_b_x[j], rg_lambda[j], rg_w_out[j])
        else:
            m = rwkv7_time_mix(x, rw_mix[j], rw_w_r[j], rw_w_k[j], rw_w_v[j], rw_w0[j], rw_w1[j],
                               rw_w2[j], rw_a0[j], rw_a1[j], rw_a2[j], rw_g1[j], rw_g2[j],
                               rw_k_k[j], rw_k_a[j], rw_r_k[j], rw_lnx_g[j], rw_lnx_b[j], rw_w_o[j])
        x = layer_norm(DEEPNORM_ALPHA * x + m, ln_g[i, 0], ln_b[i, 0])
        c = peer_channel_mix(x, peer_w_q[i], peer_sub_keys[i], peer_u[i], peer_v[i])
        x = layer_norm(DEEPNORM_ALPHA * x + c, ln_g[i, 1], ln_b[i, 1])
    return x
```

```cpp
#define MK_REP 0x8000
#define MK_NREP 1
#include <hip/hip_runtime.h>
#include <cstdio>
#include <cstdint>

#define LAS __attribute__((address_space(3)))
#define GAS __attribute__((address_space(1)))
typedef unsigned short bf16_t;
typedef short bf16x8 __attribute__((ext_vector_type(8)));
typedef float f32x4 __attribute__((ext_vector_type(4)));
typedef float f32x2 __attribute__((ext_vector_type(2)));
typedef unsigned u32x4 __attribute__((ext_vector_type(4)));
typedef unsigned u32x2 __attribute__((ext_vector_type(2)));
typedef __bf16 bf16x2_t __attribute__((ext_vector_type(2)));

namespace mk {
constexpr int D = 1024, NB = 8, S = 2048, T = NB * S, W = 1408, NH = 16, HB = 88;
constexpr float ALPHA = 1.41421356237f, LN_EPS = 1e-5f;
constexpr int NWAVES = 8, NTHREADS = 512;

__device__ __forceinline__ unsigned f2bf(float f) { unsigned u = __builtin_bit_cast(unsigned, f); return (u + 0x7fffu + ((u >> 16) & 1u)) >> 16; }
__device__ __forceinline__ unsigned pk2(float lo, float hi) { return f2bf(lo) | (f2bf(hi) << 16); }
__device__ __forceinline__ float bf_lo(unsigned w) { return __builtin_bit_cast(float, w << 16); }
__device__ __forceinline__ float bf_hi(unsigned w) { return __builtin_bit_cast(float, w & 0xffff0000u); }
__device__ __forceinline__ float ldbf(const bf16_t* p) { return __builtin_bit_cast(float, ((unsigned)*p) << 16); }
__device__ __forceinline__ unsigned cvt_pk_bf16(float lo, float hi) { unsigned r; asm volatile("v_cvt_pk_bf16_f32 %0, %1, %2" : "=v"(r) : "v"(lo), "v"(hi)); return r; }
__device__ __forceinline__ unsigned cvt_pk_bf16_c(float lo, float hi) { f32x2 v = {lo, hi}; bf16x2_t b = __builtin_convertvector(v, bf16x2_t); return __builtin_bit_cast(unsigned, b); }
__device__ __forceinline__ float fast_exp(float x) { return __builtin_amdgcn_exp2f(x * 1.44269504089f); }
__device__ __forceinline__ float fast_rcp(float x) { return __builtin_amdgcn_rcpf(x); }
__device__ __forceinline__ float fast_sigmoid(float x) { return fast_rcp(1.f + fast_exp(-x)); }
__device__ __forceinline__ float fast_tanh(float x) { float e = fast_exp(-2.f * fabsf(x)); float t = (1.f - e) * fast_rcp(1.f + e); return x < 0.f ? -t : t; }
__device__ __forceinline__ float gelu_tanh(float x) { const float c = 0.7978845608028654f; float u = c * (x + 0.044715f * x * x * x); return x * fast_sigmoid(2.f * u); }
__device__ __forceinline__ float softplus_f(float x) { return x > 15.f ? x : __logf(1.f + fast_exp(x)); }
__device__ __forceinline__ int lane_id() { return (int)__builtin_amdgcn_mbcnt_hi(~0u, __builtin_amdgcn_mbcnt_lo(~0u, 0u)); }
__device__ __forceinline__ float wave_sum(float v) {
#pragma unroll
    for (int o = 1; o < 64; o <<= 1) v += __shfl_xor(v, o);
    return v;
}
template <int CTRL> __device__ __forceinline__ float dpp_f(float v) { return __builtin_bit_cast(float, __builtin_amdgcn_update_dpp(0, __builtin_bit_cast(int, v), CTRL, 0xf, 0xf, false)); }
#define DPP_QP_1032 0xB1
#define DPP_QP_2301 0x4E
#define DPP_ROW_HALF_MIRROR 0x141
#define DPP_ROW_MIRROR 0x140
#define DPP_ROW_ROR(n) (0x120 + (n))
__device__ __forceinline__ float sum8(float v) { v += dpp_f<DPP_QP_1032>(v); v += dpp_f<DPP_QP_2301>(v); v += dpp_f<DPP_ROW_HALF_MIRROR>(v); return v; }
__device__ __forceinline__ float sum16(float v) { v = sum8(v); v += dpp_f<DPP_ROW_ROR(8)>(v); return v; }

#define XB_TMO      128
#define XB_XCNT(j)  (256  + 64 * (j))
#define XB_XSUB(j)  (1280 + 64 * (j))
#define XB_XGEN(j)  (2304 + 64 * (j))
#define XB_TOP      3328
#define XB_TOPGEN   3392
#define XCD_BAR_WORDS 3456
#define XB_SPIN_CAP (1u << 20)
__device__ __forceinline__ unsigned xb_ld(unsigned* p)              { return __hip_atomic_load(p, __ATOMIC_RELAXED, __HIP_MEMORY_SCOPE_AGENT); }
__device__ __forceinline__ unsigned xb_add(unsigned* p, unsigned v) { return __hip_atomic_fetch_add(p, v, __ATOMIC_RELAXED, __HIP_MEMORY_SCOPE_AGENT); }
__device__ __forceinline__ unsigned xb_xcc_id() { return (unsigned)__builtin_amdgcn_s_getreg((3 << 11) | 20) & 0xFu; }
#define XB_SPIN(cond, bar) do { unsigned _sp = 0; while (cond) { __builtin_amdgcn_s_sleep(1); \
    if ((++_sp & 255u) == 0u) { if (xb_ld(&(bar)[XB_TMO])) break; if (_sp > XB_SPIN_CAP) { atomicAdd(&(bar)[XB_TMO], 1u); break; } } } } while (0)
struct XcdBarrier { unsigned* bar; unsigned x; volatile LAS unsigned* st; };
__device__ __forceinline__ XcdBarrier xcd_barrier_post(unsigned* bar, volatile LAS unsigned* st) {
    XcdBarrier b; b.bar = bar; b.x = xb_xcc_id(); b.st = st;
    if (threadIdx.x == 0) (void)xb_add(&bar[XB_XCNT(b.x)], 1u);
    return b;
}
__device__ __forceinline__ void xcd_barrier_complete(unsigned* bar, unsigned x, unsigned& nloc, unsigned& nx) {
    const unsigned G = gridDim.x * gridDim.y * gridDim.z;
    unsigned sum, cnt, mine, sp = 0u;
    for (;;) {
        sum = 0u; cnt = 0u; mine = 0u;
#pragma unroll
        for (unsigned j = 0; j < 16; ++j) { const unsigned c = xb_ld(&bar[XB_XCNT(j)]); sum += c; cnt += (c > 0u) ? 1u : 0u; mine = (j == x) ? c : mine; }
        if (sum == G) break;
        __builtin_amdgcn_s_sleep(1);
        if ((++sp & 255u) == 0u) { if (xb_ld(&bar[XB_TMO])) break; if (sp > XB_SPIN_CAP) { atomicAdd(&bar[XB_TMO], 1u); break; } }
    }
    nloc = mine > 0u ? mine : 1u; nx = cnt > 0u ? cnt : 1u;
}
__device__ __forceinline__ void xcd_barrier(const XcdBarrier& b, const bool leader) {
    asm volatile("s_waitcnt vmcnt(0)" ::: "memory");
    __syncthreads();
    if (leader) {
        unsigned* bar = b.bar;
        __builtin_amdgcn_s_waitcnt(0);
        unsigned nloc = b.st[0], nx = b.st[1];
        if (nloc == 0u) { xcd_barrier_complete(bar, b.x, nloc, nx); b.st[0] = nloc; b.st[1] = nx; }
        const unsigned old = xb_add(&bar[XB_XSUB(b.x)], 1u);
        const unsigned gen = old / nloc;
        if (old + 1u == (gen + 1u) * nloc) {
            __builtin_amdgcn_fence(__ATOMIC_RELEASE, "agent");
            asm volatile("s_waitcnt vmcnt(0)" ::: "memory");
            const unsigned og = xb_add(&bar[XB_TOP], 1u);
            const unsigned tg = og / nx;
            if (og + 1u == (tg + 1u) * nx) xb_add(&bar[XB_TOPGEN], 1u);
            else XB_SPIN(xb_ld(&bar[XB_TOPGEN]) == tg, bar);
            __builtin_amdgcn_fence(__ATOMIC_ACQUIRE, "agent");
            xb_add(&bar[XB_XGEN(b.x)], 1u);
            asm volatile("s_waitcnt vmcnt(0)" ::: "memory");
        } else {
            XB_SPIN(xb_ld(&bar[XB_XGEN(b.x)]) == gen, bar);
            __builtin_amdgcn_fence(__ATOMIC_ACQUIRE, "agent");
            asm volatile("s_waitcnt vmcnt(0)" ::: "memory");
        }
    }
    __syncthreads();
}

namespace pg8 {
constexpr int BM = 256, BK = 64, HALF = 128, HTB = HALF * BK * 2, STAGE_BYTES = 8 * HTB, NXCD = 8, WGM = 8;
__host__ __device__ __forceinline__ int lds_byte(int r, int c) { const int st = (r >> 4) * 2 + (c >> 5), rr = r & 15, cc = c & 31, ob = rr * 64 + cc * 2; return st * 1024 + (ob ^ (((ob >> 9) & 1) << 5)); }
__host__ __device__ __forceinline__ void stage_rc(int b, int& R, int& C) { const int st = b / 1024, sb = b % 1024, swz = sb ^ (((sb >> 9) & 1) << 5); R = (st >> 1) * 16 + swz / 64; C = (st & 1) * 32 + (swz % 64) / 2; }
__host__ __device__ __forceinline__ int perm32(int rho) { const int n = rho >> 4, i = rho & 15; return 8 * (i >> 2) + 4 * n + (i & 3); }

struct Unit { const char* A; const char* B; int pm, pn; };
template <class P> struct Order {
    int nM, nN, nwg, G, c; P p;
    __device__ __forceinline__ void init(int nM_, int nN_, int G_, int c_, const P& p_) { nM = nM_; nN = nN_; nwg = nM * nN; G = G_; c = c_; p = p_; }
    __device__ __forceinline__ bool next(int i, Unit& u) const {
        const long L = (long)i * G + c; if (L >= nwg) return false;
        int wgid = (int)L; { const int q = nwg / NXCD, r = nwg % NXCD, xcd = wgid % NXCD, off = wgid / NXCD; wgid = (xcd < r ? xcd * (q + 1) : r * (q + 1) + (xcd - r) * q) + off; }
        const int nig = WGM * nN, gid = wgid / nig, fm = gid * WGM, gsz = (nM - fm) < WGM ? (nM - fm) : WGM;
        u.pm = fm + ((wgid % nig) % gsz); u.pn = (wgid % nig) / gsz; p.locate(u); return true;
    }
};

template <class Epi, class Sched, bool ALIGN_EPI, bool SP2>
__device__ __forceinline__ void gemm_phase(LAS unsigned char* lds, const int tid, const int lda, const int ldb, const int K, const Sched& S, const Epi& E) {
    const int wid = __builtin_amdgcn_readfirstlane(tid >> 6), lane = tid & 63, wr = wid >> 2, wc = wid & 3, fr = lane & 15, fq = lane >> 4;
    const int nt = K / BK;
    unsigned voffA[2], voffB[2];
#pragma unroll
    for (int i = 0; i < 2; ++i) { int R, C; stage_rc(tid * 16 + i * 8192, R, C); const int Rb = Epi::PERM ? ((R & ~31) + perm32(R & 31)) : R;
        voffA[i] = (unsigned)(R * lda + C) * 2u; voffB[i] = (unsigned)(Rb * ldb + C) * 2u; }
    const size_t kstep = (size_t)(BK * 2);
    const size_t hstepA = (size_t)HALF * lda * 2, hstepB = (size_t)HALF * ldb * 2;
    const unsigned ldsw = (unsigned)wid * 1024u;
    const int aoff = lds_byte(wr * 64 + fr, fq * 8), boff = lds_byte(wc * 32 + fr, fq * 8);
#define PG8_SA(b, h) (((b) * 2 + (h)) * HTB)
#define PG8_SB(b, h) ((4 + (b) * 2 + (h)) * HTB)
#define PG8_STAGE(bufoff, gbase, voff) do { _Pragma("unroll") for (int _i = 0; _i < 2; ++_i) \
        __builtin_amdgcn_global_load_lds((const unsigned*)((const char*)(gbase) + (voff)[_i]), (LAS unsigned*)(lds + (bufoff) + ldsw + _i * 8192), 16, 0, 0); } while (0)
#define PG8_LDA(dst, b, h) do { _Pragma("unroll") for (int m = 0; m < 4; ++m) _Pragma("unroll") for (int k = 0; k < 2; ++k) dst[m][k] = *(const LAS bf16x8*)(lds + PG8_SA(b, h) + aoff + m * 2048 + k * 1024); } while (0)
#define PG8_LDB(dst, b, h) do { _Pragma("unroll") for (int n = 0; n < 2; ++n) _Pragma("unroll") for (int k = 0; k < 2; ++k) dst[n][k] = *(const LAS bf16x8*)(lds + PG8_SB(b, h) + boff + n * 2048 + k * 1024); } while (0)
#define PG8_MMA(ai, bj, At, Bt) do { __builtin_amdgcn_s_setprio(1); _Pragma("unroll") for (int m = 0; m < 4; ++m) _Pragma("unroll") for (int n = 0; n < 2; ++n) _Pragma("unroll") for (int k = 0; k < 2; ++k) \
        acc[ai][bj][m][n] = __builtin_amdgcn_mfma_f32_16x16x32_bf16(Bt[n][k], At[m][k], acc[ai][bj][m][n], 0, 0, 0); __builtin_amdgcn_s_setprio(0); } while (0)
#define PG8_WAIT_V(n) asm volatile("s_waitcnt vmcnt(" #n ")" ::: "memory")
#define PG8_WAIT_L(n) asm volatile("s_waitcnt lgkmcnt(" #n ")" ::: "memory")
#define PG8_BAR __builtin_amdgcn_s_barrier()
#define PG8_SCHED __builtin_amdgcn_sched_barrier(0)
    Unit cur, nxt; int ui = 0;
    if (!S.next(0, cur)) return;
    f32x4 acc[2][2][4][2];
#pragma unroll
    for (int a = 0; a < 2; ++a)
#pragma unroll
        for (int b = 0; b < 2; ++b)
#pragma unroll
            for (int m = 0; m < 4; ++m)
#pragma unroll
                for (int n = 0; n < 2; ++n) acc[a][b][m][n] = (f32x4){0.f, 0.f, 0.f, 0.f};
    bf16x8 At[4][2], B0[2][2], B1[2][2];
    const char* cA = cur.A; const char* cB = cur.B;
    if constexpr (SP2) {
        PG8_STAGE(PG8_SB(0, 0), cB, voffB); PG8_STAGE(PG8_SB(0, 1), cB + hstepB, voffB); PG8_STAGE(PG8_SA(0, 0), cA, voffA); PG8_STAGE(PG8_SA(0, 1), cA + hstepA, voffA);
        if (wr == 1) PG8_BAR;
        PG8_WAIT_V(2); PG8_BAR;
        PG8_STAGE(PG8_SB(1, 0), cB + kstep, voffB); PG8_STAGE(PG8_SA(1, 0), cA + kstep, voffA); PG8_STAGE(PG8_SB(1, 1), cB + hstepB + kstep, voffB);
        PG8_WAIT_V(6); PG8_BAR;
    } else {
        PG8_STAGE(PG8_SB(0, 0), cB, voffB); PG8_STAGE(PG8_SA(0, 0), cA, voffA); PG8_STAGE(PG8_SB(0, 1), cB + hstepB, voffB); PG8_STAGE(PG8_SA(0, 1), cA + hstepA, voffA);
        if (wr == 1) PG8_BAR;
        PG8_WAIT_V(4); PG8_BAR;
        PG8_STAGE(PG8_SB(1, 0), cB + kstep, voffB); PG8_STAGE(PG8_SA(1, 0), cA + kstep, voffA); PG8_STAGE(PG8_SB(1, 1), cB + hstepB + kstep, voffB);
        PG8_WAIT_V(6); PG8_BAR;
    }
    for (;;) {
        const bool has_next = S.next(ui + 1, nxt);
        const char* nA = has_next ? nxt.A : cA; const char* nB = has_next ? nxt.B : cB;
#pragma unroll 1
        for (int t = 0; t < nt; t += 2) {
            const bool last = (t == nt - 2);
            const char* a1 = cA + (size_t)(t + 1) * kstep;
            const char* a2 = last ? nA : cA + (size_t)(t + 2) * kstep; const char* b2 = last ? nB : cB + (size_t)(t + 2) * kstep;
            const char* a3 = a2 + kstep; const char* b3 = b2 + kstep;
            if constexpr (SP2) {
            PG8_LDB(B0, 0, 0); PG8_LDB(B1, 0, 1); PG8_SCHED; PG8_LDA(At, 0, 0); PG8_STAGE(PG8_SA(1, 1), a1 + hstepA, voffA);
            PG8_WAIT_V(8); PG8_WAIT_L(0); PG8_BAR; PG8_MMA(0, 0, At, B0); PG8_MMA(0, 1, At, B1); PG8_BAR; PG8_SCHED;
            PG8_LDA(At, 0, 1); PG8_STAGE(PG8_SB(0, 0), b2, voffB); PG8_STAGE(PG8_SB(0, 1), b2 + hstepB, voffB); PG8_STAGE(PG8_SA(0, 0), a2, voffA);
            PG8_WAIT_V(8); PG8_WAIT_L(0); PG8_BAR; PG8_MMA(1, 0, At, B0); PG8_MMA(1, 1, At, B1); PG8_BAR; PG8_SCHED;
            PG8_LDB(B0, 1, 0); PG8_LDB(B1, 1, 1); PG8_SCHED; PG8_LDA(At, 1, 0); PG8_STAGE(PG8_SA(0, 1), a2 + hstepA, voffA);
            PG8_WAIT_V(8); PG8_WAIT_L(0); PG8_BAR; PG8_MMA(0, 0, At, B0); PG8_MMA(0, 1, At, B1); PG8_BAR; PG8_SCHED;
            PG8_LDA(At, 1, 1); PG8_STAGE(PG8_SB(1, 0), b3, voffB); PG8_STAGE(PG8_SB(1, 1), b3 + hstepB, voffB); PG8_STAGE(PG8_SA(1, 0), a3, voffA);
            PG8_WAIT_V(8); PG8_WAIT_L(0); PG8_BAR; PG8_MMA(1, 0, At, B0); PG8_MMA(1, 1, At, B1); PG8_BAR; PG8_SCHED;
            } else {
            PG8_LDB(B0, 0, 0); PG8_SCHED; PG8_LDA(At, 0, 0); PG8_STAGE(PG8_SA(1, 1), a1 + hstepA, voffA);
            PG8_WAIT_L(8); PG8_BAR; PG8_WAIT_L(0); PG8_MMA(0, 0, At, B0); PG8_BAR; PG8_SCHED;
            PG8_LDB(B1, 0, 1); PG8_STAGE(PG8_SB(0, 0), b2, voffB);
            PG8_BAR; PG8_WAIT_L(0); PG8_MMA(0, 1, At, B1); PG8_BAR;
            PG8_LDA(At, 0, 1); PG8_STAGE(PG8_SA(0, 0), a2, voffA);
            PG8_BAR; PG8_WAIT_L(0); PG8_MMA(1, 0, At, B0); PG8_BAR; PG8_SCHED;
            PG8_STAGE(PG8_SB(0, 1), b2 + hstepB, voffB);
            PG8_WAIT_V(6); PG8_BAR; PG8_MMA(1, 1, At, B1); PG8_BAR;
            PG8_LDB(B0, 1, 0); PG8_SCHED; PG8_LDA(At, 1, 0); PG8_STAGE(PG8_SA(0, 1), a2 + hstepA, voffA);
            PG8_WAIT_L(8); PG8_BAR; PG8_WAIT_L(0); PG8_MMA(0, 0, At, B0); PG8_BAR; PG8_SCHED;
            PG8_LDB(B1, 1, 1); PG8_STAGE(PG8_SB(1, 0), b3, voffB);
            PG8_BAR; PG8_WAIT_L(0); PG8_MMA(0, 1, At, B1); PG8_BAR;
            PG8_LDA(At, 1, 1); PG8_STAGE(PG8_SA(1, 0), a3, voffA);
            PG8_BAR; PG8_WAIT_L(0); PG8_MMA(1, 0, At, B0); PG8_BAR; PG8_SCHED;
            PG8_STAGE(PG8_SB(1, 1), b3 + hstepB, voffB);
            PG8_WAIT_V(6); PG8_BAR; PG8_MMA(1, 1, At, B1); PG8_BAR;
            }
        }
        if constexpr (ALIGN_EPI) { if (wr == 0) PG8_BAR; }
        { int l_e = lane_id(); asm volatile("" : "+v"(l_e)); E(acc, cur, wr, wc, l_e & 15, l_e >> 4); }
        if (!has_next) break;
#pragma unroll
        for (int a = 0; a < 2; ++a)
#pragma unroll
            for (int b = 0; b < 2; ++b)
#pragma unroll
                for (int m = 0; m < 4; ++m)
#pragma unroll
                    for (int n = 0; n < 2; ++n) acc[a][b][m][n] = (f32x4){0.f, 0.f, 0.f, 0.f};
        cur = nxt; cA = nA; cB = nB; ++ui;
        if constexpr (ALIGN_EPI) { if (wr == 1) PG8_BAR; }
    }
    PG8_WAIT_V(0);
    if constexpr (!ALIGN_EPI) { if (wr == 0) PG8_BAR; }
    PG8_BAR;
#undef PG8_SA
#undef PG8_SB
#undef PG8_STAGE
#undef PG8_LDA
#undef PG8_LDB
#undef PG8_MMA
#undef PG8_WAIT_V
#undef PG8_WAIT_L
#undef PG8_BAR
#undef PG8_SCHED
}
}
}
namespace mk {
constexpr size_t MiB = 1u << 20;
constexpr size_t WS_CTL = 0, CTL_ZERO_BYTES = 65536;
constexpr size_t WS_WIN = 1 * MiB, WS_WG = 7 * MiB, WS_WOUT = 10 * MiB, WS_WPEER = 13 * MiB, WS_WRKV = 21 * MiB, WS_WL2 = 29 * MiB, WS_WO = 31 * MiB, WS_VEC = 33 * MiB;
constexpr size_t WS_UB = 34 * MiB, WS_VB = 66 * MiB;
constexpr size_t WS_X0B = 98 * MiB, WS_GATE = 130 * MiB, WS_H2 = 174 * MiB, WS_XC = 218 * MiB, WS_A = 262 * MiB, WS_U = 350 * MiB, WS_AGG = 438 * MiB;
constexpr size_t WS_Y = WS_H2, WS_Z0 = WS_A, WS_XF = 350 * MiB, WS_XB0 = 98 * MiB;
constexpr size_t WS_SC0 = 130 * MiB, WS_EID0 = 258 * MiB, WS_GW0 = 266 * MiB;
constexpr size_t WS_MIX = 34 * MiB, WS_R = 226 * MiB, WS_K = 258 * MiB, WS_V = 290 * MiB, WS_LORA = 322 * MiB, WS_WDEC = 98 * MiB, WS_AA = 162 * MiB, WS_G = 194 * MiB, WS_OG = WS_R;
constexpr size_t WS_Z1 = 98 * MiB, WS_XB1 = 162 * MiB;
constexpr size_t WS_SC1 = 194 * MiB, WS_EID1 = 322 * MiB, WS_GW1 = 330 * MiB;
constexpr size_t WS_DBG = 444 * MiB, WS_END = 512 * MiB;
constexpr int CW_BAR = 4096;
constexpr int LDS_BYTES = 163840, MISC_OFF = LDS_BYTES - 256;

struct Args { const float* in[34]; float* out; unsigned char* ws; int ph_lo, ph_hi; };

struct Frame {
    LAS unsigned char* lds; volatile LAS unsigned* MISC; unsigned* ctl; unsigned char* ws;
    int tid, lane, wave, vcu, G, gw, NGW, bx;
    float* out;
};
#define LDS_WAIT() asm volatile("s_waitcnt lgkmcnt(0)" ::: "memory")

__device__ __forceinline__ void transpose_item(const float* W, int K, int N, bf16_t* WT, int ldt, int row_off, int col_off, LAS float* scr, int item, int lane) {
    const int nblk = N / 32, kb = item / nblk, nb = item % nblk, k0 = 64 * kb, n0 = 32 * nb;
#pragma unroll 8
    for (int i = 0; i < 32; ++i) { const int kk = 2 * i + (lane >> 5); scr[kk * 33 + (lane & 31)] = W[(size_t)(k0 + kk) * N + n0 + (lane & 31)]; }
    LDS_WAIT(); asm volatile("" ::: "memory");
    const int c = lane & 7;
#pragma unroll
    for (int j = 0; j < 4; ++j) { const int n = (lane >> 3) + 8 * j; const LAS float* s = scr + (8 * c) * 33 + n;
        u32x4 o; o.x = pk2(s[0 * 33], s[1 * 33]); o.y = pk2(s[2 * 33], s[3 * 33]); o.z = pk2(s[4 * 33], s[5 * 33]); o.w = pk2(s[6 * 33], s[7 * 33]);
        *(u32x4*)(WT + (size_t)(row_off + n0 + n) * ldt + col_off + k0 + 8 * c) = o; }
    LDS_WAIT(); asm volatile("" ::: "memory");
    (void)K;
}
__device__ __forceinline__ int gates_koff(int q) { int s = 128 * (q > 0 ? q - 1 : 0); return s > 1024 ? 1024 : s; }

__device__ __forceinline__ void cvt_stream(const float* src, bf16_t* dst, size_t n8, size_t w, size_t nw) {
    for (size_t i = w; i < n8; i += nw) { const f32x4 a = *(const f32x4*)(src + i * 8), b = *(const f32x4*)(src + i * 8 + 4);
        u32x4 o; o.x = pk2(a.x, a.y); o.y = pk2(a.z, a.w); o.z = pk2(b.x, b.y); o.w = pk2(b.z, b.w); *(u32x4*)(dst + i * 8) = o; }
}

__device__ __forceinline__ void cvt_stream_fp8(const float* src, unsigned char* dst, size_t n16, size_t w, size_t nw, float scale) {
    for (size_t i = w; i < n16; i += nw) { const f32x4 a = *(const f32x4*)(src + i * 16) * scale, b = *(const f32x4*)(src + i * 16 + 4) * scale, c = *(const f32x4*)(src + i * 16 + 8) * scale, d = *(const f32x4*)(src + i * 16 + 12) * scale;
        u32x4 o; int t;
        t = __builtin_amdgcn_cvt_pk_fp8_f32(a.x, a.y, 0, false); o.x = (unsigned)__builtin_amdgcn_cvt_pk_fp8_f32(a.z, a.w, t, true);
        t = __builtin_amdgcn_cvt_pk_fp8_f32(b.x, b.y, 0, false); o.y = (unsigned)__builtin_amdgcn_cvt_pk_fp8_f32(b.z, b.w, t, true);
        t = __builtin_amdgcn_cvt_pk_fp8_f32(c.x, c.y, 0, false); o.z = (unsigned)__builtin_amdgcn_cvt_pk_fp8_f32(c.z, c.w, t, true);
        t = __builtin_amdgcn_cvt_pk_fp8_f32(d.x, d.y, 0, false); o.w = (unsigned)__builtin_amdgcn_cvt_pk_fp8_f32(d.z, d.w, t, true);
        *(u32x4*)(dst + i * 16) = o; }
}
constexpr float U_SCALE = 256.f, V_SCALE = 32.f;

__device__ __forceinline__ void p0_prologue(Frame& F, const Args& args) {
    LAS float* scr = (LAS float*)(F.lds + F.wave * 16384);
    const int gw = F.gw, NGW = F.NGW, lane = F.lane;
    bf16_t* Win_t = (bf16_t*)(F.ws + WS_WIN); bf16_t* Wout_t = (bf16_t*)(F.ws + WS_WOUT); bf16_t* Wrkv_t = (bf16_t*)(F.ws + WS_WRKV); bf16_t* Wl2_t = (bf16_t*)(F.ws + WS_WL2); bf16_t* Wo_t = (bf16_t*)(F.ws + WS_WO);
    for (int it = gw; it < 16 * 88; it += NGW) transpose_item(args.in[1], 1024, 2816, Win_t, 1024, 0, 0, scr, it, lane);
    for (int it = gw; it < 22 * 32; it += NGW) transpose_item(args.in[9], 1408, 1024, Wout_t, 1408, 0, 0, scr, it, lane);
    for (int it = gw; it < 512; it += NGW) transpose_item(args.in[11], 1024, 1024, Wrkv_t, 1024, 0, 0, scr, it, lane);
    for (int it = gw; it < 512; it += NGW) transpose_item(args.in[12], 1024, 1024, Wrkv_t, 1024, 1024, 0, scr, it, lane);
    for (int it = gw; it < 512; it += NGW) transpose_item(args.in[13], 1024, 1024, Wrkv_t, 1024, 2048, 0, scr, it, lane);
    for (int it = gw; it < 32; it += NGW) transpose_item(args.in[15], 1024, 64, Wrkv_t, 1024, 3072, 0, scr, it, lane);
    for (int it = gw; it < 32; it += NGW) transpose_item(args.in[18], 1024, 64, Wrkv_t, 1024, 3328, 0, scr, it, lane);
    for (int it = gw; it < 64; it += NGW) transpose_item(args.in[20], 1024, 128, Wrkv_t, 1024, 3584, 0, scr, it, lane);
    for (int it = gw; it < 512; it += NGW) transpose_item(args.in[27], 1024, 1024, Wo_t, 1024, 0, 0, scr, it, lane);
    for (int it = gw; it < 32; it += NGW) transpose_item(args.in[16], 64, 1024, Wl2_t, 256, 0, 0, scr, it, lane);
    for (int it = gw; it < 32; it += NGW) transpose_item(args.in[19], 64, 1024, Wl2_t, 256, 1024, 64, scr, it, lane);
    for (int it = gw; it < 64; it += NGW) transpose_item(args.in[21], 128, 1024, Wl2_t, 256, 2048, 128, scr, it, lane);
    const size_t gt = (size_t)gw * 64 + lane, NGT = (size_t)NGW * 64;
    const u32x4 z4 = {0u, 0u, 0u, 0u};
    for (size_t i = gt; i < (size_t)768 * 128; i += NGT) {
        const int row = 3072 + (int)(i / 128), r = row - 3072; const bool data = (r < 64) || (r >= 256 && r < 320) || (r >= 512 && r < 640);
        if (!data) *(u32x4*)(Wrkv_t + (size_t)row * 1024 + (i % 128) * 8) = z4; }
    for (size_t i = gt; i < (size_t)3072 * 32; i += NGT) {
        const int row = (int)(i / 32), c8 = (int)(i % 32) * 8, g = row >> 10; const int lo = g == 0 ? 0 : (g == 1 ? 64 : 128), hi = g == 0 ? 64 : (g == 1 ? 128 : 256);
        if (c8 < lo || c8 >= hi) *(u32x4*)(Wl2_t + (size_t)row * 256 + c8) = z4; }
    { bf16_t* Wg_t = (bf16_t*)(F.ws + WS_WG);
      for (size_t i = gt; i < (size_t)2816 * 48; i += NGT) {
          const int row = (int)(i / 48), k8 = (int)(i % 48) * 8, q = row >> 8, r = row & 255, gs = r >> 7, ch = 128 * q + (r & 127), h = ch / HB, j = ch % HB;
          const float* w = (gs ? args.in[6] : args.in[4]) + (size_t)h * HB * HB; const int kg0 = gates_koff(q) + k8;
          float v[8];
#pragma unroll
          for (int e = 0; e < 8; ++e) { const int kg = kg0 + e; v[e] = (kg / HB == h) ? w[(kg % HB) * HB + j] : 0.f; }
          u32x4 o; o.x = pk2(v[0], v[1]); o.y = pk2(v[2], v[3]); o.z = pk2(v[4], v[5]); o.w = pk2(v[6], v[7]);
          *(u32x4*)(Wg_t + (size_t)row * 384 + k8) = o; } }
    for (int it = gw; it < 4096; it += NGW) {
        const int layer = it >> 11, hp = (it >> 7) & 15, n0 = ((it >> 4) & 7) * 16, k0 = (it & 15) * 64;
        const float* keys = args.in[29] + ((size_t)layer * 16 + hp) * 128 * 128; const float* wq = args.in[28] + (size_t)layer * 1024 * 2048 + hp * 128;
        bf16_t* We = (bf16_t*)(F.ws + WS_WPEER) + (size_t)layer * 2048 * 1024;
        f32x4 acc[4];
#pragma unroll
        for (int s = 0; s < 4; ++s) acc[s] = (f32x4){0.f, 0.f, 0.f, 0.f};
        const int li = lane & 15, q = lane >> 4;
        for (int dc = 0; dc < 8; ++dc) {
            const int d = 16 * dc + 4 * q;
            const f32x4 a = *(const f32x4*)(keys + (size_t)(n0 + li) * 128 + d);
            f32x4 b[4];
#pragma unroll
            for (int s = 0; s < 4; ++s) b[s] = *(const f32x4*)(wq + (size_t)(k0 + 16 * s + li) * 2048 + d);
#pragma unroll
            for (int e = 0; e < 4; ++e)
#pragma unroll
                for (int s = 0; s < 4; ++s) acc[s] = __builtin_amdgcn_mfma_f32_16x16x4f32(a[e], b[s][e], acc[s], 0, 0, 0);
        }
#pragma unroll
        for (int s = 0; s < 4; ++s)
#pragma unroll
            for (int r = 0; r < 4; ++r) We[(size_t)(hp * 128 + n0 + 4 * q + r) * 1024 + k0 + 16 * s + li] = (bf16_t)f2bf(acc[s][r]);
    }
    cvt_stream(args.in[0], (bf16_t*)(F.ws + WS_X0B), (size_t)T * D / 8, gt, NGT);
    cvt_stream_fp8(args.in[30], F.ws + WS_UB, (size_t)16384 * D / 16, gt, NGT, U_SCALE);
    cvt_stream_fp8(args.in[31], F.ws + WS_VB, (size_t)16384 * D / 16, gt, NGT, V_SCALE);
    { float* sl = (float*)(F.ws + WS_VEC); for (size_t i = gt; i < (size_t)W; i += NGT) { const float l = args.in[8][i]; sl[i] = -8.f * (l < -15.f ? -l : log1pf(expf(-l))); } }
}

struct ProbPlain { const char* A; const char* B; size_t strideA, strideB;
    __device__ __forceinline__ void locate(pg8::Unit& u) const { u.A = A + (size_t)u.pm * strideA; u.B = B + (size_t)u.pn * strideB; } };
struct ProbGates { const char* A; const char* B;
    __device__ __forceinline__ void locate(pg8::Unit& u) const { u.A = A + (size_t)u.pm * (256 * W * 2) + gates_koff(u.pn) * 2; u.B = B + (size_t)u.pn * (256 * 384 * 2); } };
struct ProbRkv { const char* mix; const char* B;
    __device__ __forceinline__ void locate(pg8::Unit& u) const { const int pn = u.pn; const int j = pn < 4 ? 0 : (pn < 8 ? 2 : (pn < 12 ? 3 : (pn == 12 ? 1 : (pn == 13 ? 4 : 5))));
        u.A = mix + (size_t)j * ((size_t)T * D * 2) + (size_t)u.pm * (256 * D * 2); u.B = B + (size_t)pn * (256 * D * 2); } };

struct EpiWin { static constexpr bool PERM = true; bf16_t* gate; bf16_t* h2;
    __device__ __forceinline__ void operator()(const f32x4 (&acc)[2][2][4][2], const pg8::Unit& u, int wr, int wc, int fr, int fq) const {
        const int row0 = u.pm * 256 + wr * 64 + fr;
#pragma unroll
        for (int bj = 0; bj < 2; ++bj) { const int hb = 2 * u.pn + bj; const bool isg = hb < 11; bf16_t* base = isg ? gate : h2; const int col = 128 * (isg ? hb : hb - 11) + wc * 32 + 8 * fq;
#pragma unroll
            for (int ai = 0; ai < 2; ++ai)
#pragma unroll
                for (int m = 0; m < 4; ++m) { f32x4 v0 = acc[ai][bj][m][0], v1 = acc[ai][bj][m][1];
                    if (isg) {
#pragma unroll
                        for (int j = 0; j < 4; ++j) { v0[j] = gelu_tanh(v0[j]); v1[j] = gelu_tanh(v1[j]); } }
                    u32x4 w; w.x = cvt_pk_bf16(v0[0], v0[1]); w.y = cvt_pk_bf16(v0[2], v0[3]); w.z = cvt_pk_bf16(v1[0], v1[1]); w.w = cvt_pk_bf16(v1[2], v1[3]);
                    *(u32x4*)(base + (size_t)(row0 + ai * 128 + m * 16) * W + col) = w; } }
    } };
struct EpiGates { static constexpr bool PERM = false; const bf16_t* xc; const float* sl; const float* ba; const float* bx; float* a; float* uo;
    __device__ __forceinline__ void operator()(const f32x4 (&acc)[2][2][4][2], const pg8::Unit& u, int wr, int wc, int fr, int fq) const {
        const int row0 = u.pm * 256 + wr * 64 + fr;
#pragma unroll
        for (int ai = 0; ai < 2; ++ai)
#pragma unroll
            for (int m = 0; m < 4; ++m) {
#pragma unroll
                for (int n = 0; n < 2; ++n) { const int c = 128 * u.pn + wc * 32 + 16 * n + 4 * fq; const size_t off = (size_t)(row0 + ai * 128 + m * 16) * W + c;
                    const f32x4 s4 = *(const f32x4*)(sl + c), ba4 = *(const f32x4*)(ba + c), bx4 = *(const f32x4*)(bx + c);
                    const u32x2 xw = *(const u32x2*)(xc + off);
                    const f32x4 pa = acc[ai][0][m][n] + ba4, px = acc[ai][1][m][n] + bx4; f32x4 av, uv; const f32x4 xs = {bf_lo(xw.x), bf_hi(xw.x), bf_lo(xw.y), bf_hi(xw.y)};
#pragma unroll
                    for (int j = 0; j < 4; ++j) { const float r = fast_sigmoid(pa[j]), ig = fast_sigmoid(px[j]); const float la = s4[j] * r; const float aa = fast_exp(la);
                        av[j] = aa; uv[j] = sqrtf(fmaxf(1.f - aa * aa, 0.f)) * ig * xs[j]; }
                    *(f32x4*)(a + off) = av; *(f32x4*)(uo + off) = uv; __builtin_amdgcn_sched_barrier(0); }
                asm volatile("" ::: "memory"); }
    } };
struct EpiRes { static constexpr bool PERM = false; const float* res; float* z;
    __device__ __forceinline__ void operator()(const f32x4 (&acc)[2][2][4][2], const pg8::Unit& u, int wr, int wc, int fr, int fq) const {
        const int row0 = u.pm * 256 + wr * 64 + fr, col0 = u.pn * 256 + wc * 32 + 4 * fq;
#pragma unroll
        for (int ai = 0; ai < 2; ++ai)
#pragma unroll
            for (int m = 0; m < 4; ++m) { const size_t off = (size_t)(row0 + ai * 128 + m * 16) * D + col0;
#pragma unroll
                for (int bj = 0; bj < 2; ++bj)
#pragma unroll
                    for (int n = 0; n < 2; ++n) { const f32x4 r4 = *(const f32x4*)(res + off + bj * 128 + n * 16); *(f32x4*)(z + off + bj * 128 + n * 16) = r4 * ALPHA + acc[ai][bj][m][n]; } }
    } };
struct EpiScores { static constexpr bool PERM = false; float* sc;
    __device__ __forceinline__ void operator()(const f32x4 (&acc)[2][2][4][2], const pg8::Unit& u, int wr, int wc, int fr, int fq) const {
#pragma unroll
        for (int ai = 0; ai < 2; ++ai) { const int tb = 4 * u.pm + 2 * ai + wr;
#pragma unroll
            for (int bj = 0; bj < 2; ++bj) { const int hp = 2 * u.pn + bj; float* base = sc + ((size_t)(tb * 16 + hp) * 128) * 64;
#pragma unroll
                for (int m = 0; m < 4; ++m) { const int tl = 16 * m + fr;
#pragma unroll
                    for (int n = 0; n < 2; ++n) { const int nn = 32 * wc + 16 * n + 4 * fq;
#pragma unroll
                        for (int j = 0; j < 4; ++j) base[(size_t)(nn + j) * 64 + tl] = acc[ai][bj][m][n][j]; } } } }
    } };
struct EpiRkv { static constexpr bool PERM = true; bf16_t* r; bf16_t* lora;
    __device__ __forceinline__ void operator()(const f32x4 (&acc)[2][2][4][2], const pg8::Unit& u, int wr, int wc, int fr, int fq) const {
        const int row0 = u.pm * 256 + wr * 64 + fr, pn = u.pn;
        if (pn < 12) { bf16_t* base = r + (size_t)(pn >> 2) * ((size_t)T * D); const int col0 = (pn & 3) * 256 + wc * 32 + 8 * fq;
#pragma unroll
            for (int ai = 0; ai < 2; ++ai)
#pragma unroll
                for (int m = 0; m < 4; ++m)
#pragma unroll
                    for (int bj = 0; bj < 2; ++bj) { const f32x4 v0 = acc[ai][bj][m][0], v1 = acc[ai][bj][m][1];
                        u32x4 w; w.x = cvt_pk_bf16(v0[0], v0[1]); w.y = cvt_pk_bf16(v0[2], v0[3]); w.z = cvt_pk_bf16(v1[0], v1[1]); w.w = cvt_pk_bf16(v1[2], v1[3]);
                        *(u32x4*)(base + (size_t)(row0 + ai * 128 + m * 16) * D + col0 + bj * 128) = w; }
        } else {
            const int kind = pn - 12;
            const int lim = kind == 2 ? 128 : 64, dst0 = kind == 0 ? 0 : (kind == 1 ? 64 : 128);
#pragma unroll
            for (int bj = 0; bj < 2; ++bj) { const int cl = 128 * bj + wc * 32 + 8 * fq; if (cl < lim) {
#pragma unroll
                for (int ai = 0; ai < 2; ++ai)
#pragma unroll
                    for (int m = 0; m < 4; ++m) { f32x4 v0 = acc[ai][bj][m][0], v1 = acc[ai][bj][m][1];
#pragma unroll
                        for (int j = 0; j < 4; ++j) { if (kind == 0) { v0[j] = fast_tanh(v0[j]); v1[j] = fast_tanh(v1[j]); } else if (kind == 2) { v0[j] = fast_sigmoid(v0[j]); v1[j] = fast_sigmoid(v1[j]); } }
                        u32x4 w; w.x = cvt_pk_bf16(v0[0], v0[1]); w.y = cvt_pk_bf16(v0[2], v0[3]); w.z = cvt_pk_bf16(v1[0], v1[1]); w.w = cvt_pk_bf16(v1[2], v1[3]);
                        *(u32x4*)(lora + (size_t)(row0 + ai * 128 + m * 16) * 256 + dst0 + cl) = w; } } }
        }
    } };
struct EpiLora2 { static constexpr bool PERM = true; float* wdec; bf16_t* aa; const float* w0; const float* a0;
    __device__ __forceinline__ void operator()(const f32x4 (&acc)[2][2][4][2], const pg8::Unit& u, int wr, int wc, int fr, int fq) const {
        const int row0 = u.pm * 256 + wr * 64 + fr, pn = u.pn, kind = pn >> 2;
#pragma unroll
        for (int bj = 0; bj < 2; ++bj) { const int col = (pn & 3) * 256 + 128 * bj + wc * 32 + 8 * fq;
            f32x4 c0 = {0.f, 0.f, 0.f, 0.f}, c1 = c0;
            if (kind == 0) { c0 = *(const f32x4*)(w0 + col); c1 = *(const f32x4*)(w0 + col + 4); } else if (kind == 1) { c0 = *(const f32x4*)(a0 + col); c1 = *(const f32x4*)(a0 + col + 4); }
#pragma unroll
            for (int ai = 0; ai < 2; ++ai)
#pragma unroll
                for (int m = 0; m < 4; ++m) { f32x4 v0 = acc[ai][bj][m][0] + c0, v1 = acc[ai][bj][m][1] + c1; const size_t off = (size_t)(row0 + ai * 128 + m * 16) * D + col;
                    if (kind == 0) {
#pragma unroll
                        for (int j = 0; j < 4; ++j) { v0[j] = fast_exp(-0.60653066f * fast_sigmoid(v0[j])); v1[j] = fast_exp(-0.60653066f * fast_sigmoid(v1[j])); }
                        *(f32x4*)(wdec + off) = v0; *(f32x4*)(wdec + off + 4) = v1;
                    } else {
                        if (kind == 1) {
#pragma unroll
                            for (int j = 0; j < 4; ++j) { v0[j] = fast_sigmoid(v0[j]); v1[j] = fast_sigmoid(v1[j]); } }
                        u32x4 w; w.x = cvt_pk_bf16(v0[0], v0[1]); w.y = cvt_pk_bf16(v0[2], v0[3]); w.z = cvt_pk_bf16(v1[0], v1[1]); w.w = cvt_pk_bf16(v1[2], v1[3]);
                        *(u32x4*)(aa + (size_t)(kind - 1) * ((size_t)T * D) + off) = w; }
                    __builtin_amdgcn_sched_barrier(0); } }
    } };

template <class Epi, class Prob>
__device__ __forceinline__ void run_gemm(Frame& F, int nM, int nN, int lda, int ldb, int K, const Prob& P, const Epi& E) {
    pg8::Order<Prob> S; S.init(nM, nN, F.G, F.bx, P);
    pg8::gemm_phase<Epi, pg8::Order<Prob>, true, true>(F.lds, F.tid, lda, ldb, K, S, E);
}

__device__ __forceinline__ void conv_phase(Frame& F, const float* cw, const float* cb) {
    const bf16_t* h2 = (const bf16_t*)(F.ws + WS_H2); bf16_t* xc = (bf16_t*)(F.ws + WS_XC);
    const size_t gt = (size_t)F.gw * 64 + F.lane, NGT = (size_t)F.NGW * 64;
    for (size_t i = gt; i < (size_t)T * (W / 8); i += NGT) {
        const int t = (int)(i / (W / 8)), c = (int)(i % (W / 8)) * 8, s = t & (S - 1);
        float acc[8];
        { const f32x4 b0 = *(const f32x4*)(cb + c), b1 = *(const f32x4*)(cb + c + 4); acc[0] = b0.x; acc[1] = b0.y; acc[2] = b0.z; acc[3] = b0.w; acc[4] = b1.x; acc[5] = b1.y; acc[6] = b1.z; acc[7] = b1.w; }
#pragma unroll
        for (int j = 0; j < 4; ++j) { if (s - 3 + j >= 0) {
            const u32x4 hv = *(const u32x4*)(h2 + (size_t)(t - 3 + j) * W + c); const f32x4 w0 = *(const f32x4*)(cw + j * W + c), w1 = *(const f32x4*)(cw + j * W + c + 4);
            acc[0] += w0.x * bf_lo(hv.x); acc[1] += w0.y * bf_hi(hv.x); acc[2] += w0.z * bf_lo(hv.y); acc[3] += w0.w * bf_hi(hv.y);
            acc[4] += w1.x * bf_lo(hv.z); acc[5] += w1.y * bf_hi(hv.z); acc[6] += w1.z * bf_lo(hv.w); acc[7] += w1.w * bf_hi(hv.w); } }
        u32x4 o; o.x = pk2(acc[0], acc[1]); o.y = pk2(acc[2], acc[3]); o.z = pk2(acc[4], acc[5]); o.w = pk2(acc[6], acc[7]);
        *(u32x4*)(xc + (size_t)t * W + c) = o;
    }
}
constexpr int RG_CH = 32, RG_NCH = S / RG_CH;
__device__ __forceinline__ void rgscan1_phase(Frame& F) {
    const float* a = (const float*)(F.ws + WS_A); const float* u = (const float*)(F.ws + WS_U); float* agg = (float*)(F.ws + WS_AGG);
    for (int it = F.gw; it < NB * RG_NCH * 11; it += F.NGW) {
        const int cg = it % 11, ch = (it / 11) % RG_NCH, b = it / (11 * RG_NCH), c = cg * 128 + 2 * F.lane; const size_t t0 = (size_t)b * S + (size_t)ch * RG_CH;
        f32x2 P = {1.f, 1.f}, H = {0.f, 0.f};
#pragma unroll 8
        for (int s = 0; s < RG_CH; ++s) { const f32x2 av = *(const f32x2*)(a + (t0 + s) * W + c), uv = *(const f32x2*)(u + (t0 + s) * W + c); H = av * H + uv; P = P * av; }
        const size_t o = (size_t)(b * RG_NCH + ch) * W + c; *(f32x2*)(agg + o) = P; *(f32x2*)(agg + o + (size_t)NB * RG_NCH * W) = H;
    }
}
__device__ __forceinline__ void rgscan2_phase(Frame& F) {
    const float* a = (const float*)(F.ws + WS_A); const float* u = (const float*)(F.ws + WS_U); const float* agg = (const float*)(F.ws + WS_AGG);
    const bf16_t* gate = (const bf16_t*)(F.ws + WS_GATE); bf16_t* y = (bf16_t*)(F.ws + WS_Y);
    for (int it = F.gw; it < NB * RG_NCH * 11; it += F.NGW) {
        const int cg = it % 11, ch = (it / 11) % RG_NCH, b = it / (11 * RG_NCH), c = cg * 128 + 2 * F.lane; const size_t t0 = (size_t)b * S + (size_t)ch * RG_CH;
        f32x2 H = {0.f, 0.f};
        for (int j = 0; j < ch; ++j) { const size_t o = (size_t)(b * RG_NCH + j) * W + c; const f32x2 Pj = *(const f32x2*)(agg + o), Hj = *(const f32x2*)(agg + o + (size_t)NB * RG_NCH * W); H = Pj * H + Hj; }
#pragma unroll 8
        for (int s = 0; s < RG_CH; ++s) { const size_t o = (t0 + s) * W + c; const f32x2 av = *(const f32x2*)(a + o), uv = *(const f32x2*)(u + o); H = av * H + uv;
            const unsigned gw_ = *(const unsigned*)(gate + o); *(unsigned*)(y + o) = pk2(H.x * bf_lo(gw_), H.y * bf_hi(gw_)); }
    }
}
__device__ __forceinline__ void ln_phase(Frame& F, const float* z, const float* g, const float* bb, float* xf, bf16_t* xb) {
    for (int m = F.gw; m < T; m += F.NGW) {
        const f32x4* zr = (const f32x4*)(z + (size_t)m * D) + F.lane; f32x4 v[4]; float s = 0.f;
#pragma unroll
        for (int j = 0; j < 4; ++j) { v[j] = zr[64 * j]; s += (v[j].x + v[j].y) + (v[j].z + v[j].w); }
        const float mean = wave_sum(s) * (1.f / D); float s2 = 0.f;
#pragma unroll
        for (int j = 0; j < 4; ++j) { v[j] = v[j] - mean; s2 += (v[j].x * v[j].x + v[j].y * v[j].y) + (v[j].z * v[j].z + v[j].w * v[j].w); }
        const float rstd = 1.f / sqrtf(wave_sum(s2) * (1.f / D) + LN_EPS);
#pragma unroll
        for (int j = 0; j < 4; ++j) { const int c = 4 * F.lane + 256 * j; const f32x4 o = v[j] * rstd * *(const f32x4*)(g + c) + *(const f32x4*)(bb + c);
            *(f32x4*)(xf + (size_t)m * D + c) = o; u32x2 w; w.x = pk2(o.x, o.y); w.y = pk2(o.z, o.w); *(u32x2*)(xb + (size_t)m * D + c) = w; }
    }
}
__device__ __forceinline__ void ins16(float (&s)[16], float x) {
#pragma unroll
    for (int i = 0; i < 16; ++i) { const float hi = fmaxf(s[i], x); x = fminf(s[i], x); s[i] = hi; }
}
__device__ __forceinline__ void topk_phase(Frame& F, const float* sc, int* eid, float* gwt) {
    for (int it = F.gw; it < (T / 64) * 8; it += F.NGW) {
        const int tb = it >> 3, h = it & 7, t = tb * 64 + F.lane;
        float s0[16], s1[16];
#pragma unroll
        for (int i = 0; i < 16; ++i) { s0[i] = -__builtin_inff(); s1[i] = -__builtin_inff(); }
        const float* p0 = sc + ((size_t)(tb * 16 + 2 * h) * 128) * 64 + F.lane; const float* p1 = p0 + 128 * 64;
#pragma unroll 4
        for (int n = 0; n < 128; ++n) { const float v = p0[(size_t)n * 64]; ins16(s0, __builtin_bit_cast(float, (__builtin_bit_cast(unsigned, v) & ~127u) | (unsigned)(127 - n))); }
#pragma unroll 4
        for (int n = 0; n < 128; ++n) { const float v = p1[(size_t)n * 64]; ins16(s1, __builtin_bit_cast(float, (__builtin_bit_cast(unsigned, v) & ~127u) | (unsigned)(127 - n))); }
        float tt[16];
#pragma unroll
        for (int i = 0; i < 16; ++i) tt[i] = -__builtin_inff();
#pragma unroll
        for (int i = 0; i < 16; ++i)
#pragma unroll
            for (int j = 0; j < 16; ++j) if ((i + 1) * (j + 1) <= 16) { const float c = s0[i] + s1[j]; ins16(tt, __builtin_bit_cast(float, (__builtin_bit_cast(unsigned, c) & ~255u) | (unsigned)(255 - (i * 16 + j)))); }
        float e[16], sum = 0.f;
#pragma unroll
        for (int r = 0; r < 16; ++r) { e[r] = fast_exp(tt[r] - tt[0]); sum += e[r]; }
        const float inv = 1.f / sum;
        int ids[16];
#pragma unroll
        for (int r = 0; r < 16; ++r) { const unsigned code = 255u - (__builtin_bit_cast(unsigned, tt[r]) & 255u); const unsigned ci = code >> 4, cj = code & 15u; unsigned i0 = 0, i1 = 0;
#pragma unroll
            for (int i = 0; i < 16; ++i) { i0 = (ci == (unsigned)i) ? (127u - (__builtin_bit_cast(unsigned, s0[i]) & 127u)) : i0; i1 = (cj == (unsigned)i) ? (127u - (__builtin_bit_cast(unsigned, s1[i]) & 127u)) : i1; }
            ids[r] = (int)(i0 * 128u + i1); }
        int* ep = eid + (size_t)t * 128 + h * 16; float* gp = gwt + (size_t)t * 128 + h * 16;
#pragma unroll
        for (int r = 0; r < 16; r += 4) { *(int4*)(ep + r) = make_int4(ids[r], ids[r + 1], ids[r + 2], ids[r + 3]); *(f32x4*)(gp + r) = (f32x4){e[r] * inv, e[r + 1] * inv, e[r + 2] * inv, e[r + 3] * inv}; }
    }
}
__device__ __forceinline__ int bitrev4(int x) { return ((x & 1) << 3) | ((x & 2) << 1) | ((x & 4) >> 1) | ((x & 8) >> 3); }
__device__ __forceinline__ f32x2 fp8lo(unsigned w) { return __builtin_amdgcn_cvt_pk_f32_fp8((int)w, false); }
__device__ __forceinline__ f32x2 fp8hi(unsigned w) { return __builtin_amdgcn_cvt_pk_f32_fp8((int)w, true); }
__device__ __forceinline__ void gather_phase(Frame& F, const float* xf, const int* eid, const float* gwt, const float* g, const float* bb, float* outf) {
    const unsigned char* Ub = F.ws + WS_UB; const unsigned char* Vb = F.ws + WS_VB;
    const int lane = F.lane, l15 = lane & 15, fl = bitrev4(l15);
    const bool b0 = lane & 1, b1 = lane & 2, b2 = lane & 4, b3 = lane & 8;
    for (int t = F.gw; t < T; t += F.NGW) {
        f32x2 xs[8], acc[8]; f32x4 xr[4];
#pragma unroll
        for (int j = 0; j < 4; ++j) { xr[j] = *(const f32x4*)(xf + (size_t)t * D + 16 * lane + 4 * j); xs[2 * j] = (f32x2){xr[j].x, xr[j].y} * (1.f / U_SCALE); xs[2 * j + 1] = (f32x2){xr[j].z, xr[j].w} * (1.f / U_SCALE); }
#pragma unroll
        for (int i = 0; i < 8; ++i) acc[i] = (f32x2){0.f, 0.f};
        for (int grp = 0; grp < 8; ++grp) {
            const int e_nat = eid[(size_t)t * 128 + grp * 16 + l15];
            const float g_perm = gwt[(size_t)t * 128 + grp * 16 + fl];
            float p[16];
            { u32x4 ra[16];
#pragma unroll
              for (int kk = 0; kk < 16; ++kk) { const int ek = __builtin_amdgcn_readlane(e_nat, kk); ra[kk] = *(const u32x4*)(Ub + (size_t)ek * D + 16 * lane); }
#pragma unroll
              for (int kk = 0; kk < 16; ++kk) { f32x2 d = fp8lo(ra[kk].x) * xs[0]; d += fp8hi(ra[kk].x) * xs[1]; d += fp8lo(ra[kk].y) * xs[2]; d += fp8hi(ra[kk].y) * xs[3];
                  d += fp8lo(ra[kk].z) * xs[4]; d += fp8hi(ra[kk].z) * xs[5]; d += fp8lo(ra[kk].w) * xs[6]; d += fp8hi(ra[kk].w) * xs[7]; p[kk] = d.x + d.y; } }
            float q8[8], q4[4], q2[2];
#pragma unroll
            for (int i = 0; i < 8; ++i) { const float keep = b0 ? p[8 + i] : p[i], send = b0 ? p[i] : p[8 + i]; q8[i] = keep + dpp_f<DPP_QP_1032>(send); }
#pragma unroll
            for (int i = 0; i < 4; ++i) { const float keep = b1 ? q8[4 + i] : q8[i], send = b1 ? q8[i] : q8[4 + i]; q4[i] = keep + dpp_f<DPP_QP_2301>(send); }
#pragma unroll
            for (int i = 0; i < 2; ++i) { const float keep = b2 ? q4[2 + i] : q4[i], send = b2 ? q4[i] : q4[2 + i]; q2[i] = keep + __shfl_xor(send, 4); }
            float act; { const float keep = b3 ? q2[1] : q2[0], send = b3 ? q2[0] : q2[1]; act = keep + __shfl_xor(send, 8); }
            act += __shfl_xor(act, 16); act += __shfl_xor(act, 32);
            const float coef = g_perm * gelu_tanh(act) * (1.f / V_SCALE);
            { u32x4 ra[16];
#pragma unroll
              for (int kk = 0; kk < 16; ++kk) { const int ek = __builtin_amdgcn_readlane(e_nat, kk); ra[kk] = *(const u32x4*)(Vb + (size_t)ek * D + 16 * lane); }
#pragma unroll
              for (int kk = 0; kk < 16; ++kk) { const int srcl = ((kk & 1) << 3) | ((kk & 2) << 1) | ((kk & 4) >> 1) | ((kk & 8) >> 3);
                  const float ck = __builtin_bit_cast(float, __builtin_amdgcn_readlane(__builtin_bit_cast(int, coef), srcl)); const f32x2 c2 = {ck, ck};
                  acc[0] += c2 * fp8lo(ra[kk].x); acc[1] += c2 * fp8hi(ra[kk].x); acc[2] += c2 * fp8lo(ra[kk].y); acc[3] += c2 * fp8hi(ra[kk].y);
                  acc[4] += c2 * fp8lo(ra[kk].z); acc[5] += c2 * fp8hi(ra[kk].z); acc[6] += c2 * fp8lo(ra[kk].w); acc[7] += c2 * fp8hi(ra[kk].w); } }
        }
        float s = 0.f;
#pragma unroll
        for (int j = 0; j < 4; ++j) { acc[2 * j] += (f32x2){xr[j].x, xr[j].y} * ALPHA; acc[2 * j + 1] += (f32x2){xr[j].z, xr[j].w} * ALPHA; s += (acc[2 * j].x + acc[2 * j].y) + (acc[2 * j + 1].x + acc[2 * j + 1].y); }
        const float mean = wave_sum(s) * (1.f / D); float s2 = 0.f;
#pragma unroll
        for (int i = 0; i < 8; ++i) { acc[i] = acc[i] - mean; s2 += acc[i].x * acc[i].x + acc[i].y * acc[i].y; }
        const float rstd = 1.f / sqrtf(wave_sum(s2) * (1.f / D) + LN_EPS);
#pragma unroll
        for (int j = 0; j < 4; ++j) { const int c = 16 * lane + 4 * j; const f32x4 gg = *(const f32x4*)(g + c), b4 = *(const f32x4*)(bb + c);
            *(f32x4*)(outf + (size_t)t * D + c) = (f32x4){acc[2 * j].x * rstd * gg.x + b4.x, acc[2 * j].y * rstd * gg.y + b4.y, acc[2 * j + 1].x * rstd * gg.z + b4.z, acc[2 * j + 1].y * rstd * gg.w + b4.w}; }
    }
}
__device__ __forceinline__ void mix_phase(Frame& F, const float* mix) {
    const float* xf = (const float*)(F.ws + WS_XF); bf16_t* mx = (bf16_t*)(F.ws + WS_MIX);
    const size_t gt = (size_t)F.gw * 64 + F.lane, NGT = (size_t)F.NGW * 64;
    for (size_t i = gt; i < (size_t)T * (D / 8); i += NGT) {
        const int t = (int)(i >> 7), c = (int)(i & 127) * 8, s = t & (S - 1);
        const f32x4 x0 = *(const f32x4*)(xf + (size_t)t * D + c), x1 = *(const f32x4*)(xf + (size_t)t * D + c + 4);
        f32x4 p0 = {0.f, 0.f, 0.f, 0.f}, p1 = p0;
        if (s > 0) { p0 = *(const f32x4*)(xf + (size_t)(t - 1) * D + c); p1 = *(const f32x4*)(xf + (size_t)(t - 1) * D + c + 4); }
        const f32x4 d0 = p0 - x0, d1 = p1 - x1;
#pragma unroll
        for (int m = 0; m < 6; ++m) { const f32x4 m0 = *(const f32x4*)(mix + m * D + c), m1 = *(const f32x4*)(mix + m * D + c + 4); const f32x4 o0 = x0 + d0 * m0, o1 = x1 + d1 * m1;
            u32x4 o; o.x = pk2(o0.x, o0.y); o.y = pk2(o0.z, o0.w); o.z = pk2(o1.x, o1.y); o.w = pk2(o1.z, o1.w);
            *(u32x4*)(mx + (size_t)m * ((size_t)T * D) + (size_t)t * D + c) = o; }
    }
}
typedef float f32x16 __attribute__((ext_vector_type(16)));
constexpr int RWL = 32, RW_NCH = S / RWL;
constexpr int PK_A2 = 0, PK_RT = 4096, PK_MBR = 8192, PK_BH = 10240, PK_N2 = 14336, PK_MKR = 16384, PK_KH = 18432, PK_VT = 22528, PK_GL = 26624, PK_BON = 26880, PK_BYTES = 27648;
constexpr size_t PK_BATCH = (size_t)1024 * PK_BYTES;
__device__ __forceinline__ unsigned char* pack_ptr(unsigned char* ws, float* out, int b, int hc) {
    unsigned char* base = b < 2 ? ws + 34 * MiB + (size_t)b * PK_BATCH : (b == 2 ? ws + 322 * MiB : (b < 6 ? ws + 414 * MiB + (size_t)(b - 3) * PK_BATCH : (unsigned char*)out + (size_t)(b - 6) * PK_BATCH));
    return base + (size_t)hc * PK_BYTES;
}
__device__ __forceinline__ bf16x8 frag_acc(const f32x16& x, const int s) {
    u32x4 w; w.x = cvt_pk_bf16_c(x[8 * s + 0], x[8 * s + 1]); w.y = cvt_pk_bf16_c(x[8 * s + 2], x[8 * s + 3]); w.z = cvt_pk_bf16_c(x[8 * s + 4], x[8 * s + 5]); w.w = cvt_pk_bf16_c(x[8 * s + 6], x[8 * s + 7]);
    return __builtin_bit_cast(bf16x8, w);
}
__device__ __forceinline__ f32x16 mfma32(bf16x8 a, bf16x8 b, f32x16 c) { return __builtin_amdgcn_mfma_f32_32x32x16_bf16(a, b, c, 0, 0, 0); }
__device__ __forceinline__ float wave_sum_fast(float v) { v = sum16(v); v += __shfl_xor(v, 16); v += __shfl_xor(v, 32); return v; }
#define F16ZERO (f32x16){0.f,0.f,0.f,0.f,0.f,0.f,0.f,0.f,0.f,0.f,0.f,0.f,0.f,0.f,0.f,0.f}

__device__ __forceinline__ void rwprep_phase(Frame& F, const Args& args, const int nbatch) {
    const int lane0 = F.lane;
    LAS unsigned char* wl = F.lds + F.wave * 18432;
    const bf16_t* R = (const bf16_t*)(F.ws + WS_R); const bf16_t* Kt_ = (const bf16_t*)(F.ws + WS_K); const bf16_t* Vt_ = (const bf16_t*)(F.ws + WS_V);
    const bf16_t* AA = (const bf16_t*)(F.ws + WS_AA); const float* WD = (const float*)(F.ws + WS_WDEC);
    for (int it = F.gw; it < nbatch * NH * RW_NCH; it += F.NGW) {
        int lane = lane0; asm volatile("" : "+v"(lane));
        const int r = lane & 31, hh = lane >> 5;
        const int b = it / (NH * RW_NCH), hc = it % (NH * RW_NCH), h = hc / RW_NCH, c = hc % RW_NCH, ch = h * 64 + lane;
        unsigned char* pk = pack_ptr(F.ws, F.out, b, hc);
        const float kkc = args.in[22][ch], kac = args.in[23][ch], rkc = args.in[24][ch];
        const size_t tok0 = (size_t)b * S + (size_t)c * RWL;
        const int posj = 16 * (lane >> 4) + ((lane & 3) | ((lane & 4) << 1) | ((lane & 8) >> 1));
        float gam = 1.f, bon = 0.f;
#pragma unroll 1
        for (int blk = 0; blk < 2; ++blk) {
            unsigned short rr[16], kr[16], ar[16]; float wv[16];
#pragma unroll
            for (int q = 0; q < 16; ++q) { const size_t off = (tok0 + 16 * blk + q) * D + ch; rr[q] = R[off]; kr[q] = Kt_[off]; ar[q] = AA[off]; wv[q] = WD[off]; }
#pragma unroll
            for (int q = 0; q < 16; ++q) { const int t = 16 * blk + q;
                const float rv = __builtin_bit_cast(float, (unsigned)rr[q] << 16), kv = __builtin_bit_cast(float, (unsigned)kr[q] << 16), al = __builtin_bit_cast(float, (unsigned)ar[q] << 16), w = wv[q];
                const float kkr = kv * kkc; const float ss = wave_sum_fast(kkr * kkr); const float kk = kkr / fmaxf(sqrtf(ss), 1e-12f);
                const float km = kv * (1.f + (al - 1.f) * kac);
                const float bs = wave_sum_fast(rv * km * rkc); bon = (lane == t) ? bs : bon;
                const float at = gam * (-kk); gam *= w; const float inv = 1.f / gam;
                const float bt = kk * al * inv, ktv = km * inv, rt = gam * rv;
                *(LAS bf16_t*)(wl + 0 + t * 144 + lane * 2) = (bf16_t)f2bf(at); *(LAS bf16_t*)(wl + 4608 + t * 144 + lane * 2) = (bf16_t)f2bf(bt);
                *(LAS bf16_t*)(wl + 9216 + t * 144 + lane * 2) = (bf16_t)f2bf(ktv); *(LAS bf16_t*)(wl + 13824 + t * 144 + lane * 2) = (bf16_t)f2bf(rt);
                *(bf16_t*)(pk + PK_RT + t * 128 + posj * 2) = (bf16_t)f2bf(rt);
            }
        }
        const float gamL = gam;
        *(float*)(pk + PK_GL + lane * 4) = gamL; if (lane < 32) *(float*)(pk + PK_BON + lane * 4) = bon;
#pragma unroll
        for (int m = 0; m < 4; ++m) { unsigned short e[8];
#pragma unroll
            for (int q = 0; q < 8; ++q) e[q] = Vt_[(tok0 + 8 * m + q) * D + ch];
            u32x4 o; o.x = e[0] | ((unsigned)e[1] << 16); o.y = e[2] | ((unsigned)e[3] << 16); o.z = e[4] | ((unsigned)e[5] << 16); o.w = e[6] | ((unsigned)e[7] << 16);
            *(u32x4*)(pk + PK_VT + lane * 64 + m * 16) = o; }
        LDS_WAIT(); asm volatile("" ::: "memory");
        bf16x8 idf[2];
#pragma unroll
        for (int s = 0; s < 2; ++s) { unsigned e[8];
#pragma unroll
            for (int j = 0; j < 8; ++j) e[j] = (r == 16 * s + 8 * hh + j) ? 0x3F80u : 0u;
            u32x4 w; w.x = e[0] | (e[1] << 16); w.y = e[2] | (e[3] << 16); w.z = e[4] | (e[5] << 16); w.w = e[6] | (e[7] << 16); idf[s] = __builtin_bit_cast(bf16x8, w); }
        bf16x8 xaf[2][2];
#pragma unroll
        for (int kt = 0; kt < 2; ++kt) {
            const int fo = r * 144 + (2 * kt) * 32 + hh * 16;
            f32x16 xb = F16ZERO, xk = F16ZERO, xa = F16ZERO;
            xb = mfma32(*(const LAS bf16x8*)(wl + 4608 + fo), idf[0], xb); xb = mfma32(*(const LAS bf16x8*)(wl + 4608 + fo + 32), idf[1], xb);
            xk = mfma32(*(const LAS bf16x8*)(wl + 9216 + fo), idf[0], xk); xk = mfma32(*(const LAS bf16x8*)(wl + 9216 + fo + 32), idf[1], xk);
            xa = mfma32(*(const LAS bf16x8*)(wl + 0 + fo), idf[0], xa); xa = mfma32(*(const LAS bf16x8*)(wl + 0 + fo + 32), idf[1], xa);
            xaf[kt][0] = frag_acc(xa, 0); xaf[kt][1] = frag_acc(xa, 1);
            const float gl = __shfl(gamL, 32 * kt + r);
#pragma unroll
            for (int g = 0; g < 4; ++g) {
                u32x2 w1; w1.x = pk2(xb[4 * g] * gl, xb[4 * g + 1] * gl); w1.y = pk2(xb[4 * g + 2] * gl, xb[4 * g + 3] * gl);
                *(u32x2*)(pk + PK_BH + (32 * kt + r) * 64 + 2 * (16 * (g >> 1) + 8 * hh + 4 * (g & 1))) = w1;
                u32x2 w2; w2.x = pk2(xk[4 * g] * gl, xk[4 * g + 1] * gl); w2.y = pk2(xk[4 * g + 2] * gl, xk[4 * g + 3] * gl);
                *(u32x2*)(pk + PK_KH + (32 * kt + r) * 64 + 2 * (8 * g + 4 * hh)) = w2; }
        }
        f32x16 pBA = F16ZERO, pBR = F16ZERO, pKR = F16ZERO, qAK = F16ZERO;
#pragma unroll
        for (int ks = 0; ks < 4; ++ks) {
            const int fo = r * 144 + ks * 32 + hh * 16;
            const bf16x8 fA = *(const LAS bf16x8*)(wl + 0 + fo), fB = *(const LAS bf16x8*)(wl + 4608 + fo), fK = *(const LAS bf16x8*)(wl + 9216 + fo), fR = *(const LAS bf16x8*)(wl + 13824 + fo);
            pBA = mfma32(fB, fA, pBA);
            pBR = mfma32(fB, fR, pBR);
            pKR = mfma32(fK, fR, pKR);
            qAK = mfma32(fA, fK, qAK);
        }
        LDS_WAIT(); asm volatile("" ::: "memory");
#pragma unroll
        for (int g = 0; g < 4; ++g) {
            float mb[4], mkv[4];
#pragma unroll
            for (int d = 0; d < 4; ++d) { const int reg = 4 * g + d, row = d + 8 * g + 4 * hh;
                *(LAS float*)(wl + 13824 + row * 144 + r * 4) = (row < r) ? pBA[reg] : 0.f;
                mb[d] = (row <= r) ? pBR[reg] : 0.f; mkv[d] = (row <= r) ? pKR[reg] : 0.f;
                qAK[reg] = (r < row) ? qAK[reg] : 0.f; }
            u32x2 w1; w1.x = pk2(mb[0], mb[1]); w1.y = pk2(mb[2], mb[3]); *(u32x2*)(pk + PK_MBR + r * 64 + 2 * (16 * (g >> 1) + 8 * hh + 4 * (g & 1))) = w1;
            u32x2 w2; w2.x = pk2(mkv[0], mkv[1]); w2.y = pk2(mkv[2], mkv[3]); *(u32x2*)(pk + PK_MKR + r * 64 + 2 * (8 * g + 4 * hh)) = w2;
        }
        *(LAS bf16x8*)(wl + lane * 96) = frag_acc(qAK, 0); *(LAS bf16x8*)(wl + lane * 96 + 16) = frag_acc(qAK, 1);
        *(LAS bf16x8*)(wl + lane * 96 + 32) = xaf[0][0]; *(LAS bf16x8*)(wl + lane * 96 + 48) = xaf[0][1]; *(LAS bf16x8*)(wl + lane * 96 + 64) = xaf[1][0]; *(LAS bf16x8*)(wl + lane * 96 + 80) = xaf[1][1];
        LDS_WAIT(); asm volatile("" ::: "memory");
        float tt[32]; int lmo = 13824;
#pragma unroll
        for (int cc = 31; cc >= 0; --cc) { float acc = (r == cc) ? 1.f : 0.f;
            if (cc < 31 && (cc & 1)) asm volatile("" : "+v"(lmo) : "v"(tt[cc + 1]));
#pragma unroll
            for (int q4 = 0; q4 < 8; ++q4) { if (4 * q4 + 3 > cc) { const f32x4 lm = *(const LAS f32x4*)(wl + lmo + cc * 144 + q4 * 16);
#pragma unroll
                for (int d = 0; d < 4; ++d) { const int i = 4 * q4 + d; if (i > cc) acc += tt[i] * lm[d]; } } }
            tt[cc] = acc; }
        f32x16 a2t0 = F16ZERO, a2t1 = F16ZERO, n2t = F16ZERO;
#pragma unroll
        for (int s = 0; s < 2; ++s) {
            float p[8];
#pragma unroll
            for (int j = 0; j < 8; ++j) p[j] = hh ? tt[16 * s + 8 * (j >> 2) + 4 + (j & 3)] : tt[16 * s + 8 * (j >> 2) + (j & 3)];
            u32x4 wp; wp.x = pk2(p[0], p[1]); wp.y = pk2(p[2], p[3]); wp.z = pk2(p[4], p[5]); wp.w = pk2(p[6], p[7]);
            const bf16x8 fTp = __builtin_bit_cast(bf16x8, wp);
            a2t0 = mfma32(*(const LAS bf16x8*)(wl + lane * 96 + 32 + 16 * s), fTp, a2t0); a2t1 = mfma32(*(const LAS bf16x8*)(wl + lane * 96 + 64 + 16 * s), fTp, a2t1);
            n2t = mfma32(*(const LAS bf16x8*)(wl + lane * 96 + 16 * s), fTp, n2t);
        }
#pragma unroll
        for (int g = 0; g < 4; ++g) {
            u32x2 w0; w0.x = pk2(a2t0[4 * g], a2t0[4 * g + 1]); w0.y = pk2(a2t0[4 * g + 2], a2t0[4 * g + 3]);
            u32x2 w1; w1.x = pk2(a2t1[4 * g], a2t1[4 * g + 1]); w1.y = pk2(a2t1[4 * g + 2], a2t1[4 * g + 3]);
            *(u32x2*)(pk + PK_A2 + r * 128 + 2 * (16 * (0 + (g >> 1)) + 8 * hh + 4 * (g & 1))) = w0;
            *(u32x2*)(pk + PK_A2 + r * 128 + 2 * (16 * (2 + (g >> 1)) + 8 * hh + 4 * (g & 1))) = w1;
            u32x2 w2; w2.x = pk2(n2t[4 * g], n2t[4 * g + 1]); w2.y = pk2(n2t[4 * g + 2], n2t[4 * g + 3]);
            *(u32x2*)(pk + PK_N2 + r * 64 + 2 * (8 * g + 4 * hh)) = w2;
        }
        LDS_WAIT(); asm volatile("" ::: "memory");
    }
}

constexpr int SC_OBUF = 4 * PK_BYTES, SC_BON = SC_OBUF + 2 * 8192;
__device__ __forceinline__ void rwscan2_phase(Frame& F, const Args& args, bf16_t* OG, const int nbatch) {
    const int bx = F.bx; if (bx >= nbatch * NH) return;
    const int b = bx >> 4, h = bx & 15, lane = F.lane, r = lane & 31, hh = lane >> 5, wave = F.wave;
    const bf16_t* Vt_ = (const bf16_t*)(F.ws + WS_V); const bf16_t* G = (const bf16_t*)(F.ws + WS_G);
    const unsigned char* pk0 = pack_ptr(F.ws, F.out, b, h * RW_NCH);
    LAS unsigned char* lds = F.lds;
    const int dp0 = wave == 6 ? 0 : 14, dpn = wave == 6 ? 14 : 13;
#define SC_DMA(chunk) do { const unsigned char* src_ = pk0 + (size_t)(chunk) * PK_BYTES + lane * 16; LAS unsigned char* dst_ = lds + ((chunk) & 3) * PK_BYTES; \
        _Pragma("unroll") for (int p_ = 0; p_ < 14; ++p_) if (p_ < dpn) __builtin_amdgcn_global_load_lds((const unsigned*)(src_ + (dp0 + p_) * 1024), (LAS unsigned*)(dst_ + (dp0 + p_) * 1024), 16, 0, 0); } while (0)
#define SC_WAIT(k) do { if (wave == 6) { if ((k) == 2) asm volatile("s_waitcnt vmcnt(28)" ::: "memory"); else if ((k) == 1) asm volatile("s_waitcnt vmcnt(14)" ::: "memory"); else asm volatile("s_waitcnt vmcnt(0)" ::: "memory"); } \
        else { if ((k) == 2) asm volatile("s_waitcnt vmcnt(26)" ::: "memory"); else if ((k) == 1) asm volatile("s_waitcnt vmcnt(13)" ::: "memory"); else asm volatile("s_waitcnt vmcnt(0)" ::: "memory"); } } while (0)
    f32x16 Z0 = F16ZERO, Z1 = F16ZERO;
    if (wave >= 6) { SC_DMA(0); SC_DMA(1); SC_DMA(2); SC_WAIT(2); }
    asm volatile("" ::: "memory"); __builtin_amdgcn_s_barrier(); asm volatile("" ::: "memory");
    for (int c = 0; c <= RW_NCH; ++c) {
        if (wave >= 6) {
            if (c + 3 < RW_NCH) { SC_DMA(c + 3); SC_WAIT(2); } else if (c + 2 < RW_NCH) { SC_WAIT(1); } else { SC_WAIT(0); }
        } else if (wave < 2) {
            if (c < RW_NCH) {
                const LAS unsigned char* sl = lds + (c & 3) * PK_BYTES; const int vh = wave;
                const bf16x8 zb0 = frag_acc(Z0, 0), zb1 = frag_acc(Z0, 1), zb2 = frag_acc(Z1, 0), zb3 = frag_acc(Z1, 1);
                const bf16x8 vt0 = *(const LAS bf16x8*)(sl + PK_VT + (32 * vh + r) * 64 + hh * 16), vt1 = *(const LAS bf16x8*)(sl + PK_VT + (32 * vh + r) * 64 + 32 + hh * 16);
                f32x16 U = F16ZERO, O = F16ZERO;
                { const LAS unsigned char* pa = sl + PK_A2 + r * 128 + hh * 16; const LAS unsigned char* pr = sl + PK_RT + r * 128 + hh * 16;
                  U = mfma32(*(const LAS bf16x8*)(pa), zb0, U); U = mfma32(*(const LAS bf16x8*)(pa + 32), zb1, U); U = mfma32(*(const LAS bf16x8*)(pa + 64), zb2, U); U = mfma32(*(const LAS bf16x8*)(pa + 96), zb3, U);
                  const LAS unsigned char* pn = sl + PK_N2 + r * 64 + hh * 16; U = mfma32(*(const LAS bf16x8*)(pn), vt0, U); U = mfma32(*(const LAS bf16x8*)(pn + 32), vt1, U);
                  O = mfma32(*(const LAS bf16x8*)(pr), zb0, O); O = mfma32(*(const LAS bf16x8*)(pr + 32), zb1, O); O = mfma32(*(const LAS bf16x8*)(pr + 64), zb2, O); O = mfma32(*(const LAS bf16x8*)(pr + 96), zb3, O);
                  const LAS unsigned char* pm = sl + PK_MKR + r * 64 + hh * 16; O = mfma32(*(const LAS bf16x8*)(pm), vt0, O); O = mfma32(*(const LAS bf16x8*)(pm + 32), vt1, O); }
                const bf16x8 ub0 = frag_acc(U, 0), ub1 = frag_acc(U, 1);
                { const LAS unsigned char* pb = sl + PK_MBR + r * 64 + hh * 16; O = mfma32(*(const LAS bf16x8*)(pb), ub0, O); O = mfma32(*(const LAS bf16x8*)(pb + 32), ub1, O); }
#pragma unroll
                for (int g = 0; g < 4; ++g) { const f32x4 g0 = *(const LAS f32x4*)(sl + PK_GL + 4 * (8 * g + 4 * hh)), g1 = *(const LAS f32x4*)(sl + PK_GL + 4 * (32 + 8 * g + 4 * hh));
#pragma unroll
                    for (int d = 0; d < 4; ++d) { Z0[4 * g + d] *= g0[d]; Z1[4 * g + d] *= g1[d]; } }
                { const LAS unsigned char* pb = sl + PK_BH + r * 64 + hh * 16; const LAS unsigned char* pkk = sl + PK_KH + r * 64 + hh * 16;
                  Z0 = mfma32(*(const LAS bf16x8*)(pb), ub0, Z0); Z0 = mfma32(*(const LAS bf16x8*)(pb + 32), ub1, Z0); Z0 = mfma32(*(const LAS bf16x8*)(pkk), vt0, Z0); Z0 = mfma32(*(const LAS bf16x8*)(pkk + 32), vt1, Z0);
                  Z1 = mfma32(*(const LAS bf16x8*)(pb + 2048), ub0, Z1); Z1 = mfma32(*(const LAS bf16x8*)(pb + 2048 + 32), ub1, Z1); Z1 = mfma32(*(const LAS bf16x8*)(pkk + 2048), vt0, Z1); Z1 = mfma32(*(const LAS bf16x8*)(pkk + 2048 + 32), vt1, Z1); }
                LAS float* ob = (LAS float*)(lds + SC_OBUF + (c & 1) * 8192);
#pragma unroll
                for (int reg = 0; reg < 16; ++reg) ob[((reg & 3) + 8 * (reg >> 2) + 4 * hh) * 64 + 32 * vh + r] = O[reg];
                if (vh == 0 && lane < 32) ((LAS float*)(lds + SC_BON))[(c & 1) * 32 + lane] = *(const LAS float*)(sl + PK_BON + lane * 4);
            }
        } else if (c >= 1) {
            const LAS float* ob = (const LAS float*)(lds + SC_OBUF + ((c - 1) & 1) * 8192); const LAS float* bn = (const LAS float*)(lds + SC_BON) + ((c - 1) & 1) * 32;
            for (int u = (wave - 2) * 64 + lane; u < 512; u += 256) {
                const int t = u >> 4, q = u & 15, c4 = h * 64 + 4 * q; const size_t off = ((size_t)b * S + (size_t)(c - 1) * RWL + t) * D + c4;
                const f32x4 o4 = *(const LAS f32x4*)(ob + t * 64 + 4 * q); const float bs = bn[t];
                const u32x2 vw = *(const u32x2*)(Vt_ + off), gw_ = *(const u32x2*)(G + off); const f32x4 lg4 = *(const f32x4*)(args.in[25] + c4), lb4 = *(const f32x4*)(args.in[26] + c4);
                float sm = (o4.x + o4.y) + (o4.z + o4.w); sm = sum16(sm); const float mu = sm * (1.f / 64.f); const f32x4 dd = o4 - mu;
                float vs = (dd.x * dd.x + dd.y * dd.y) + (dd.z * dd.z + dd.w * dd.w); vs = sum16(vs); const float rs = 1.f / sqrtf(vs * (1.f / 64.f) + 64e-5f);
                const f32x4 v4 = {bf_lo(vw.x), bf_hi(vw.x), bf_lo(vw.y), bf_hi(vw.y)}, g4 = {bf_lo(gw_.x), bf_hi(gw_.x), bf_lo(gw_.y), bf_hi(gw_.y)};
                const f32x4 res = (dd * rs * lg4 + lb4 + v4 * bs) * g4;
                u32x2 w; w.x = pk2(res.x, res.y); w.y = pk2(res.z, res.w); *(u32x2*)(OG + off) = w;
            }
        }
        asm volatile("s_waitcnt lgkmcnt(0)" ::: "memory");
        __builtin_amdgcn_s_barrier();
        asm volatile("" ::: "memory");
    }
#undef SC_DMA
#undef SC_WAIT
}
}
namespace mk {
constexpr int NPH = 21;
#ifndef MK_NBATCH
#define MK_NBATCH 8
#endif
#ifndef MK_PER_PHASE
#define MK_PER_PHASE 0
#endif
#ifndef MK_MASK
#define MK_MASK 0x1FFFFF
#endif
__global__ void __launch_bounds__(NTHREADS, 2) mk_fwd(Args args) {
    extern __shared__ __attribute__((aligned(16))) unsigned char lds_raw[];
    { volatile LAS unsigned* M0 = (volatile LAS unsigned*)((LAS unsigned char*)lds_raw + MISC_OFF); if (threadIdx.x < 64) M0[threadIdx.x] = 0u; }
    __syncthreads();
    const int lo = args.ph_lo, hi = args.ph_hi;
    const int wave0 = __builtin_amdgcn_readfirstlane((int)threadIdx.x >> 6);
    if (hi - lo > 1) (void)xcd_barrier_post((unsigned*)(args.ws + WS_CTL) + CW_BAR, (volatile LAS unsigned*)((LAS unsigned char*)lds_raw + MISC_OFF) + 8);
#define MKFRAME() \
        int lane_ = lane_id(), bx_ = blockIdx.x; asm volatile("" : "+v"(lane_)); asm volatile("" : "+s"(bx_)); \
        Frame F; F.lds = (LAS unsigned char*)lds_raw; F.MISC = (volatile LAS unsigned*)(F.lds + MISC_OFF); \
        F.lane = lane_; F.wave = wave0; F.tid = wave0 * 64 + lane_; F.bx = bx_; \
        F.G = gridDim.x; F.vcu = (F.G % 8 == 0) ? (bx_ % 8) * (F.G / 8) + bx_ / 8 : bx_; \
        F.gw = F.vcu * NWAVES + F.wave; F.NGW = F.G * NWAVES; \
        F.ws = args.ws; F.ctl = (unsigned*)(args.ws + WS_CTL); F.out = args.out; unsigned char* ws = F.ws; (void)ws;
#define INP(k) (args.in[k])
#define IN(k) (((MK_MASK >> (k)) & 1) && lo <= (k) && (k) < hi)
#ifndef MK_REP
#define MK_REP 0
#endif
#ifndef MK_NREP
#define MK_NREP 2
#endif
#define FORCE_BAR() do { XcdBarrier bar; bar.bar = (unsigned*)(args.ws + WS_CTL) + CW_BAR; bar.x = xb_xcc_id(); bar.st = (volatile LAS unsigned*)((LAS unsigned char*)lds_raw + MISC_OFF) + 8; xcd_barrier(bar, wave0 == 0 && lane_id() == 0); } while (0)
#define SEAM(k) do { if (lo <= (k) && (k) + 1 < hi) { XcdBarrier bar; bar.bar = (unsigned*)(args.ws + WS_CTL) + CW_BAR; bar.x = xb_xcc_id(); bar.st = (volatile LAS unsigned*)((LAS unsigned char*)lds_raw + MISC_OFF) + 8; xcd_barrier(bar, wave0 == 0 && lane_id() == 0); } } while (0)
    if (IN(0)) { MKFRAME() asm volatile("; PHASE_BEGIN 0"); p0_prologue(F, args); }
    SEAM(0);
    if (((MK_REP >> 0) & 1) && IN(0)) { for (int rep_ = 0; rep_ < MK_NREP; ++rep_) { { MKFRAME() p0_prologue(F, args); } FORCE_BAR(); } }
    if (IN(1)) { MKFRAME() asm volatile("; PHASE_BEGIN 1"); { ProbPlain P{(const char*)(ws + WS_X0B), (const char*)(ws + WS_WIN), (size_t)256 * D * 2, (size_t)256 * D * 2}; EpiWin E{(bf16_t*)(ws + WS_GATE), (bf16_t*)(ws + WS_H2)};
            run_gemm(F, 64, 11, D, D, D, P, E); } }
    SEAM(1);
    if (((MK_REP >> 1) & 1) && IN(1)) { for (int rep_ = 0; rep_ < MK_NREP; ++rep_) { { MKFRAME() { ProbPlain P{(const char*)(ws + WS_X0B), (const char*)(ws + WS_WIN), (size_t)256 * D * 2, (size_t)256 * D * 2}; EpiWin E{(bf16_t*)(ws + WS_GATE), (bf16_t*)(ws + WS_H2)};
            run_gemm(F, 64, 11, D, D, D, P, E); } } FORCE_BAR(); } }
    if (IN(2)) { MKFRAME() asm volatile("; PHASE_BEGIN 2"); conv_phase(F, INP(2), INP(3)); }
    SEAM(2);
    if (((MK_REP >> 2) & 1) && IN(2)) { for (int rep_ = 0; rep_ < MK_NREP; ++rep_) { { MKFRAME() conv_phase(F, INP(2), INP(3)); } FORCE_BAR(); } }
    if (IN(3)) { MKFRAME() asm volatile("; PHASE_BEGIN 3"); { ProbGates P{(const char*)(ws + WS_XC), (const char*)(ws + WS_WG)}; EpiGates E{(const bf16_t*)(ws + WS_XC), (const float*)(ws + WS_VEC), INP(5), INP(7), (float*)(ws + WS_A), (float*)(ws + WS_U)};
            run_gemm(F, 64, 11, W, 384, 384, P, E); } }
    SEAM(3);
    if (((MK_REP >> 3) & 1) && IN(3)) { for (int rep_ = 0; rep_ < MK_NREP; ++rep_) { { MKFRAME() { ProbGates P{(const char*)(ws + WS_XC), (const char*)(ws + WS_WG)}; EpiGates E{(const bf16_t*)(ws + WS_XC), (const float*)(ws + WS_VEC), INP(5), INP(7), (float*)(ws + WS_A), (float*)(ws + WS_U)};
            run_gemm(F, 64, 11, W, 384, 384, P, E); } } FORCE_BAR(); } }
    if (IN(4)) { MKFRAME() asm volatile("; PHASE_BEGIN 4"); rgscan1_phase(F); }
    SEAM(4);
    if (((MK_REP >> 4) & 1) && IN(4)) { for (int rep_ = 0; rep_ < MK_NREP; ++rep_) { { MKFRAME() rgscan1_phase(F); } FORCE_BAR(); } }
    if (IN(5)) { MKFRAME() asm volatile("; PHASE_BEGIN 5"); rgscan2_phase(F); }
    SEAM(5);
    if (((MK_REP >> 5) & 1) && IN(5)) { for (int rep_ = 0; rep_ < MK_NREP; ++rep_) { { MKFRAME() rgscan2_phase(F); } FORCE_BAR(); } }
    if (IN(6)) { MKFRAME() asm volatile("; PHASE_BEGIN 6"); { ProbPlain P{(const char*)(ws + WS_Y), (const char*)(ws + WS_WOUT), (size_t)256 * W * 2, (size_t)256 * W * 2}; EpiRes E{INP(0), (float*)(ws + WS_Z0)};
            run_gemm(F, 64, 4, W, W, W, P, E); } }
    SEAM(6);
    if (((MK_REP >> 6) & 1) && IN(6)) { for (int rep_ = 0; rep_ < MK_NREP; ++rep_) { { MKFRAME() { ProbPlain P{(const char*)(ws + WS_Y), (const char*)(ws + WS_WOUT), (size_t)256 * W * 2, (size_t)256 * W * 2}; EpiRes E{INP(0), (float*)(ws + WS_Z0)};
            run_gemm(F, 64, 4, W, W, W, P, E); } } FORCE_BAR(); } }
    if (IN(7)) { MKFRAME() asm volatile("; PHASE_BEGIN 7"); ln_phase(F, (const float*)(ws + WS_Z0), INP(32), INP(33), (float*)(ws + WS_XF), (bf16_t*)(ws + WS_XB0)); }
    SEAM(7);
    if (((MK_REP >> 7) & 1) && IN(7)) { for (int rep_ = 0; rep_ < MK_NREP; ++rep_) { { MKFRAME() ln_phase(F, (const float*)(ws + WS_Z0), INP(32), INP(33), (float*)(ws + WS_XF), (bf16_t*)(ws + WS_XB0)); } FORCE_BAR(); } }
    if (IN(8)) { MKFRAME() asm volatile("; PHASE_BEGIN 8"); { ProbPlain P{(const char*)(ws + WS_XB0), (const char*)(ws + WS_WPEER), (size_t)256 * D * 2, (size_t)256 * D * 2}; EpiScores E{(float*)(ws + WS_SC0)};
            run_gemm(F, 64, 8, D, D, D, P, E); } }
    SEAM(8);
    if (((MK_REP >> 8) & 1) && IN(8)) { for (int rep_ = 0; rep_ < MK_NREP; ++rep_) { { MKFRAME() { ProbPlain P{(const char*)(ws + WS_XB0), (const char*)(ws + WS_WPEER), (size_t)256 * D * 2, (size_t)256 * D * 2}; EpiScores E{(float*)(ws + WS_SC0)};
            run_gemm(F, 64, 8, D, D, D, P, E); } } FORCE_BAR(); } }
    if (IN(9)) { MKFRAME() asm volatile("; PHASE_BEGIN 9"); topk_phase(F, (const float*)(ws + WS_SC0), (int*)(ws + WS_EID0), (float*)(ws + WS_GW0)); }
    SEAM(9);
    if (((MK_REP >> 9) & 1) && IN(9)) { for (int rep_ = 0; rep_ < MK_NREP; ++rep_) { { MKFRAME() topk_phase(F, (const float*)(ws + WS_SC0), (int*)(ws + WS_EID0), (float*)(ws + WS_GW0)); } FORCE_BAR(); } }
    if (IN(10)) { MKFRAME() asm volatile("; PHASE_BEGIN 10"); gather_phase(F, (const float*)(ws + WS_XF), (const int*)(ws + WS_EID0), (const float*)(ws + WS_GW0), INP(32) + D, INP(33) + D, (float*)(ws + WS_XF)); }
    SEAM(10);
    if (((MK_REP >> 10) & 1) && IN(10)) { for (int rep_ = 0; rep_ < MK_NREP; ++rep_) { { MKFRAME() gather_phase(F, (const float*)(ws + WS_XF), (const int*)(ws + WS_EID0), (const float*)(ws + WS_GW0), INP(32) + D, INP(33) + D, (float*)(ws + WS_DBG)); } FORCE_BAR(); } }
    if (IN(11)) { MKFRAME() asm volatile("; PHASE_BEGIN 11"); mix_phase(F, INP(10)); }
    SEAM(11);
    if (((MK_REP >> 11) & 1) && IN(11)) { for (int rep_ = 0; rep_ < MK_NREP; ++rep_) { { MKFRAME() mix_phase(F, INP(10)); } FORCE_BAR(); } }
    if (IN(12)) { MKFRAME() asm volatile("; PHASE_BEGIN 12"); { ProbRkv P{(const char*)(ws + WS_MIX), (const char*)(ws + WS_WRKV)}; EpiRkv E{(bf16_t*)(ws + WS_R), (bf16_t*)(ws + WS_LORA)};
            run_gemm(F, 64, 15, D, D, D, P, E); } }
    SEAM(12);
    if (((MK_REP >> 12) & 1) && IN(12)) { for (int rep_ = 0; rep_ < MK_NREP; ++rep_) { { MKFRAME() { ProbRkv P{(const char*)(ws + WS_MIX), (const char*)(ws + WS_WRKV)}; EpiRkv E{(bf16_t*)(ws + WS_R), (bf16_t*)(ws + WS_LORA)};
            run_gemm(F, 64, 15, D, D, D, P, E); } } FORCE_BAR(); } }
    if (IN(13)) { MKFRAME() asm volatile("; PHASE_BEGIN 13"); { ProbPlain P{(const char*)(ws + WS_LORA), (const char*)(ws + WS_WL2), (size_t)256 * 256 * 2, (size_t)256 * 256 * 2}; EpiLora2 E{(float*)(ws + WS_WDEC), (bf16_t*)(ws + WS_AA), INP(14), INP(17)};
            static_assert(WS_G == WS_AA + (size_t)T * D * 2, "g follows aa");
            run_gemm(F, 64, 12, 256, 256, 256, P, E); } }
    SEAM(13);
    if (((MK_REP >> 13) & 1) && IN(13)) { for (int rep_ = 0; rep_ < MK_NREP; ++rep_) { { MKFRAME() { ProbPlain P{(const char*)(ws + WS_LORA), (const char*)(ws + WS_WL2), (size_t)256 * 256 * 2, (size_t)256 * 256 * 2}; EpiLora2 E{(float*)(ws + WS_WDEC), (bf16_t*)(ws + WS_AA), INP(14), INP(17)};
            static_assert(WS_G == WS_AA + (size_t)T * D * 2, "g follows aa");
            run_gemm(F, 64, 12, 256, 256, 256, P, E); } } FORCE_BAR(); } }
    if (IN(14)) { MKFRAME() asm volatile("; PHASE_BEGIN 14"); rwprep_phase(F, args, MK_NBATCH); }
    SEAM(14);
    if (((MK_REP >> 14) & 1) && IN(14)) { for (int rep_ = 0; rep_ < MK_NREP; ++rep_) { { MKFRAME() rwprep_phase(F, args, MK_NBATCH); } FORCE_BAR(); } }
    if (IN(15)) { MKFRAME() asm volatile("; PHASE_BEGIN 15"); rwscan2_phase(F, args, (bf16_t*)(ws + WS_OG), MK_NBATCH); }
    SEAM(15);
    if (((MK_REP >> 15) & 1) && IN(15)) { for (int rep_ = 0; rep_ < MK_NREP; ++rep_) { { MKFRAME() rwscan2_phase(F, args, (bf16_t*)(ws + WS_XB1), MK_NBATCH); } FORCE_BAR(); } }
    if (IN(16)) { MKFRAME() asm volatile("; PHASE_BEGIN 16"); { ProbPlain P{(const char*)(ws + WS_OG), (const char*)(ws + WS_WO), (size_t)256 * D * 2, (size_t)256 * D * 2}; EpiRes E{(const float*)(ws + WS_XF), (float*)(ws + WS_Z1)};
            run_gemm(F, 64, 4, D, D, D, P, E); } }
    SEAM(16);
    if (((MK_REP >> 16) & 1) && IN(16)) { for (int rep_ = 0; rep_ < MK_NREP; ++rep_) { { MKFRAME() { ProbPlain P{(const char*)(ws + WS_OG), (const char*)(ws + WS_WO), (size_t)256 * D * 2, (size_t)256 * D * 2}; EpiRes E{(const float*)(ws + WS_XF), (float*)(ws + WS_Z1)};
            run_gemm(F, 64, 4, D, D, D, P, E); } } FORCE_BAR(); } }
    if (IN(17)) { MKFRAME() asm volatile("; PHASE_BEGIN 17"); ln_phase(F, (const float*)(ws + WS_Z1), INP(32) + 2 * D, INP(33) + 2 * D, (float*)(ws + WS_XF), (bf16_t*)(ws + WS_XB1)); { const size_t gt_ = (size_t)F.gw * 64 + F.lane, NGT_ = (size_t)F.NGW * 64; cvt_stream_fp8(INP(30) + (size_t)16384 * D, ws + WS_UB, (size_t)16384 * D / 16, gt_, NGT_, U_SCALE); cvt_stream_fp8(INP(31) + (size_t)16384 * D, ws + WS_VB, (size_t)16384 * D / 16, gt_, NGT_, V_SCALE); } }
    SEAM(17);
    if (((MK_REP >> 17) & 1) && IN(17)) { for (int rep_ = 0; rep_ < MK_NREP; ++rep_) { { MKFRAME() ln_phase(F, (const float*)(ws + WS_Z1), INP(32) + 2 * D, INP(33) + 2 * D, (float*)(ws + WS_XF), (bf16_t*)(ws + WS_XB1)); { const size_t gt_ = (size_t)F.gw * 64 + F.lane, NGT_ = (size_t)F.NGW * 64; cvt_stream_fp8(INP(30) + (size_t)16384 * D, ws + WS_UB, (size_t)16384 * D / 16, gt_, NGT_, U_SCALE); cvt_stream_fp8(INP(31) + (size_t)16384 * D, ws + WS_VB, (size_t)16384 * D / 16, gt_, NGT_, V_SCALE); } } FORCE_BAR(); } }
    if (IN(18)) { MKFRAME() asm volatile("; PHASE_BEGIN 18"); { ProbPlain P{(const char*)(ws + WS_XB1), (const char*)(ws + WS_WPEER + (size_t)2048 * D * 2), (size_t)256 * D * 2, (size_t)256 * D * 2}; EpiScores E{(float*)(ws + WS_SC1)};
            run_gemm(F, 64, 8, D, D, D, P, E); } }
    SEAM(18);
    if (((MK_REP >> 18) & 1) && IN(18)) { for (int rep_ = 0; rep_ < MK_NREP; ++rep_) { { MKFRAME() { ProbPlain P{(const char*)(ws + WS_XB1), (const char*)(ws + WS_WPEER + (size_t)2048 * D * 2), (size_t)256 * D * 2, (size_t)256 * D * 2}; EpiScores E{(float*)(ws + WS_SC1)};
            run_gemm(F, 64, 8, D, D, D, P, E); } } FORCE_BAR(); } }
    if (IN(19)) { MKFRAME() asm volatile("; PHASE_BEGIN 19"); topk_phase(F, (const float*)(ws + WS_SC1), (int*)(ws + WS_EID1), (float*)(ws + WS_GW1)); }
    SEAM(19);
    if (((MK_REP >> 19) & 1) && IN(19)) { for (int rep_ = 0; rep_ < MK_NREP; ++rep_) { { MKFRAME() topk_phase(F, (const float*)(ws + WS_SC1), (int*)(ws + WS_EID1), (float*)(ws + WS_GW1)); } FORCE_BAR(); } }
    if (IN(20)) { MKFRAME() asm volatile("; PHASE_BEGIN 20"); gather_phase(F, (const float*)(ws + WS_XF), (const int*)(ws + WS_EID1), (const float*)(ws + WS_GW1), INP(32) + 3 * D, INP(33) + 3 * D, F.out); }
    SEAM(20);
    if (((MK_REP >> 20) & 1) && IN(20)) { for (int rep_ = 0; rep_ < MK_NREP; ++rep_) { { MKFRAME() gather_phase(F, (const float*)(ws + WS_XF), (const int*)(ws + WS_EID1), (const float*)(ws + WS_GW1), INP(32) + 3 * D, INP(33) + 3 * D, F.out); } FORCE_BAR(); } }
#undef INP
#undef IN
#undef SEAM
#undef FORCE_BAR
#undef MKFRAME
}

static int g_grid = 0;
static inline bool mk_setup() {
    if (g_grid == 0) {
        int dev = 0, cus = 0;
        if (hipGetDevice(&dev) != hipSuccess || hipDeviceGetAttribute(&cus, hipDeviceAttributeMultiprocessorCount, dev) != hipSuccess) { g_grid = -1; return false; }
        if (hipFuncSetAttribute((const void*)mk_fwd, hipFuncAttributeMaxDynamicSharedMemorySize, LDS_BYTES) != hipSuccess) { fprintf(stderr, "hipFuncSetAttribute failed\n"); g_grid = -1; return false; }
        (void)hipGetLastError();
        g_grid = cus;
        if (g_grid != 256) fprintf(stderr, "warning: %d CUs (kernel assumes >= 128 workgroups)\n", g_grid);
    }
    return g_grid > 0;
}
static inline void mk_launch(hipStream_t stream, void* const* d_in, void* d_out, void* d_ws, int lo, int hi) {
    Args a{};
    for (int i = 0; i < 34; ++i) a.in[i] = (const float*)d_in[i];
    a.out = (float*)d_out; a.ws = (unsigned char*)d_ws; a.ph_lo = lo; a.ph_hi = hi;
    hipLaunchKernelGGL(mk_fwd, dim3(g_grid), dim3(NTHREADS), LDS_BYTES, stream, a);
}
}
extern "C" void kernel_launch(void* const* d_in, const int* in_sizes, int n_in, void* d_out, int out_size, void* d_ws, size_t ws_size, hipStream_t stream) {
    (void)in_sizes; (void)n_in; (void)out_size;
    if (!mk::mk_setup()) return;
    if (ws_size < mk::WS_END) { fprintf(stderr, "workspace too small: %zu\n", ws_size); return; }
    (void)hipMemsetAsync((char*)d_ws + mk::WS_CTL, 0, mk::CTL_ZERO_BYTES, stream);
#if MK_PER_PHASE
    for (int p = 0; p < mk::NPH; ++p) mk::mk_launch(stream, d_in, d_out, d_ws, p, p + 1);
#else
    mk::mk_launch(stream, d_in, d_out, d_ws, 0, mk::NPH);
#endif
}
```

```cpp
#include <hip/hip_runtime.h>
#include <cstdio>
#include <cstdint>

#define LAS __attribute__((address_space(3)))
#define GAS __attribute__((address_space(1)))
typedef unsigned short bf16_t;
typedef short bf16x8 __attribute__((ext_vector_type(8)));
typedef float f32x4 __attribute__((ext_vector_type(4)));
typedef float f32x2 __attribute__((ext_vector_type(2)));
typedef unsigned u32x4 __attribute__((ext_vector_type(4)));
typedef unsigned u32x2 __attribute__((ext_vector_type(2)));
typedef __bf16 bf16x2_t __attribute__((ext_vector_type(2)));

namespace mk {
constexpr int D = 1024, NB = 8, S = 2048, T = NB * S, W = 1408, NH = 16, HB = 88;
constexpr float ALPHA = 1.41421356237f, LN_EPS = 1e-5f;
constexpr int NWAVES = 8, NTHREADS = 512;

__device__ __forceinline__ unsigned f2bf(float f) { unsigned u = __builtin_bit_cast(unsigned, f); return (u + 0x7fffu + ((u >> 16) & 1u)) >> 16; }
__device__ __forceinline__ unsigned pk2(float lo, float hi) { return f2bf(lo) | (f2bf(hi) << 16); }
__device__ __forceinline__ float bf_lo(unsigned w) { return __builtin_bit_cast(float, w << 16); }
__device__ __forceinline__ float bf_hi(unsigned w) { return __builtin_bit_cast(float, w & 0xffff0000u); }
__device__ __forceinline__ float ldbf(const bf16_t* p) { return __builtin_bit_cast(float, ((unsigned)*p) << 16); }
__device__ __forceinline__ unsigned cvt_pk_bf16(float lo, float hi) { unsigned r; asm volatile("v_cvt_pk_bf16_f32 %0, %1, %2" : "=v"(r) : "v"(lo), "v"(hi)); return r; }
__device__ __forceinline__ unsigned cvt_pk_bf16_c(float lo, float hi) { f32x2 v = {lo, hi}; bf16x2_t b = __builtin_convertvector(v, bf16x2_t); return __builtin_bit_cast(unsigned, b); }
__device__ __forceinline__ float fast_exp(float x) { return __builtin_amdgcn_exp2f(x * 1.44269504089f); }
__device__ __forceinline__ float fast_rcp(float x) { return __builtin_amdgcn_rcpf(x); }
__device__ __forceinline__ float fast_sigmoid(float x) { return fast_rcp(1.f + fast_exp(-x)); }
__device__ __forceinline__ float fast_tanh(float x) { float e = fast_exp(-2.f * fabsf(x)); float t = (1.f - e) * fast_rcp(1.f + e); return x < 0.f ? -t : t; }
__device__ __forceinline__ float gelu_tanh(float x) { const float c = 0.7978845608028654f; float u = c * (x + 0.044715f * x * x * x); return x * fast_sigmoid(2.f * u); }
__device__ __forceinline__ float softplus_f(float x) { return x > 15.f ? x : __logf(1.f + fast_exp(x)); }
__device__ __forceinline__ int lane_id() { return (int)__builtin_amdgcn_mbcnt_hi(~0u, __builtin_amdgcn_mbcnt_lo(~0u, 0u)); }
__device__ __forceinline__ float wave_sum(float v) {
#pragma unroll
    for (int o = 1; o < 64; o <<= 1) v += __shfl_xor(v, o);
    return v;
}
template <int CTRL> __device__ __forceinline__ float dpp_f(float v) { return __builtin_bit_cast(float, __builtin_amdgcn_update_dpp(0, __builtin_bit_cast(int, v), CTRL, 0xf, 0xf, false)); }
#define DPP_QP_1032 0xB1
#define DPP_QP_2301 0x4E
#define DPP_ROW_HALF_MIRROR 0x141
#define DPP_ROW_MIRROR 0x140
#define DPP_ROW_ROR(n) (0x120 + (n))
__device__ __forceinline__ float sum8(float v) { v += dpp_f<DPP_QP_1032>(v); v += dpp_f<DPP_QP_2301>(v); v += dpp_f<DPP_ROW_HALF_MIRROR>(v); return v; }
__device__ __forceinline__ float sum16(float v) { v = sum8(v); v += dpp_f<DPP_ROW_ROR(8)>(v); return v; }

#define XB_TMO      128
#define XB_XCNT(j)  (256  + 64 * (j))
#define XB_XSUB(j)  (1280 + 64 * (j))
#define XB_XGEN(j)  (2304 + 64 * (j))
#define XB_TOP      3328
#define XB_TOPGEN   3392
#define XCD_BAR_WORDS 3456
#define XB_SPIN_CAP (1u << 20)
__device__ __forceinline__ unsigned xb_ld(unsigned* p)              { return __hip_atomic_load(p, __ATOMIC_RELAXED, __HIP_MEMORY_SCOPE_AGENT); }
__device__ __forceinline__ unsigned xb_add(unsigned* p, unsigned v) { return __hip_atomic_fetch_add(p, v, __ATOMIC_RELAXED, __HIP_MEMORY_SCOPE_AGENT); }
__device__ __forceinline__ unsigned xb_xcc_id() { return (unsigned)__builtin_amdgcn_s_getreg((3 << 11) | 20) & 0xFu; }
#define XB_SPIN(cond, bar) do { unsigned _sp = 0; while (cond) { __builtin_amdgcn_s_sleep(1); \
    if ((++_sp & 255u) == 0u) { if (xb_ld(&(bar)[XB_TMO])) break; if (_sp > XB_SPIN_CAP) { atomicAdd(&(bar)[XB_TMO], 1u); break; } } } } while (0)
struct XcdBarrier { unsigned* bar; unsigned x; volatile LAS unsigned* st; };
__device__ __forceinline__ XcdBarrier xcd_barrier_post(unsigned* bar, volatile LAS unsigned* st) {
    XcdBarrier b; b.bar = bar; b.x = xb_xcc_id(); b.st = st;
    if (threadIdx.x == 0) (void)xb_add(&bar[XB_XCNT(b.x)], 1u);
    return b;
}
__device__ __forceinline__ void xcd_barrier_complete(unsigned* bar, unsigned x, unsigned& nloc, unsigned& nx) {
    const unsigned G = gridDim.x * gridDim.y * gridDim.z;
    unsigned sum, cnt, mine, sp = 0u;
    for (;;) {
        sum = 0u; cnt = 0u; mine = 0u;
#pragma unroll
        for (unsigned j = 0; j < 16; ++j) { const unsigned c = xb_ld(&bar[XB_XCNT(j)]); sum += c; cnt += (c > 0u) ? 1u : 0u; mine = (j == x) ? c : mine; }
        if (sum == G) break;
        __builtin_amdgcn_s_sleep(1);
        if ((++sp & 255u) == 0u) { if (xb_ld(&bar[XB_TMO])) break; if (sp > XB_SPIN_CAP) { atomicAdd(&bar[XB_TMO], 1u); break; } }
    }
    nloc = mine > 0u ? mine : 1u; nx = cnt > 0u ? cnt : 1u;
}
__device__ __forceinline__ void xcd_barrier(const XcdBarrier& b, const bool leader) {
    asm volatile("s_waitcnt vmcnt(0)" ::: "memory");
    __syncthreads();
    if (leader) {
        unsigned* bar = b.bar;
        __builtin_amdgcn_s_waitcnt(0);
        unsigned nloc = b.st[0], nx = b.st[1];
        if (nloc == 0u) { xcd_barrier_complete(bar, b.x, nloc, nx); b.st[0] = nloc; b.st[1] = nx; }
        const unsigned old = xb_add(&bar[XB_XSUB(b.x)], 1u);
        const unsigned gen = old / nloc;
        if (old + 1u == (gen + 1u) * nloc) {
            __builtin_amdgcn_fence(__ATOMIC_RELEASE, "agent");
            asm volatile("s_waitcnt vmcnt(0)" ::: "memory");
            const unsigned og = xb_add(&bar[XB_TOP], 1u);
            const unsigned tg = og / nx;
            if (og + 1u == (tg + 1u) * nx) xb_add(&bar[XB_TOPGEN], 1u);
            else XB_SPIN(xb_ld(&bar[XB_TOPGEN]) == tg, bar);
            __builtin_amdgcn_fence(__ATOMIC_ACQUIRE, "agent");
            xb_add(&bar[XB_XGEN(b.x)], 1u);
            asm volatile("s_waitcnt vmcnt(0)" ::: "memory");
        } else {
            XB_SPIN(xb_ld(&bar[XB_XGEN(b.x)]) == gen, bar);
            __builtin_amdgcn_fence(__ATOMIC_ACQUIRE, "agent");
            asm volatile("s_waitcnt vmcnt(0)" ::: "memory");
        }
    }
    __syncthreads();
}

namespace pg8 {
constexpr int BM = 256, BK = 64, HALF = 128, HTB = HALF * BK * 2, STAGE_BYTES = 8 * HTB, NXCD = 8, WGM = 8;
__host__ __device__ __forceinline__ int lds_byte(int r, int c) { const int st = (r >> 4) * 2 + (c >> 5), rr = r & 15, cc = c & 31, ob = rr * 64 + cc * 2; return st * 1024 + (ob ^ (((ob >> 9) & 1) << 5)); }
__host__ __device__ __forceinline__ void stage_rc(int b, int& R, int& C) { const int st = b / 1024, sb = b % 1024, swz = sb ^ (((sb >> 9) & 1) << 5); R = (st >> 1) * 16 + swz / 64; C = (st & 1) * 32 + (swz % 64) / 2; }
__host__ __device__ __forceinline__ int perm32(int rho) { const int n = rho >> 4, i = rho & 15; return 8 * (i >> 2) + 4 * n + (i & 3); }

struct Unit { const char* A; const char* B; int pm, pn; };
template <class P> struct Order {
    int nM, nN, nwg, G, c; P p;
    __device__ __forceinline__ void init(int nM_, int nN_, int G_, int c_, const P& p_) { nM = nM_; nN = nN_; nwg = nM * nN; G = G_; c = c_; p = p_; }
    __device__ __forceinline__ bool next(int i, Unit& u) const {
        const long L = (long)i * G + c; if (L >= nwg) return false;
        int wgid = (int)L; { const int q = nwg / NXCD, r = nwg % NXCD, xcd = wgid % NXCD, off = wgid / NXCD; wgid = (xcd < r ? xcd * (q + 1) : r * (q + 1) + (xcd - r) * q) + off; }
        const int nig = WGM * nN, gid = wgid / nig, fm = gid * WGM, gsz = (nM - fm) < WGM ? (nM - fm) : WGM;
        u.pm = fm + ((wgid % nig) % gsz); u.pn = (wgid % nig) / gsz; p.locate(u); return true;
    }
};

template <class Epi, class Sched, bool ALIGN_EPI, bool SP2>
__device__ __forceinline__ void gemm_phase(LAS unsigned char* lds, const int tid, const int lda, const int ldb, const int K, const Sched& S, const Epi& E) {
    const int wid = __builtin_amdgcn_readfirstlane(tid >> 6), lane = tid & 63, wr = wid >> 2, wc = wid & 3, fr = lane & 15, fq = lane >> 4;
    const int nt = K / BK;
    unsigned voffA[2], voffB[2];
#pragma unroll
    for (int i = 0; i < 2; ++i) { int R, C; stage_rc(tid * 16 + i * 8192, R, C); const int Rb = Epi::PERM ? ((R & ~31) + perm32(R & 31)) : R;
        voffA[i] = (unsigned)(R * lda + C) * 2u; voffB[i] = (unsigned)(Rb * ldb + C) * 2u; }
    const size_t kstep = (size_t)(BK * 2);
    const size_t hstepA = (size_t)HALF * lda * 2, hstepB = (size_t)HALF * ldb * 2;
    const unsigned ldsw = (unsigned)wid * 1024u;
    const int aoff = lds_byte(wr * 64 + fr, fq * 8), boff = lds_byte(wc * 32 + fr, fq * 8);
#define PG8_SA(b, h) (((b) * 2 + (h)) * HTB)
#define PG8_SB(b, h) ((4 + (b) * 2 + (h)) * HTB)
#define PG8_STAGE(bufoff, gbase, voff) do { _Pragma("unroll") for (int _i = 0; _i < 2; ++_i) \
        __builtin_amdgcn_global_load_lds((const unsigned*)((const char*)(gbase) + (voff)[_i]), (LAS unsigned*)(lds + (bufoff) + ldsw + _i * 8192), 16, 0, 0); } while (0)
#define PG8_LDA(dst, b, h) do { _Pragma("unroll") for (int m = 0; m < 4; ++m) _Pragma("unroll") for (int k = 0; k < 2; ++k) dst[m][k] = *(const LAS bf16x8*)(lds + PG8_SA(b, h) + aoff + m * 2048 + k * 1024); } while (0)
#define PG8_LDB(dst, b, h) do { _Pragma("unroll") for (int n = 0; n < 2; ++n) _Pragma("unroll") for (int k = 0; k < 2; ++k) dst[n][k] = *(const LAS bf16x8*)(lds + PG8_SB(b, h) + boff + n * 2048 + k * 1024); } while (0)
#define PG8_MMA(ai, bj, At, Bt) do { __builtin_amdgcn_s_setprio(1); _Pragma("unroll") for (int m = 0; m < 4; ++m) _Pragma("unroll") for (int n = 0; n < 2; ++n) _Pragma("unroll") for (int k = 0; k < 2; ++k) \
        acc[ai][bj][m][n] = __builtin_amdgcn_mfma_f32_16x16x32_bf16(Bt[n][k], At[m][k], acc[ai][bj][m][n], 0, 0, 0); __builtin_amdgcn_s_setprio(0); } while (0)
#define PG8_WAIT_V(n) asm volatile("s_waitcnt vmcnt(" #n ")" ::: "memory")
#define PG8_WAIT_L(n) asm volatile("s_waitcnt lgkmcnt(" #n ")" ::: "memory")
#define PG8_BAR __builtin_amdgcn_s_barrier()
#define PG8_SCHED __builtin_amdgcn_sched_barrier(0)
    Unit cur, nxt; int ui = 0;
    if (!S.next(0, cur)) return;
    f32x4 acc[2][2][4][2];
#pragma unroll
    for (int a = 0; a < 2; ++a)
#pragma unroll
        for (int b = 0; b < 2; ++b)
#pragma unroll
            for (int m = 0; m < 4; ++m)
#pragma unroll
                for (int n = 0; n < 2; ++n) acc[a][b][m][n] = (f32x4){0.f, 0.f, 0.f, 0.f};
    bf16x8 At[4][2], B0[2][2], B1[2][2];
    const char* cA = cur.A; const char* cB = cur.B;
    if constexpr (SP2) {
        PG8_STAGE(PG8_SB(0, 0), cB, voffB); PG8_STAGE(PG8_SB(0, 1), cB + hstepB, voffB); PG8_STAGE(PG8_SA(0, 0), cA, voffA); PG8_STAGE(PG8_SA(0, 1), cA + hstepA, voffA);
        if (wr == 1) PG8_BAR;
        PG8_WAIT_V(2); PG8_BAR;
        PG8_STAGE(PG8_SB(1, 0), cB + kstep, voffB); PG8_STAGE(PG8_SA(1, 0), cA + kstep, voffA); PG8_STAGE(PG8_SB(1, 1), cB + hstepB + kstep, voffB);
        PG8_WAIT_V(6); PG8_BAR;
    } else {
        PG8_STAGE(PG8_SB(0, 0), cB, voffB); PG8_STAGE(PG8_SA(0, 0), cA, voffA); PG8_STAGE(PG8_SB(0, 1), cB + hstepB, voffB); PG8_STAGE(PG8_SA(0, 1), cA + hstepA, voffA);
        if (wr == 1) PG8_BAR;
        PG8_WAIT_V(4); PG8_BAR;
        PG8_STAGE(PG8_SB(1, 0), cB + kstep, voffB); PG8_STAGE(PG8_SA(1, 0), cA + kstep, voffA); PG8_STAGE(PG8_SB(1, 1), cB + hstepB + kstep, voffB);
        PG8_WAIT_V(6); PG8_BAR;
    }
    for (;;) {
        const bool has_next = S.next(ui + 1, nxt);
        const char* nA = has_next ? nxt.A : cA; const char* nB = has_next ? nxt.B : cB;
#pragma unroll 1
        for (int t = 0; t < nt; t += 2) {
            const bool last = (t == nt - 2);
            const char* a1 = cA + (size_t)(t + 1) * kstep;
            const char* a2 = last ? nA : cA + (size_t)(t + 2) * kstep; const char* b2 = last ? nB : cB + (size_t)(t + 2) * kstep;
            const char* a3 = a2 + kstep; const char* b3 = b2 + kstep;
            if constexpr (SP2) {
            PG8_LDB(B0, 0, 0); PG8_LDB(B1, 0, 1); PG8_SCHED; PG8_LDA(At, 0, 0); PG8_STAGE(PG8_SA(1, 1), a1 + hstepA, voffA);
            PG8_WAIT_V(8); PG8_WAIT_L(0); PG8_BAR; PG8_MMA(0, 0, At, B0); PG8_MMA(0, 1, At, B1); PG8_BAR; PG8_SCHED;
            PG8_LDA(At, 0, 1); PG8_STAGE(PG8_SB(0, 0), b2, voffB); PG8_STAGE(PG8_SB(0, 1), b2 + hstepB, voffB); PG8_STAGE(PG8_SA(0, 0), a2, voffA);
            PG8_WAIT_V(8); PG8_WAIT_L(0); PG8_BAR; PG8_MMA(1, 0, At, B0); PG8_MMA(1, 1, At, B1); PG8_BAR; PG8_SCHED;
            PG8_LDB(B0, 1, 0); PG8_LDB(B1, 1, 1); PG8_SCHED; PG8_LDA(At, 1, 0); PG8_STAGE(PG8_SA(0, 1), a2 + hstepA, voffA);
            PG8_WAIT_V(8); PG8_WAIT_L(0); PG8_BAR; PG8_MMA(0, 0, At, B0); PG8_MMA(0, 1, At, B1); PG8_BAR; PG8_SCHED;
            PG8_LDA(At, 1, 1); PG8_STAGE(PG8_SB(1, 0), b3, voffB); PG8_STAGE(PG8_SB(1, 1), b3 + hstepB, voffB); PG8_STAGE(PG8_SA(1, 0), a3, voffA);
            PG8_WAIT_V(8); PG8_WAIT_L(0); PG8_BAR; PG8_MMA(1, 0, At, B0); PG8_MMA(1, 1, At, B1); PG8_BAR; PG8_SCHED;
            } else {
            PG8_LDB(B0, 0, 0); PG8_SCHED; PG8_LDA(At, 0, 0); PG8_STAGE(PG8_SA(1, 1), a1 + hstepA, voffA);
            PG8_WAIT_L(8); PG8_BAR; PG8_WAIT_L(0); PG8_MMA(0, 0, At, B0); PG8_BAR; PG8_SCHED;
            PG8_LDB(B1, 0, 1); PG8_STAGE(PG8_SB(0, 0), b2, voffB);
            PG8_BAR; PG8_WAIT_L(0); PG8_MMA(0, 1, At, B1); PG8_BAR;
            PG8_LDA(At, 0, 1); PG8_STAGE(PG8_SA(0, 0), a2, voffA);
            PG8_BAR; PG8_WAIT_L(0); PG8_MMA(1, 0, At, B0); PG8_BAR; PG8_SCHED;
            PG8_STAGE(PG8_SB(0, 1), b2 + hstepB, voffB);
            PG8_WAIT_V(6); PG8_BAR; PG8_MMA(1, 1, At, B1); PG8_BAR;
            PG8_LDB(B0, 1, 0); PG8_SCHED; PG8_LDA(At, 1, 0); PG8_STAGE(PG8_SA(0, 1), a2 + hstepA, voffA);
            PG8_WAIT_L(8); PG8_BAR; PG8_WAIT_L(0); PG8_MMA(0, 0, At, B0); PG8_BAR; PG8_SCHED;
            PG8_LDB(B1, 1, 1); PG8_STAGE(PG8_SB(1, 0), b3, voffB);
            PG8_BAR; PG8_WAIT_L(0); PG8_MMA(0, 1, At, B1); PG8_BAR;
            PG8_LDA(At, 1, 1); PG8_STAGE(PG8_SA(1, 0), a3, voffA);
            PG8_BAR; PG8_WAIT_L(0); PG8_MMA(1, 0, At, B0); PG8_BAR; PG8_SCHED;
            PG8_STAGE(PG8_SB(1, 1), b3 + hstepB, voffB);
            PG8_WAIT_V(6); PG8_BAR; PG8_MMA(1, 1, At, B1); PG8_BAR;
            }
        }
        if constexpr (ALIGN_EPI) { if (wr == 0) PG8_BAR; }
        { int l_e = lane_id(); asm volatile("" : "+v"(l_e)); E(acc, cur, wr, wc, l_e & 15, l_e >> 4); }
        if (!has_next) break;
#pragma unroll
        for (int a = 0; a < 2; ++a)
#pragma unroll
            for (int b = 0; b < 2; ++b)
#pragma unroll
                for (int m = 0; m < 4; ++m)
#pragma unroll
                    for (int n = 0; n < 2; ++n) acc[a][b][m][n] = (f32x4){0.f, 0.f, 0.f, 0.f};
        cur = nxt; cA = nA; cB = nB; ++ui;
        if constexpr (ALIGN_EPI) { if (wr == 1) PG8_BAR; }
    }
    PG8_WAIT_V(0);
    if constexpr (!ALIGN_EPI) { if (wr == 0) PG8_BAR; }
    PG8_BAR;
#undef PG8_SA
#undef PG8_SB
#undef PG8_STAGE
#undef PG8_LDA
#undef PG8_LDB
#undef PG8_MMA
#undef PG8_WAIT_V
#undef PG8_WAIT_L
#undef PG8_BAR
#undef PG8_SCHED
}
}
}
namespace mk {
constexpr size_t MiB = 1u << 20;
constexpr size_t WS_CTL = 0, CTL_ZERO_BYTES = 65536;
constexpr size_t WS_WIN = 1 * MiB, WS_WG = 7 * MiB, WS_WOUT = 10 * MiB, WS_WPEER = 13 * MiB, WS_WRKV = 21 * MiB, WS_WL2 = 29 * MiB, WS_WO = 31 * MiB, WS_VEC = 33 * MiB;
constexpr size_t WS_UB = 34 * MiB, WS_VB = 66 * MiB;
constexpr size_t WS_X0B = 98 * MiB, WS_GATE = 130 * MiB, WS_H2 = 174 * MiB, WS_XC = 218 * MiB, WS_A = 262 * MiB, WS_U = 350 * MiB, WS_AGG = 438 * MiB;
constexpr size_t WS_Y = WS_H2, WS_Z0 = WS_A, WS_XF = 350 * MiB, WS_XB0 = 98 * MiB;
constexpr size_t WS_SC0 = 130 * MiB, WS_EID0 = 258 * MiB, WS_GW0 = 266 * MiB;
constexpr size_t WS_MIX = 34 * MiB, WS_R = 226 * MiB, WS_K = 258 * MiB, WS_V = 290 * MiB, WS_LORA = 322 * MiB, WS_WDEC = 98 * MiB, WS_AA = 162 * MiB, WS_G = 194 * MiB, WS_OG = WS_R;
constexpr size_t WS_Z1 = 98 * MiB, WS_XB1 = 162 * MiB;
constexpr size_t WS_SC1 = 194 * MiB, WS_EID1 = 322 * MiB, WS_GW1 = 330 * MiB;
constexpr size_t WS_PART0 = 130 * MiB, WS_ZP0 = 194 * MiB, WS_PART1 = 194 * MiB, WS_ZP1 = 258 * MiB;
constexpr size_t WS_DBG = 444 * MiB, WS_END = 512 * MiB;
constexpr int CW_BAR = 4096;
constexpr int LDS_BYTES = 163840, MISC_OFF = LDS_BYTES - 256;

struct Args { const float* in[34]; float* out; unsigned char* ws; int ph_lo, ph_hi; };

struct Frame {
    LAS unsigned char* lds; volatile LAS unsigned* MISC; unsigned* ctl; unsigned char* ws;
    int tid, lane, wave, vcu, G, gw, NGW, bx;
    float* out;
};
#define LDS_WAIT() asm volatile("s_waitcnt lgkmcnt(0)" ::: "memory")

__device__ __forceinline__ void transpose_item(const float* W, int K, int N, bf16_t* WT, int ldt, int row_off, int col_off, LAS float* scr, int item, int lane) {
    const int nblk = N / 32, kb = item / nblk, nb = item % nblk, k0 = 64 * kb, n0 = 32 * nb;
#pragma unroll 8
    for (int i = 0; i < 32; ++i) { const int kk = 2 * i + (lane >> 5); scr[kk * 33 + (lane & 31)] = W[(size_t)(k0 + kk) * N + n0 + (lane & 31)]; }
    LDS_WAIT(); asm volatile("" ::: "memory");
    const int c = lane & 7;
#pragma unroll
    for (int j = 0; j < 4; ++j) { const int n = (lane >> 3) + 8 * j; const LAS float* s = scr + (8 * c) * 33 + n;
        u32x4 o; o.x = pk2(s[0 * 33], s[1 * 33]); o.y = pk2(s[2 * 33], s[3 * 33]); o.z = pk2(s[4 * 33], s[5 * 33]); o.w = pk2(s[6 * 33], s[7 * 33]);
        *(u32x4*)(WT + (size_t)(row_off + n0 + n) * ldt + col_off + k0 + 8 * c) = o; }
    LDS_WAIT(); asm volatile("" ::: "memory");
    (void)K;
}
__device__ __forceinline__ int gates_koff(int q) { int s = 128 * (q > 0 ? q - 1 : 0); return s > 1024 ? 1024 : s; }

__device__ __forceinline__ void cvt_stream(const float* src, bf16_t* dst, size_t n8, size_t w, size_t nw) {
    for (size_t i = w; i < n8; i += nw) { const f32x4 a = *(const f32x4*)(src + i * 8), b = *(const f32x4*)(src + i * 8 + 4);
        u32x4 o; o.x = pk2(a.x, a.y); o.y = pk2(a.z, a.w); o.z = pk2(b.x, b.y); o.w = pk2(b.z, b.w); *(u32x4*)(dst + i * 8) = o; }
}

__device__ __forceinline__ void cvt_stream_fp8(const float* src, unsigned char* dst, size_t n16, size_t w, size_t nw, float scale) {
    for (size_t i = w; i < n16; i += nw) { const f32x4 a = *(const f32x4*)(src + i * 16) * scale, b = *(const f32x4*)(src + i * 16 + 4) * scale, c = *(const f32x4*)(src + i * 16 + 8) * scale, d = *(const f32x4*)(src + i * 16 + 12) * scale;
        u32x4 o; int t;
        t = __builtin_amdgcn_cvt_pk_fp8_f32(a.x, a.y, 0, false); o.x = (unsigned)__builtin_amdgcn_cvt_pk_fp8_f32(a.z, a.w, t, true);
        t = __builtin_amdgcn_cvt_pk_fp8_f32(b.x, b.y, 0, false); o.y = (unsigned)__builtin_amdgcn_cvt_pk_fp8_f32(b.z, b.w, t, true);
        t = __builtin_amdgcn_cvt_pk_fp8_f32(c.x, c.y, 0, false); o.z = (unsigned)__builtin_amdgcn_cvt_pk_fp8_f32(c.z, c.w, t, true);
        t = __builtin_amdgcn_cvt_pk_fp8_f32(d.x, d.y, 0, false); o.w = (unsigned)__builtin_amdgcn_cvt_pk_fp8_f32(d.z, d.w, t, true);
        *(u32x4*)(dst + ((i & 63) >> 3) * ((size_t)16384 * 128) + (i >> 6) * 128 + (i & 7) * 16) = o; }
}
constexpr float U_SCALE = 256.f, V_SCALE = 32.f;

__device__ __forceinline__ void p0_prologue(Frame& F, const Args& args) {
    LAS float* scr = (LAS float*)(F.lds + F.wave * 16384);
    const int gw = F.gw, NGW = F.NGW, lane = F.lane;
    bf16_t* Win_t = (bf16_t*)(F.ws + WS_WIN); bf16_t* Wout_t = (bf16_t*)(F.ws + WS_WOUT); bf16_t* Wrkv_t = (bf16_t*)(F.ws + WS_WRKV); bf16_t* Wl2_t = (bf16_t*)(F.ws + WS_WL2); bf16_t* Wo_t = (bf16_t*)(F.ws + WS_WO);
    for (int it = gw; it < 16 * 88; it += NGW) transpose_item(args.in[1], 1024, 2816, Win_t, 1024, 0, 0, scr, it, lane);
    for (int it = gw; it < 22 * 32; it += NGW) transpose_item(args.in[9], 1408, 1024, Wout_t, 1408, 0, 0, scr, it, lane);
    for (int it = gw; it < 512; it += NGW) transpose_item(args.in[11], 1024, 1024, Wrkv_t, 1024, 0, 0, scr, it, lane);
    for (int it = gw; it < 512; it += NGW) transpose_item(args.in[12], 1024, 1024, Wrkv_t, 1024, 1024, 0, scr, it, lane);
    for (int it = gw; it < 512; it += NGW) transpose_item(args.in[13], 1024, 1024, Wrkv_t, 1024, 2048, 0, scr, it, lane);
    for (int it = gw; it < 32; it += NGW) transpose_item(args.in[15], 1024, 64, Wrkv_t, 1024, 3072, 0, scr, it, lane);
    for (int it = gw; it < 32; it += NGW) transpose_item(args.in[18], 1024, 64, Wrkv_t, 1024, 3328, 0, scr, it, lane);
    for (int it = gw; it < 64; it += NGW) transpose_item(args.in[20], 1024, 128, Wrkv_t, 1024, 3584, 0, scr, it, lane);
    for (int it = gw; it < 512; it += NGW) transpose_item(args.in[27], 1024, 1024, Wo_t, 1024, 0, 0, scr, it, lane);
    for (int it = gw; it < 32; it += NGW) transpose_item(args.in[16], 64, 1024, Wl2_t, 256, 0, 0, scr, it, lane);
    for (int it = gw; it < 32; it += NGW) transpose_item(args.in[19], 64, 1024, Wl2_t, 256, 1024, 64, scr, it, lane);
    for (int it = gw; it < 64; it += NGW) transpose_item(args.in[21], 128, 1024, Wl2_t, 256, 2048, 128, scr, it, lane);
    const size_t gt = (size_t)gw * 64 + lane, NGT = (size_t)NGW * 64;
    const u32x4 z4 = {0u, 0u, 0u, 0u};
    for (size_t i = gt; i < (size_t)768 * 128; i += NGT) {
        const int row = 3072 + (int)(i / 128), r = row - 3072; const bool data = (r < 64) || (r >= 256 && r < 320) || (r >= 512 && r < 640);
        if (!data) *(u32x4*)(Wrkv_t + (size_t)row * 1024 + (i % 128) * 8) = z4; }
    for (size_t i = gt; i < (size_t)3072 * 32; i += NGT) {
        const int row = (int)(i / 32), c8 = (int)(i % 32) * 8, g = row >> 10; const int lo = g == 0 ? 0 : (g == 1 ? 64 : 128), hi = g == 0 ? 64 : (g == 1 ? 128 : 256);
        if (c8 < lo || c8 >= hi) *(u32x4*)(Wl2_t + (size_t)row * 256 + c8) = z4; }
    { bf16_t* Wg_t = (bf16_t*)(F.ws + WS_WG);
      for (size_t i = gt; i < (size_t)2816 * 48; i += NGT) {
          const int row = (int)(i / 48), k8 = (int)(i % 48) * 8, q = row >> 8, r = row & 255, gs = r >> 7, ch = 128 * q + (r & 127), h = ch / HB, j = ch % HB;
          const float* w = (gs ? args.in[6] : args.in[4]) + (size_t)h * HB * HB; const int kg0 = gates_koff(q) + k8;
          float v[8];
#pragma unroll
          for (int e = 0; e < 8; ++e) { const int kg = kg0 + e; v[e] = (kg / HB == h) ? w[(kg % HB) * HB + j] : 0.f; }
          u32x4 o; o.x = pk2(v[0], v[1]); o.y = pk2(v[2], v[3]); o.z = pk2(v[4], v[5]); o.w = pk2(v[6], v[7]);
          *(u32x4*)(Wg_t + (size_t)row * 384 + k8) = o; } }
    for (int it = gw; it < 4096; it += NGW) {
        const int layer = it >> 11, hp = (it >> 7) & 15, n0 = ((it >> 4) & 7) * 16, k0 = (it & 15) * 64;
        const float* keys = args.in[29] + ((size_t)layer * 16 + hp) * 128 * 128; const float* wq = args.in[28] + (size_t)layer * 1024 * 2048 + hp * 128;
        bf16_t* We = (bf16_t*)(F.ws + WS_WPEER) + (size_t)layer * 2048 * 1024;
        f32x4 acc[4];
#pragma unroll
        for (int s = 0; s < 4; ++s) acc[s] = (f32x4){0.f, 0.f, 0.f, 0.f};
        const int li = lane & 15, q = lane >> 4;
        for (int dc = 0; dc < 8; ++dc) {
            const int d = 16 * dc + 4 * q;
            const f32x4 a = *(const f32x4*)(keys + (size_t)(n0 + li) * 128 + d);
            f32x4 b[4];
#pragma unroll
            for (int s = 0; s < 4; ++s) b[s] = *(const f32x4*)(wq + (size_t)(k0 + 16 * s + li) * 2048 + d);
#pragma unroll
            for (int e = 0; e < 4; ++e)
#pragma unroll
                for (int s = 0; s < 4; ++s) acc[s] = __builtin_amdgcn_mfma_f32_16x16x4f32(a[e], b[s][e], acc[s], 0, 0, 0);
        }
#pragma unroll
        for (int s = 0; s < 4; ++s)
#pragma unroll
            for (int r = 0; r < 4; ++r) We[(size_t)(hp * 128 + n0 + 4 * q + r) * 1024 + k0 + 16 * s + li] = (bf16_t)f2bf(acc[s][r]);
    }
    cvt_stream(args.in[0], (bf16_t*)(F.ws + WS_X0B), (size_t)T * D / 8, gt, NGT);
    cvt_stream_fp8(args.in[30], F.ws + WS_UB, (size_t)16384 * D / 16, gt, NGT, U_SCALE);
    cvt_stream_fp8(args.in[31], F.ws + WS_VB, (size_t)16384 * D / 16, gt, NGT, V_SCALE);
    { float* sl = (float*)(F.ws + WS_VEC); for (size_t i = gt; i < (size_t)W; i += NGT) { const float l = args.in[8][i]; sl[i] = -8.f * (l < -15.f ? -l : log1pf(expf(-l))); } }
}

struct ProbPlain { const char* A; const char* B; size_t strideA, strideB;
    __device__ __forceinline__ void locate(pg8::Unit& u) const { u.A = A + (size_t)u.pm * strideA; u.B = B + (size_t)u.pn * strideB; } };
struct ProbGates { const char* A; const char* B;
    __device__ __forceinline__ void locate(pg8::Unit& u) const { u.A = A + (size_t)u.pm * (256 * W * 2) + gates_koff(u.pn) * 2; u.B = B + (size_t)u.pn * (256 * 384 * 2); } };
struct ProbRkv { const char* mix; const char* B;
    __device__ __forceinline__ void locate(pg8::Unit& u) const { const int pn = u.pn; const int j = pn < 4 ? 0 : (pn < 8 ? 2 : (pn < 12 ? 3 : (pn == 12 ? 1 : (pn == 13 ? 4 : 5))));
        u.A = mix + (size_t)j * ((size_t)T * D * 2) + (size_t)u.pm * (256 * D * 2); u.B = B + (size_t)pn * (256 * D * 2); } };

struct EpiWin { static constexpr bool PERM = true; bf16_t* gate; bf16_t* h2;
    __device__ __forceinline__ void operator()(const f32x4 (&acc)[2][2][4][2], const pg8::Unit& u, int wr, int wc, int fr, int fq) const {
        const int row0 = u.pm * 256 + wr * 64 + fr;
#pragma unroll
        for (int bj = 0; bj < 2; ++bj) { const int hb = 2 * u.pn + bj; const bool isg = hb < 11; bf16_t* base = isg ? gate : h2; const int col = 128 * (isg ? hb : hb - 11) + wc * 32 + 8 * fq;
#pragma unroll
            for (int ai = 0; ai < 2; ++ai)
#pragma unroll
                for (int m = 0; m < 4; ++m) { f32x4 v0 = acc[ai][bj][m][0], v1 = acc[ai][bj][m][1];
                    if (isg) {
#pragma unroll
                        for (int j = 0; j < 4; ++j) { v0[j] = gelu_tanh(v0[j]); v1[j] = gelu_tanh(v1[j]); } }
                    u32x4 w; w.x = cvt_pk_bf16(v0[0], v0[1]); w.y = cvt_pk_bf16(v0[2], v0[3]); w.z = cvt_pk_bf16(v1[0], v1[1]); w.w = cvt_pk_bf16(v1[2], v1[3]);
                    *(u32x4*)(base + (size_t)(row0 + ai * 128 + m * 16) * W + col) = w; } }
    } };
struct EpiGates { static constexpr bool PERM = false; const bf16_t* xc; const float* sl; const float* ba; const float* bx; float* a; float* uo;
    __device__ __forceinline__ void operator()(const f32x4 (&acc)[2][2][4][2], const pg8::Unit& u, int wr, int wc, int fr, int fq) const {
        const int row0 = u.pm * 256 + wr * 64 + fr;
#pragma unroll
        for (int ai = 0; ai < 2; ++ai)
#pragma unroll
            for (int m = 0; m < 4; ++m) {
#pragma unroll
                for (int n = 0; n < 2; ++n) { const int c = 128 * u.pn + wc * 32 + 16 * n + 4 * fq; const size_t off = (size_t)(row0 + ai * 128 + m * 16) * W + c;
                    const f32x4 s4 = *(const f32x4*)(sl + c), ba4 = *(const f32x4*)(ba + c), bx4 = *(const f32x4*)(bx + c);
                    const u32x2 xw = *(const u32x2*)(xc + off);
                    const f32x4 pa = acc[ai][0][m][n] + ba4, px = acc[ai][1][m][n] + bx4; f32x4 av, uv; const f32x4 xs = {bf_lo(xw.x), bf_hi(xw.x), bf_lo(xw.y), bf_hi(xw.y)};
#pragma unroll
                    for (int j = 0; j < 4; ++j) { const float r = fast_sigmoid(pa[j]), ig = fast_sigmoid(px[j]); const float la = s4[j] * r; const float aa = fast_exp(la);
                        av[j] = aa; uv[j] = sqrtf(fmaxf(1.f - aa * aa, 0.f)) * ig * xs[j]; }
                    *(f32x4*)(a + off) = av; *(f32x4*)(uo + off) = uv; __builtin_amdgcn_sched_barrier(0); }
                asm volatile("" ::: "memory"); }
    } };
struct EpiRes { static constexpr bool PERM = false; const float* res; float* z;
    __device__ __forceinline__ void operator()(const f32x4 (&acc)[2][2][4][2], const pg8::Unit& u, int wr, int wc, int fr, int fq) const {
        const int row0 = u.pm * 256 + wr * 64 + fr, col0 = u.pn * 256 + wc * 32 + 4 * fq;
#pragma unroll
        for (int ai = 0; ai < 2; ++ai)
#pragma unroll
            for (int m = 0; m < 4; ++m) { const size_t off = (size_t)(row0 + ai * 128 + m * 16) * D + col0;
#pragma unroll
                for (int bj = 0; bj < 2; ++bj)
#pragma unroll
                    for (int n = 0; n < 2; ++n) { const f32x4 r4 = *(const f32x4*)(res + off + bj * 128 + n * 16); *(f32x4*)(z + off + bj * 128 + n * 16) = r4 * ALPHA + acc[ai][bj][m][n]; } }
    } };
struct EpiScores { static constexpr bool PERM = false; float* sc;
    __device__ __forceinline__ void operator()(const f32x4 (&acc)[2][2][4][2], const pg8::Unit& u, int wr, int wc, int fr, int fq) const {
#pragma unroll
        for (int ai = 0; ai < 2; ++ai) { const int tb = 4 * u.pm + 2 * ai + wr;
#pragma unroll
            for (int bj = 0; bj < 2; ++bj) { const int hp = 2 * u.pn + bj; float* base = sc + ((size_t)(tb * 16 + hp) * 128) * 64;
#pragma unroll
                for (int m = 0; m < 4; ++m) { const int tl = 16 * m + fr;
#pragma unroll
                    for (int n = 0; n < 2; ++n) { const int nn = 32 * wc + 16 * n + 4 * fq;
#pragma unroll
                        for (int j = 0; j < 4; ++j) base[(size_t)(nn + j) * 64 + tl] = acc[ai][bj][m][n][j]; } } } }
    } };
struct EpiRkv { static constexpr bool PERM = true; bf16_t* r; bf16_t* lora;
    __device__ __forceinline__ void operator()(const f32x4 (&acc)[2][2][4][2], const pg8::Unit& u, int wr, int wc, int fr, int fq) const {
        const int row0 = u.pm * 256 + wr * 64 + fr, pn = u.pn;
        if (pn < 12) { bf16_t* base = r + (size_t)(pn >> 2) * ((size_t)T * D); const int col0 = (pn & 3) * 256 + wc * 32 + 8 * fq;
#pragma unroll
            for (int ai = 0; ai < 2; ++ai)
#pragma unroll
                for (int m = 0; m < 4; ++m)
#pragma unroll
                    for (int bj = 0; bj < 2; ++bj) { const f32x4 v0 = acc[ai][bj][m][0], v1 = acc[ai][bj][m][1];
                        u32x4 w; w.x = cvt_pk_bf16(v0[0], v0[1]); w.y = cvt_pk_bf16(v0[2], v0[3]); w.z = cvt_pk_bf16(v1[0], v1[1]); w.w = cvt_pk_bf16(v1[2], v1[3]);
                        *(u32x4*)(base + (size_t)(row0 + ai * 128 + m * 16) * D + col0 + bj * 128) = w; }
        } else {
            const int kind = pn - 12;
            const int lim = kind == 2 ? 128 : 64, dst0 = kind == 0 ? 0 : (kind == 1 ? 64 : 128);
#pragma unroll
            for (int bj = 0; bj < 2; ++bj) { const int cl = 128 * bj + wc * 32 + 8 * fq; if (cl < lim) {
#pragma unroll
                for (int ai = 0; ai < 2; ++ai)
#pragma unroll
                    for (int m = 0; m < 4; ++m) { f32x4 v0 = acc[ai][bj][m][0], v1 = acc[ai][bj][m][1];
#pragma unroll
                        for (int j = 0; j < 4; ++j) { if (kind == 0) { v0[j] = fast_tanh(v0[j]); v1[j] = fast_tanh(v1[j]); } else if (kind == 2) { v0[j] = fast_sigmoid(v0[j]); v1[j] = fast_sigmoid(v1[j]); } }
                        u32x4 w; w.x = cvt_pk_bf16(v0[0], v0[1]); w.y = cvt_pk_bf16(v0[2], v0[3]); w.z = cvt_pk_bf16(v1[0], v1[1]); w.w = cvt_pk_bf16(v1[2], v1[3]);
                        *(u32x4*)(lora + (size_t)(row0 + ai * 128 + m * 16) * 256 + dst0 + cl) = w; } } }
        }
    } };
struct EpiLora2 { static constexpr bool PERM = true; float* wdec; bf16_t* aa; const float* w0; const float* a0;
    __device__ __forceinline__ void operator()(const f32x4 (&acc)[2][2][4][2], const pg8::Unit& u, int wr, int wc, int fr, int fq) const {
        const int row0 = u.pm * 256 + wr * 64 + fr, pn = u.pn, kind = pn >> 2;
#pragma unroll
        for (int bj = 0; bj < 2; ++bj) { const int col = (pn & 3) * 256 + 128 * bj + wc * 32 + 8 * fq;
            f32x4 c0 = {0.f, 0.f, 0.f, 0.f}, c1 = c0;
            if (kind == 0) { c0 = *(const f32x4*)(w0 + col); c1 = *(const f32x4*)(w0 + col + 4); } else if (kind == 1) { c0 = *(const f32x4*)(a0 + col); c1 = *(const f32x4*)(a0 + col + 4); }
#pragma unroll
            for (int ai = 0; ai < 2; ++ai)
#pragma unroll
                for (int m = 0; m < 4; ++m) { f32x4 v0 = acc[ai][bj][m][0] + c0, v1 = acc[ai][bj][m][1] + c1; const size_t off = (size_t)(row0 + ai * 128 + m * 16) * D + col;
                    if (kind == 0) {
#pragma unroll
                        for (int j = 0; j < 4; ++j) { v0[j] = fast_exp(-0.60653066f * fast_sigmoid(v0[j])); v1[j] = fast_exp(-0.60653066f * fast_sigmoid(v1[j])); }
                        *(f32x4*)(wdec + off) = v0; *(f32x4*)(wdec + off + 4) = v1;
                    } else {
                        if (kind == 1) {
#pragma unroll
                            for (int j = 0; j < 4; ++j) { v0[j] = fast_sigmoid(v0[j]); v1[j] = fast_sigmoid(v1[j]); } }
                        u32x4 w; w.x = cvt_pk_bf16(v0[0], v0[1]); w.y = cvt_pk_bf16(v0[2], v0[3]); w.z = cvt_pk_bf16(v1[0], v1[1]); w.w = cvt_pk_bf16(v1[2], v1[3]);
                        *(u32x4*)(aa + (size_t)(kind - 1) * ((size_t)T * D) + off) = w; }
                    __builtin_amdgcn_sched_barrier(0); } }
    } };

template <class Epi, class Prob>
__device__ __forceinline__ void run_gemm(Frame& F, int nM, int nN, int lda, int ldb, int K, const Prob& P, const Epi& E) {
    pg8::Order<Prob> S; S.init(nM, nN, F.G, F.bx, P);
    pg8::gemm_phase<Epi, pg8::Order<Prob>, true, true>(F.lds, F.tid, lda, ldb, K, S, E);
}

__device__ __forceinline__ void conv_phase(Frame& F, const float* cw, const float* cb) {
    const bf16_t* h2 = (const bf16_t*)(F.ws + WS_H2); bf16_t* xc = (bf16_t*)(F.ws + WS_XC);
    const size_t gt = (size_t)F.gw * 64 + F.lane, NGT = (size_t)F.NGW * 64;
    for (size_t i = gt; i < (size_t)T * (W / 8); i += NGT) {
        const int t = (int)(i / (W / 8)), c = (int)(i % (W / 8)) * 8, s = t & (S - 1);
        float acc[8];
        { const f32x4 b0 = *(const f32x4*)(cb + c), b1 = *(const f32x4*)(cb + c + 4); acc[0] = b0.x; acc[1] = b0.y; acc[2] = b0.z; acc[3] = b0.w; acc[4] = b1.x; acc[5] = b1.y; acc[6] = b1.z; acc[7] = b1.w; }
#pragma unroll
        for (int j = 0; j < 4; ++j) { if (s - 3 + j >= 0) {
            const u32x4 hv = *(const u32x4*)(h2 + (size_t)(t - 3 + j) * W + c); const f32x4 w0 = *(const f32x4*)(cw + j * W + c), w1 = *(const f32x4*)(cw + j * W + c + 4);
            acc[0] += w0.x * bf_lo(hv.x); acc[1] += w0.y * bf_hi(hv.x); acc[2] += w0.z * bf_lo(hv.y); acc[3] += w0.w * bf_hi(hv.y);
            acc[4] += w1.x * bf_lo(hv.z); acc[5] += w1.y * bf_hi(hv.z); acc[6] += w1.z * bf_lo(hv.w); acc[7] += w1.w * bf_hi(hv.w); } }
        u32x4 o; o.x = pk2(acc[0], acc[1]); o.y = pk2(acc[2], acc[3]); o.z = pk2(acc[4], acc[5]); o.w = pk2(acc[6], acc[7]);
        *(u32x4*)(xc + (size_t)t * W + c) = o;
    }
}
constexpr int RG_CH = 32, RG_NCH = S / RG_CH;
__device__ __forceinline__ void rgscan1_phase(Frame& F) {
    const float* a = (const float*)(F.ws + WS_A); const float* u = (const float*)(F.ws + WS_U); float* agg = (float*)(F.ws + WS_AGG);
    for (int it = F.gw; it < NB * RG_NCH * 11; it += F.NGW) {
        const int cg = it % 11, ch = (it / 11) % RG_NCH, b = it / (11 * RG_NCH), c = cg * 128 + 2 * F.lane; const size_t t0 = (size_t)b * S + (size_t)ch * RG_CH;
        f32x2 P = {1.f, 1.f}, H = {0.f, 0.f};
#pragma unroll 8
        for (int s = 0; s < RG_CH; ++s) { const f32x2 av = *(const f32x2*)(a + (t0 + s) * W + c), uv = *(const f32x2*)(u + (t0 + s) * W + c); H = av * H + uv; P = P * av; }
        const size_t o = (size_t)(b * RG_NCH + ch) * W + c; *(f32x2*)(agg + o) = P; *(f32x2*)(agg + o + (size_t)NB * RG_NCH * W) = H;
    }
}
__device__ __forceinline__ void rgscan2_phase(Frame& F) {
    const float* a = (const float*)(F.ws + WS_A); const float* u = (const float*)(F.ws + WS_U); const float* agg = (const float*)(F.ws + WS_AGG);
    const bf16_t* gate = (const bf16_t*)(F.ws + WS_GATE); bf16_t* y = (bf16_t*)(F.ws + WS_Y);
    for (int it = F.gw; it < NB * RG_NCH * 11; it += F.NGW) {
        const int cg = it % 11, ch = (it / 11) % RG_NCH, b = it / (11 * RG_NCH), c = cg * 128 + 2 * F.lane; const size_t t0 = (size_t)b * S + (size_t)ch * RG_CH;
        f32x2 H = {0.f, 0.f};
        for (int j = 0; j < ch; ++j) { const size_t o = (size_t)(b * RG_NCH + j) * W + c; const f32x2 Pj = *(const f32x2*)(agg + o), Hj = *(const f32x2*)(agg + o + (size_t)NB * RG_NCH * W); H = Pj * H + Hj; }
#pragma unroll 8
        for (int s = 0; s < RG_CH; ++s) { const size_t o = (t0 + s) * W + c; const f32x2 av = *(const f32x2*)(a + o), uv = *(const f32x2*)(u + o); H = av * H + uv;
            const unsigned gw_ = *(const unsigned*)(gate + o); *(unsigned*)(y + o) = pk2(H.x * bf_lo(gw_), H.y * bf_hi(gw_)); }
    }
}
__device__ __forceinline__ void ln_phase(Frame& F, const float* z, const float* g, const float* bb, float* xf, bf16_t* xb) {
    for (int m = F.gw; m < T; m += F.NGW) {
        const f32x4* zr = (const f32x4*)(z + (size_t)m * D) + F.lane; f32x4 v[4]; float s = 0.f;
#pragma unroll
        for (int j = 0; j < 4; ++j) { v[j] = zr[64 * j]; s += (v[j].x + v[j].y) + (v[j].z + v[j].w); }
        const float mean = wave_sum(s) * (1.f / D); float s2 = 0.f;
#pragma unroll
        for (int j = 0; j < 4; ++j) { v[j] = v[j] - mean; s2 += (v[j].x * v[j].x + v[j].y * v[j].y) + (v[j].z * v[j].z + v[j].w * v[j].w); }
        const float rstd = 1.f / sqrtf(wave_sum(s2) * (1.f / D) + LN_EPS);
#pragma unroll
        for (int j = 0; j < 4; ++j) { const int c = 4 * F.lane + 256 * j; const f32x4 o = v[j] * rstd * *(const f32x4*)(g + c) + *(const f32x4*)(bb + c);
            *(f32x4*)(xf + (size_t)m * D + c) = o; if (xb) { u32x2 w; w.x = pk2(o.x, o.y); w.y = pk2(o.z, o.w); *(u32x2*)(xb + (size_t)m * D + c) = w; } }
    }
}
__device__ __forceinline__ void ins16(float (&s)[16], float x) {
#pragma unroll
    for (int i = 0; i < 16; ++i) { const float hi = fmaxf(s[i], x); x = fminf(s[i], x); s[i] = hi; }
}
__device__ __forceinline__ void topk_phase(Frame& F, const float* sc, int* eid, float* gwt) {
    for (int it = F.gw; it < (T / 64) * 8; it += F.NGW) {
        const int tb = it >> 3, h = it & 7, t = tb * 64 + F.lane;
        float s0[16], s1[16];
#pragma unroll
        for (int i = 0; i < 16; ++i) { s0[i] = -__builtin_inff(); s1[i] = -__builtin_inff(); }
        const float* p0 = sc + ((size_t)(tb * 16 + 2 * h) * 128) * 64 + F.lane; const float* p1 = p0 + 128 * 64;
#pragma unroll 4
        for (int n = 0; n < 128; ++n) { const float v = p0[(size_t)n * 64]; ins16(s0, __builtin_bit_cast(float, (__builtin_bit_cast(unsigned, v) & ~127u) | (unsigned)(127 - n))); }
#pragma unroll 4
        for (int n = 0; n < 128; ++n) { const float v = p1[(size_t)n * 64]; ins16(s1, __builtin_bit_cast(float, (__builtin_bit_cast(unsigned, v) & ~127u) | (unsigned)(127 - n))); }
        float tt[16];
#pragma unroll
        for (int i = 0; i < 16; ++i) tt[i] = -__builtin_inff();
#pragma unroll
        for (int i = 0; i < 16; ++i)
#pragma unroll
            for (int j = 0; j < 16; ++j) if ((i + 1) * (j + 1) <= 16) { const float c = s0[i] + s1[j]; ins16(tt, __builtin_bit_cast(float, (__builtin_bit_cast(unsigned, c) & ~255u) | (unsigned)(255 - (i * 16 + j)))); }
        float e[16], sum = 0.f;
#pragma unroll
        for (int r = 0; r < 16; ++r) { e[r] = fast_exp(tt[r] - tt[0]); sum += e[r]; }
        const float inv = 1.f / sum;
        int ids[16];
#pragma unroll
        for (int r = 0; r < 16; ++r) { const unsigned code = 255u - (__builtin_bit_cast(unsigned, tt[r]) & 255u); const unsigned ci = code >> 4, cj = code & 15u; unsigned i0 = 0, i1 = 0;
#pragma unroll
            for (int i = 0; i < 16; ++i) { i0 = (ci == (unsigned)i) ? (127u - (__builtin_bit_cast(unsigned, s0[i]) & 127u)) : i0; i1 = (cj == (unsigned)i) ? (127u - (__builtin_bit_cast(unsigned, s1[i]) & 127u)) : i1; }
            ids[r] = (int)(i0 * 128u + i1); }
        int* ep = eid + (size_t)t * 128 + h * 16; float* gp = gwt + (size_t)t * 128 + h * 16;
#pragma unroll
        for (int r = 0; r < 16; r += 4) { *(int4*)(ep + r) = make_int4(ids[r], ids[r + 1], ids[r + 2], ids[r + 3]); *(f32x4*)(gp + r) = (f32x4){e[r] * inv, e[r + 1] * inv, e[r + 2] * inv, e[r + 3] * inv}; }
    }
}
__device__ __forceinline__ f32x2 fp8lo(unsigned w) { return __builtin_amdgcn_cvt_pk_f32_fp8((int)w, false); }
__device__ __forceinline__ f32x2 fp8hi(unsigned w) { return __builtin_amdgcn_cvt_pk_f32_fp8((int)w, true); }
__device__ __forceinline__ float gu_dot(const u32x4& r, const f32x2 (&xs)[8]) { f32x2 d = fp8lo(r.x) * xs[0]; d += fp8hi(r.x) * xs[1]; d += fp8lo(r.y) * xs[2]; d += fp8hi(r.y) * xs[3];
    d += fp8lo(r.z) * xs[4]; d += fp8hi(r.z) * xs[5]; d += fp8lo(r.w) * xs[6]; d += fp8hi(r.w) * xs[7]; return sum8(d.x + d.y); }
__device__ __forceinline__ void gu_phase(Frame& F, const float* xf, const int* eid, float* part) {
    const int j = F.bx & 7, sg = F.bx >> 3, lane = F.lane, e8 = lane >> 3, dch = lane & 7;
    const unsigned char* Ub = F.ws + WS_UB + (size_t)j * ((size_t)16384 * 128); float* pj = part + (size_t)j * T * 128; const unsigned lo16 = 16u * dch;
    constexpr int TPW = T / (32 * NWAVES); const int tb = sg * (T / 32) + F.wave * TPW;
    int e0 = eid[(size_t)tb * 128 + lane], e1 = eid[(size_t)tb * 128 + 64 + lane];
    f32x4 xq[4];
#pragma unroll
    for (int q = 0; q < 4; ++q) xq[q] = *(const f32x4*)(xf + (size_t)tb * D + 128 * j + 16 * dch + 4 * q);
#pragma unroll 1
    for (int it = 0; it < TPW; ++it) { const int t = tb + it;
        u32x4 ra[16];
#pragma unroll
        for (int i = 0; i < 16; ++i) { const int ia = __shfl(i < 8 ? e0 : e1, (8 * i + e8) & 63); ra[i] = *(const u32x4*)(Ub + ((unsigned)ia * 128u + lo16)); }
        f32x2 xs[8];
#pragma unroll
        for (int q = 0; q < 4; ++q) { const f32x4 x0 = xq[q] * (1.f / U_SCALE); xs[2 * q] = (f32x2){x0.x, x0.y}; xs[2 * q + 1] = (f32x2){x0.z, x0.w}; }
        const int tn = (it + 1 < TPW) ? t + 1 : t;
        e0 = eid[(size_t)tn * 128 + lane]; e1 = eid[(size_t)tn * 128 + 64 + lane];
#pragma unroll
        for (int q = 0; q < 4; ++q) xq[q] = *(const f32x4*)(xf + (size_t)tn * D + 128 * j + 16 * dch + 4 * q);
        float a0 = 0.f, a1 = 0.f;
#pragma unroll
        for (int i = 0; i < 16; ++i) { const float sa = gu_dot(ra[i], xs); if ((i & 7) == dch) { if (i < 8) a0 = sa; else a1 = sa; } }
        pj[(size_t)t * 128 + 8 * dch + e8] = a0; pj[(size_t)t * 128 + 64 + 8 * dch + e8] = a1;
    }
}
__device__ __forceinline__ void gr_phase(Frame& F, const float* part, float* gwt) {
    const size_t gt = (size_t)F.gw * 64 + F.lane, NGT = (size_t)F.NGW * 64;
    for (size_t i = gt; i < (size_t)T * 32; i += NGT) { f32x4 a = *(const f32x4*)(part + 4 * i);
#pragma unroll
        for (int jj = 1; jj < 8; ++jj) a += *(const f32x4*)(part + (size_t)jj * T * 128 + 4 * i);
        f32x4 g = *(const f32x4*)(gwt + 4 * i);
        g.x *= gelu_tanh(a.x) * (1.f / V_SCALE); g.y *= gelu_tanh(a.y) * (1.f / V_SCALE); g.z *= gelu_tanh(a.z) * (1.f / V_SCALE); g.w *= gelu_tanh(a.w) * (1.f / V_SCALE);
        *(f32x4*)(gwt + 4 * i) = g; }
}
__device__ __forceinline__ void gv_acc(f32x2 (&acc)[8], const u32x4& r, const float c) { const f32x2 c2 = {c, c};
    acc[0] += c2 * fp8lo(r.x); acc[1] += c2 * fp8hi(r.x); acc[2] += c2 * fp8lo(r.y); acc[3] += c2 * fp8hi(r.y); acc[4] += c2 * fp8lo(r.z); acc[5] += c2 * fp8hi(r.z); acc[6] += c2 * fp8lo(r.w); acc[7] += c2 * fp8hi(r.w); }
__device__ __forceinline__ void gv_phase(Frame& F, const float* xf, const int* eid, const float* coef, float* z) {
    const int j = F.bx & 7, sg = F.bx >> 3, lane = F.lane, e8 = lane >> 3, dch = lane & 7;
    const unsigned char* Vb = F.ws + WS_VB + (size_t)j * ((size_t)16384 * 128); const unsigned lo16 = 16u * dch;
    const bool b3 = lane & 8, b4 = lane & 16, b5 = lane & 32;
    const int dd = 128 * j + 16 * dch + 2 * ((b3 ? 4 : 0) + (b4 ? 2 : 0) + (b5 ? 1 : 0));
    constexpr int TPW = T / (32 * NWAVES); const int tb = sg * (T / 32) + F.wave * TPW;
    int e0 = eid[(size_t)tb * 128 + lane], e1 = eid[(size_t)tb * 128 + 64 + lane]; float c0 = coef[(size_t)tb * 128 + lane], c1 = coef[(size_t)tb * 128 + 64 + lane];
    f32x2 xr = *(const f32x2*)(xf + (size_t)tb * D + dd);
#pragma unroll 1
    for (int it = 0; it < TPW; ++it) { const int t = tb + it;
        u32x4 ra[16]; float cf[16];
#pragma unroll
        for (int i = 0; i < 16; ++i) { const int ia = __shfl(i < 8 ? e0 : e1, (8 * i + e8) & 63); ra[i] = *(const u32x4*)(Vb + ((unsigned)ia * 128u + lo16)); cf[i] = __shfl(i < 8 ? c0 : c1, (8 * i + e8) & 63); }
        const f32x2 xcur = xr; const int tn = (it + 1 < TPW) ? t + 1 : t;
        e0 = eid[(size_t)tn * 128 + lane]; e1 = eid[(size_t)tn * 128 + 64 + lane]; c0 = coef[(size_t)tn * 128 + lane]; c1 = coef[(size_t)tn * 128 + 64 + lane];
        xr = *(const f32x2*)(xf + (size_t)tn * D + dd);
        f32x2 acc[8];
#pragma unroll
        for (int m = 0; m < 8; ++m) acc[m] = (f32x2){0.f, 0.f};
#pragma unroll
        for (int i = 0; i < 16; ++i) gv_acc(acc, ra[i], cf[i]);
        f32x2 q[4], p[2], v;
#pragma unroll
        for (int i = 0; i < 4; ++i) { const f32x2 keep = b3 ? acc[4 + i] : acc[i], send = b3 ? acc[i] : acc[4 + i]; q[i] = keep + (f32x2){dpp_f<DPP_ROW_ROR(8)>(send.x), dpp_f<DPP_ROW_ROR(8)>(send.y)}; }
#pragma unroll
        for (int i = 0; i < 2; ++i) { const f32x2 keep = b4 ? q[2 + i] : q[i], send = b4 ? q[i] : q[2 + i]; p[i] = keep + (f32x2){__shfl_xor(send.x, 16), __shfl_xor(send.y, 16)}; }
        { const f32x2 keep = b5 ? p[1] : p[0], send = b5 ? p[0] : p[1]; v = keep + (f32x2){__shfl_xor(send.x, 32), __shfl_xor(send.y, 32)}; }
        *(f32x2*)(z + (size_t)t * D + dd) = xcur * ALPHA + v;
    }
}
__device__ __forceinline__ void mix_phase(Frame& F, const float* mix) {
    const float* xf = (const float*)(F.ws + WS_XF); bf16_t* mx = (bf16_t*)(F.ws + WS_MIX);
    const size_t gt = (size_t)F.gw * 64 + F.lane, NGT = (size_t)F.NGW * 64;
    for (size_t i = gt; i < (size_t)T * (D / 8); i += NGT) {
        const int t = (int)(i >> 7), c = (int)(i & 127) * 8, s = t & (S - 1);
        const f32x4 x0 = *(const f32x4*)(xf + (size_t)t * D + c), x1 = *(const f32x4*)(xf + (size_t)t * D + c + 4);
        f32x4 p0 = {0.f, 0.f, 0.f, 0.f}, p1 = p0;
        if (s > 0) { p0 = *(const f32x4*)(xf + (size_t)(t - 1) * D + c); p1 = *(const f32x4*)(xf + (size_t)(t - 1) * D + c + 4); }
        const f32x4 d0 = p0 - x0, d1 = p1 - x1;
#pragma unroll
        for (int m = 0; m < 6; ++m) { const f32x4 m0 = *(const f32x4*)(mix + m * D + c), m1 = *(const f32x4*)(mix + m * D + c + 4); const f32x4 o0 = x0 + d0 * m0, o1 = x1 + d1 * m1;
            u32x4 o; o.x = pk2(o0.x, o0.y); o.y = pk2(o0.z, o0.w); o.z = pk2(o1.x, o1.y); o.w = pk2(o1.z, o1.w);
            *(u32x4*)(mx + (size_t)m * ((size_t)T * D) + (size_t)t * D + c) = o; }
    }
}
typedef float f32x16 __attribute__((ext_vector_type(16)));
constexpr int RWL = 32, RW_NCH = S / RWL;
constexpr int PK_A2 = 0, PK_RT = 4096, PK_MBR = 8192, PK_BH = 10240, PK_N2 = 14336, PK_MKR = 16384, PK_KH = 18432, PK_VT = 22528, PK_GL = 26624, PK_BON = 26880, PK_BYTES = 27648;
constexpr size_t PK_BATCH = (size_t)1024 * PK_BYTES;
__device__ __forceinline__ unsigned char* pack_ptr(unsigned char* ws, float* out, int b, int hc) {
    unsigned char* base = b < 2 ? ws + 34 * MiB + (size_t)b * PK_BATCH : (b == 2 ? ws + 322 * MiB : (b < 6 ? ws + 414 * MiB + (size_t)(b - 3) * PK_BATCH : (unsigned char*)out + (size_t)(b - 6) * PK_BATCH));
    return base + (size_t)hc * PK_BYTES;
}
__device__ __forceinline__ bf16x8 frag_acc(const f32x16& x, const int s) {
    u32x4 w; w.x = cvt_pk_bf16_c(x[8 * s + 0], x[8 * s + 1]); w.y = cvt_pk_bf16_c(x[8 * s + 2], x[8 * s + 3]); w.z = cvt_pk_bf16_c(x[8 * s + 4], x[8 * s + 5]); w.w = cvt_pk_bf16_c(x[8 * s + 6], x[8 * s + 7]);
    return __builtin_bit_cast(bf16x8, w);
}
__device__ __forceinline__ f32x16 mfma32(bf16x8 a, bf16x8 b, f32x16 c) { return __builtin_amdgcn_mfma_f32_32x32x16_bf16(a, b, c, 0, 0, 0); }
__device__ __forceinline__ float wave_sum_fast(float v) { v = sum16(v); v += __shfl_xor(v, 16); v += __shfl_xor(v, 32); return v; }
#define F16ZERO (f32x16){0.f,0.f,0.f,0.f,0.f,0.f,0.f,0.f,0.f,0.f,0.f,0.f,0.f,0.f,0.f,0.f}

__device__ __forceinline__ void rwprep_phase(Frame& F, const Args& args, const int nbatch) {
    const int lane0 = F.lane;
    LAS unsigned char* wl = F.lds + F.wave * 18432;
    const bf16_t* R = (const bf16_t*)(F.ws + WS_R); const bf16_t* Kt_ = (const bf16_t*)(F.ws + WS_K); const bf16_t* Vt_ = (const bf16_t*)(F.ws + WS_V);
    const bf16_t* AA = (const bf16_t*)(F.ws + WS_AA); const float* WD = (const float*)(F.ws + WS_WDEC);
    for (int it = F.gw; it < nbatch * NH * RW_NCH; it += F.NGW) {
        int lane = lane0; asm volatile("" : "+v"(lane));
        const int r = lane & 31, hh = lane >> 5;
        const int b = it / (NH * RW_NCH), hc = it % (NH * RW_NCH), h = hc / RW_NCH, c = hc % RW_NCH, ch = h * 64 + lane;
        unsigned char* pk = pack_ptr(F.ws, F.out, b, hc);
        const float kkc = args.in[22][ch], kac = args.in[23][ch], rkc = args.in[24][ch];
        const size_t tok0 = (size_t)b * S + (size_t)c * RWL;
        const int posj = 16 * (lane >> 4) + ((lane & 3) | ((lane & 4) << 1) | ((lane & 8) >> 1));
        float gam = 1.f, bon = 0.f;
#pragma unroll 1
        for (int blk = 0; blk < 2; ++blk) {
            unsigned short rr[16], kr[16], ar[16]; float wv[16];
#pragma unroll
            for (int q = 0; q < 16; ++q) { const size_t off = (tok0 + 16 * blk + q) * D + ch; rr[q] = R[off]; kr[q] = Kt_[off]; ar[q] = AA[off]; wv[q] = WD[off]; }
#pragma unroll
            for (int q = 0; q < 16; ++q) { const int t = 16 * blk + q;
                const float rv = __builtin_bit_cast(float, (unsigned)rr[q] << 16), kv = __builtin_bit_cast(float, (unsigned)kr[q] << 16), al = __builtin_bit_cast(float, (unsigned)ar[q] << 16), w = wv[q];
                const float kkr = kv * kkc; const float ss = wave_sum_fast(kkr * kkr); const float kk = kkr / fmaxf(sqrtf(ss), 1e-12f);
                const float km = kv * (1.f + (al - 1.f) * kac);
                const float bs = wave_sum_fast(rv * km * rkc); bon = (lane == t) ? bs : bon;
                const float at = gam * (-kk); gam *= w; const float inv = 1.f / gam;
                const float bt = kk * al * inv, ktv = km * inv, rt = gam * rv;
                *(LAS bf16_t*)(wl + 0 + t * 144 + lane * 2) = (bf16_t)f2bf(at); *(LAS bf16_t*)(wl + 4608 + t * 144 + lane * 2) = (bf16_t)f2bf(bt);
                *(LAS bf16_t*)(wl + 9216 + t * 144 + lane * 2) = (bf16_t)f2bf(ktv); *(LAS bf16_t*)(wl + 13824 + t * 144 + lane * 2) = (bf16_t)f2bf(rt);
                *(bf16_t*)(pk + PK_RT + t * 128 + posj * 2) = (bf16_t)f2bf(rt);
            }
        }
        const float gamL = gam;
        *(float*)(pk + PK_GL + lane * 4) = gamL; if (lane < 32) *(float*)(pk + PK_BON + lane * 4) = bon;
#pragma unroll
        for (int m = 0; m < 4; ++m) { unsigned short e[8];
#pragma unroll
            for (int q = 0; q < 8; ++q) e[q] = Vt_[(tok0 + 8 * m + q) * D + ch];
            u32x4 o; o.x = e[0] | ((unsigned)e[1] << 16); o.y = e[2] | ((unsigned)e[3] << 16); o.z = e[4] | ((unsigned)e[5] << 16); o.w = e[6] | ((unsigned)e[7] << 16);
            *(u32x4*)(pk + PK_VT + lane * 64 + m * 16) = o; }
        LDS_WAIT(); asm volatile("" ::: "memory");
        bf16x8 idf[2];
#pragma unroll
        for (int s = 0; s < 2; ++s) { unsigned e[8];
#pragma unroll
            for (int j = 0; j < 8; ++j) e[j] = (r == 16 * s + 8 * hh + j) ? 0x3F80u : 0u;
            u32x4 w; w.x = e[0] | (e[1] << 16); w.y = e[2] | (e[3] << 16); w.z = e[4] | (e[5] << 16); w.w = e[6] | (e[7] << 16); idf[s] = __builtin_bit_cast(bf16x8, w); }
        bf16x8 xaf[2][2];
#pragma unroll
        for (int kt = 0; kt < 2; ++kt) {
            const int fo = r * 144 + (2 * kt) * 32 + hh * 16;
            f32x16 xb = F16ZERO, xk = F16ZERO, xa = F16ZERO;
            xb = mfma32(*(const LAS bf16x8*)(wl + 4608 + fo), idf[0], xb); xb = mfma32(*(const LAS bf16x8*)(wl + 4608 + fo + 32), idf[1], xb);
            xk = mfma32(*(const LAS bf16x8*)(wl + 9216 + fo), idf[0], xk); xk = mfma32(*(const LAS bf16x8*)(wl + 9216 + fo + 32), idf[1], xk);
            xa = mfma32(*(const LAS bf16x8*)(wl + 0 + fo), idf[0], xa); xa = mfma32(*(const LAS bf16x8*)(wl + 0 + fo + 32), idf[1], xa);
            xaf[kt][0] = frag_acc(xa, 0); xaf[kt][1] = frag_acc(xa, 1);
            const float gl = __shfl(gamL, 32 * kt + r);
#pragma unroll
            for (int g = 0; g < 4; ++g) {
                u32x2 w1; w1.x = pk2(xb[4 * g] * gl, xb[4 * g + 1] * gl); w1.y = pk2(xb[4 * g + 2] * gl, xb[4 * g + 3] * gl);
                *(u32x2*)(pk + PK_BH + (32 * kt + r) * 64 + 2 * (16 * (g >> 1) + 8 * hh + 4 * (g & 1))) = w1;
                u32x2 w2; w2.x = pk2(xk[4 * g] * gl, xk[4 * g + 1] * gl); w2.y = pk2(xk[4 * g + 2] * gl, xk[4 * g + 3] * gl);
                *(u32x2*)(pk + PK_KH + (32 * kt + r) * 64 + 2 * (8 * g + 4 * hh)) = w2; }
        }
        f32x16 pBA = F16ZERO, pBR = F16ZERO, pKR = F16ZERO, qAK = F16ZERO;
#pragma unroll
        for (int ks = 0; ks < 4; ++ks) {
            const int fo = r * 144 + ks * 32 + hh * 16;
            const bf16x8 fA = *(const LAS bf16x8*)(wl + 0 + fo), fB = *(const LAS bf16x8*)(wl + 4608 + fo), fK = *(const LAS bf16x8*)(wl + 9216 + fo), fR = *(const LAS bf16x8*)(wl + 13824 + fo);
            pBA = mfma32(fB, fA, pBA);
            pBR = mfma32(fB, fR, pBR);
            pKR = mfma32(fK, fR, pKR);
            qAK = mfma32(fA, fK, qAK);
        }
        LDS_WAIT(); asm volatile("" ::: "memory");
#pragma unroll
        for (int g = 0; g < 4; ++g) {
            float mb[4], mkv[4];
#pragma unroll
            for (int d = 0; d < 4; ++d) { const int reg = 4 * g + d, row = d + 8 * g + 4 * hh;
                *(LAS float*)(wl + 13824 + row * 144 + r * 4) = (row < r) ? pBA[reg] : 0.f;
                mb[d] = (row <= r) ? pBR[reg] : 0.f; mkv[d] = (row <= r) ? pKR[reg] : 0.f;
                qAK[reg] = (r < row) ? qAK[reg] : 0.f; }
            u32x2 w1; w1.x = pk2(mb[0], mb[1]); w1.y = pk2(mb[2], mb[3]); *(u32x2*)(pk + PK_MBR + r * 64 + 2 * (16 * (g >> 1) + 8 * hh + 4 * (g & 1))) = w1;
            u32x2 w2; w2.x = pk2(mkv[0], mkv[1]); w2.y = pk2(mkv[2], mkv[3]); *(u32x2*)(pk + PK_MKR + r * 64 + 2 * (8 * g + 4 * hh)) = w2;
        }
        *(LAS bf16x8*)(wl + lane * 96) = frag_acc(qAK, 0); *(LAS bf16x8*)(wl + lane * 96 + 16) = frag_acc(qAK, 1);
        *(LAS bf16x8*)(wl + lane * 96 + 32) = xaf[0][0]; *(LAS bf16x8*)(wl + lane * 96 + 48) = xaf[0][1]; *(LAS bf16x8*)(wl + lane * 96 + 64) = xaf[1][0]; *(LAS bf16x8*)(wl + lane * 96 + 80) = xaf[1][1];
        LDS_WAIT(); asm volatile("" ::: "memory");
        float tt[32]; int lmo = 13824;
#pragma unroll
        for (int cc = 31; cc >= 0; --cc) { float acc = (r == cc) ? 1.f : 0.f;
            if (cc < 31 && (cc & 1)) asm volatile("" : "+v"(lmo) : "v"(tt[cc + 1]));
#pragma unroll
            for (int q4 = 0; q4 < 8; ++q4) { if (4 * q4 + 3 > cc) { const f32x4 lm = *(const LAS f32x4*)(wl + lmo + cc * 144 + q4 * 16);
#pragma unroll
                for (int d = 0; d < 4; ++d) { const int i = 4 * q4 + d; if (i > cc) acc += tt[i] * lm[d]; } } }
            tt[cc] = acc; }
        f32x16 a2t0 = F16ZERO, a2t1 = F16ZERO, n2t = F16ZERO;
#pragma unroll
        for (int s = 0; s < 2; ++s) {
            float p[8];
#pragma unroll
            for (int j = 0; j < 8; ++j) p[j] = hh ? tt[16 * s + 8 * (j >> 2) + 4 + (j & 3)] : tt[16 * s + 8 * (j >> 2) + (j & 3)];
            u32x4 wp; wp.x = pk2(p[0], p[1]); wp.y = pk2(p[2], p[3]); wp.z = pk2(p[4], p[5]); wp.w = pk2(p[6], p[7]);
            const bf16x8 fTp = __builtin_bit_cast(bf16x8, wp);
            a2t0 = mfma32(*(const LAS bf16x8*)(wl + lane * 96 + 32 + 16 * s), fTp, a2t0); a2t1 = mfma32(*(const LAS bf16x8*)(wl + lane * 96 + 64 + 16 * s), fTp, a2t1);
            n2t = mfma32(*(const LAS bf16x8*)(wl + lane * 96 + 16 * s), fTp, n2t);
        }
#pragma unroll
        for (int g = 0; g < 4; ++g) {
            u32x2 w0; w0.x = pk2(a2t0[4 * g], a2t0[4 * g + 1]); w0.y = pk2(a2t0[4 * g + 2], a2t0[4 * g + 3]);
            u32x2 w1; w1.x = pk2(a2t1[4 * g], a2t1[4 * g + 1]); w1.y = pk2(a2t1[4 * g + 2], a2t1[4 * g + 3]);
            *(u32x2*)(pk + PK_A2 + r * 128 + 2 * (16 * (0 + (g >> 1)) + 8 * hh + 4 * (g & 1))) = w0;
            *(u32x2*)(pk + PK_A2 + r * 128 + 2 * (16 * (2 + (g >> 1)) + 8 * hh + 4 * (g & 1))) = w1;
            u32x2 w2; w2.x = pk2(n2t[4 * g], n2t[4 * g + 1]); w2.y = pk2(n2t[4 * g + 2], n2t[4 * g + 3]);
            *(u32x2*)(pk + PK_N2 + r * 64 + 2 * (8 * g + 4 * hh)) = w2;
        }
        LDS_WAIT(); asm volatile("" ::: "memory");
    }
}

constexpr int SC_OBUF = 4 * PK_BYTES, SC_BON = SC_OBUF + 2 * 8192;
__device__ __forceinline__ void rwscan2_phase(Frame& F, const Args& args, bf16_t* OG, const int nbatch) {
    const int bx = F.bx; if (bx >= nbatch * NH) return;
    const int b = bx >> 4, h = bx & 15, lane = F.lane, r = lane & 31, hh = lane >> 5, wave = F.wave;
    const bf16_t* Vt_ = (const bf16_t*)(F.ws + WS_V); const bf16_t* G = (const bf16_t*)(F.ws + WS_G);
    const unsigned char* pk0 = pack_ptr(F.ws, F.out, b, h * RW_NCH);
    LAS unsigned char* lds = F.lds;
    const int dp0 = wave == 6 ? 0 : 14, dpn = wave == 6 ? 14 : 13;
#define SC_DMA(chunk) do { const unsigned char* src_ = pk0 + (size_t)(chunk) * PK_BYTES + lane * 16; LAS unsigned char* dst_ = lds + ((chunk) & 3) * PK_BYTES; \
        _Pragma("unroll") for (int p_ = 0; p_ < 14; ++p_) if (p_ < dpn) __builtin_amdgcn_global_load_lds((const unsigned*)(src_ + (dp0 + p_) * 1024), (LAS unsigned*)(dst_ + (dp0 + p_) * 1024), 16, 0, 0); } while (0)
#define SC_WAIT(k) do { if (wave == 6) { if ((k) == 2) asm volatile("s_waitcnt vmcnt(28)" ::: "memory"); else if ((k) == 1) asm volatile("s_waitcnt vmcnt(14)" ::: "memory"); else asm volatile("s_waitcnt vmcnt(0)" ::: "memory"); } \
        else { if ((k) == 2) asm volatile("s_waitcnt vmcnt(26)" ::: "memory"); else if ((k) == 1) asm volatile("s_waitcnt vmcnt(13)" ::: "memory"); else asm volatile("s_waitcnt vmcnt(0)" ::: "memory"); } } while (0)
    f32x16 Z0 = F16ZERO, Z1 = F16ZERO;
    if (wave >= 6) { SC_DMA(0); SC_DMA(1); SC_DMA(2); SC_WAIT(2); }
    asm volatile("" ::: "memory"); __builtin_amdgcn_s_barrier(); asm volatile("" ::: "memory");
    for (int c = 0; c <= RW_NCH; ++c) {
        if (wave >= 6) {
            if (c + 3 < RW_NCH) { SC_DMA(c + 3); SC_WAIT(2); } else if (c + 2 < RW_NCH) { SC_WAIT(1); } else { SC_WAIT(0); }
        } else if (wave < 2) {
            if (c < RW_NCH) {
                const LAS unsigned char* sl = lds + (c & 3) * PK_BYTES; const int vh = wave;
                const bf16x8 zb0 = frag_acc(Z0, 0), zb1 = frag_acc(Z0, 1), zb2 = frag_acc(Z1, 0), zb3 = frag_acc(Z1, 1);
                const bf16x8 vt0 = *(const LAS bf16x8*)(sl + PK_VT + (32 * vh + r) * 64 + hh * 16), vt1 = *(const LAS bf16x8*)(sl + PK_VT + (32 * vh + r) * 64 + 32 + hh * 16);
                f32x16 U = F16ZERO, O = F16ZERO;
                { const LAS unsigned char* pa = sl + PK_A2 + r * 128 + hh * 16; const LAS unsigned char* pr = sl + PK_RT + r * 128 + hh * 16;
                  U = mfma32(*(const LAS bf16x8*)(pa), zb0, U); U = mfma32(*(const LAS bf16x8*)(pa + 32), zb1, U); U = mfma32(*(const LAS bf16x8*)(pa + 64), zb2, U); U = mfma32(*(const LAS bf16x8*)(pa + 96), zb3, U);
                  const LAS unsigned char* pn = sl + PK_N2 + r * 64 + hh * 16; U = mfma32(*(const LAS bf16x8*)(pn), vt0, U); U = mfma32(*(const LAS bf16x8*)(pn + 32), vt1, U);
                  O = mfma32(*(const LAS bf16x8*)(pr), zb0, O); O = mfma32(*(const LAS bf16x8*)(pr + 32), zb1, O); O = mfma32(*(const LAS bf16x8*)(pr + 64), zb2, O); O = mfma32(*(const LAS bf16x8*)(pr + 96), zb3, O);
                  const LAS unsigned char* pm = sl + PK_MKR + r * 64 + hh * 16; O = mfma32(*(const LAS bf16x8*)(pm), vt0, O); O = mfma32(*(const LAS bf16x8*)(pm + 32), vt1, O); }
                const bf16x8 ub0 = frag_acc(U, 0), ub1 = frag_acc(U, 1);
                { const LAS unsigned char* pb = sl + PK_MBR + r * 64 + hh * 16; O = mfma32(*(const LAS bf16x8*)(pb), ub0, O); O = mfma32(*(const LAS bf16x8*)(pb + 32), ub1, O); }
#pragma unroll
                for (int g = 0; g < 4; ++g) { const f32x4 g0 = *(const LAS f32x4*)(sl + PK_GL + 4 * (8 * g + 4 * hh)), g1 = *(const LAS f32x4*)(sl + PK_GL + 4 * (32 + 8 * g + 4 * hh));
#pragma unroll
                    for (int d = 0; d < 4; ++d) { Z0[4 * g + d] *= g0[d]; Z1[4 * g + d] *= g1[d]; } }
                { const LAS unsigned char* pb = sl + PK_BH + r * 64 + hh * 16; const LAS unsigned char* pkk = sl + PK_KH + r * 64 + hh * 16;
                  Z0 = mfma32(*(const LAS bf16x8*)(pb), ub0, Z0); Z0 = mfma32(*(const LAS bf16x8*)(pb + 32), ub1, Z0); Z0 = mfma32(*(const LAS bf16x8*)(pkk), vt0, Z0); Z0 = mfma32(*(const LAS bf16x8*)(pkk + 32), vt1, Z0);
                  Z1 = mfma32(*(const LAS bf16x8*)(pb + 2048), ub0, Z1); Z1 = mfma32(*(const LAS bf16x8*)(pb + 2048 + 32), ub1, Z1); Z1 = mfma32(*(const LAS bf16x8*)(pkk + 2048), vt0, Z1); Z1 = mfma32(*(const LAS bf16x8*)(pkk + 2048 + 32), vt1, Z1); }
                LAS float* ob = (LAS float*)(lds + SC_OBUF + (c & 1) * 8192);
#pragma unroll
                for (int reg = 0; reg < 16; ++reg) ob[((reg & 3) + 8 * (reg >> 2) + 4 * hh) * 64 + 32 * vh + r] = O[reg];
                if (vh == 0 && lane < 32) ((LAS float*)(lds + SC_BON))[(c & 1) * 32 + lane] = *(const LAS float*)(sl + PK_BON + lane * 4);
            }
        } else if (c >= 1) {
            const LAS float* ob = (const LAS float*)(lds + SC_OBUF + ((c - 1) & 1) * 8192); const LAS float* bn = (const LAS float*)(lds + SC_BON) + ((c - 1) & 1) * 32;
            for (int u = (wave - 2) * 64 + lane; u < 512; u += 256) {
                const int t = u >> 4, q = u & 15, c4 = h * 64 + 4 * q; const size_t off = ((size_t)b * S + (size_t)(c - 1) * RWL + t) * D + c4;
                const f32x4 o4 = *(const LAS f32x4*)(ob + t * 64 + 4 * q); const float bs = bn[t];
                const u32x2 vw = *(const u32x2*)(Vt_ + off), gw_ = *(const u32x2*)(G + off); const f32x4 lg4 = *(const f32x4*)(args.in[25] + c4), lb4 = *(const f32x4*)(args.in[26] + c4);
                float sm = (o4.x + o4.y) + (o4.z + o4.w); sm = sum16(sm); const float mu = sm * (1.f / 64.f); const f32x4 dd = o4 - mu;
                float vs = (dd.x * dd.x + dd.y * dd.y) + (dd.z * dd.z + dd.w * dd.w); vs = sum16(vs); const float rs = 1.f / sqrtf(vs * (1.f / 64.f) + 64e-5f);
                const f32x4 v4 = {bf_lo(vw.x), bf_hi(vw.x), bf_lo(vw.y), bf_hi(vw.y)}, g4 = {bf_lo(gw_.x), bf_hi(gw_.x), bf_lo(gw_.y), bf_hi(gw_.y)};
                const f32x4 res = (dd * rs * lg4 + lb4 + v4 * bs) * g4;
                u32x2 w; w.x = pk2(res.x, res.y); w.y = pk2(res.z, res.w); *(u32x2*)(OG + off) = w;
            }
        }
        asm volatile("s_waitcnt lgkmcnt(0)" ::: "memory");
        __builtin_amdgcn_s_barrier();
        asm volatile("" ::: "memory");
    }
#undef SC_DMA
#undef SC_WAIT
}
}
namespace mk {
constexpr int NPH = 27;
#ifndef MK_NBATCH
#define MK_NBATCH 8
#endif
#ifndef MK_MASK
#define MK_MASK 0xFFFFFFFFull
#endif
#ifndef MK_REP
#define MK_REP 0ull
#endif
#ifndef MK_NREP
#define MK_NREP 2
#endif
__global__ void __launch_bounds__(NTHREADS, 2) mk_fwd(Args args) {
    extern __shared__ __attribute__((aligned(16))) unsigned char lds_raw[];
    { volatile LAS unsigned* M0 = (volatile LAS unsigned*)((LAS unsigned char*)lds_raw + MISC_OFF); if (threadIdx.x < 64) M0[threadIdx.x] = 0u; }
    __syncthreads();
    const int lo = args.ph_lo, hi = args.ph_hi;
    const int wave0 = __builtin_amdgcn_readfirstlane((int)threadIdx.x >> 6);
    if (hi - lo > 1) (void)xcd_barrier_post((unsigned*)(args.ws + WS_CTL) + CW_BAR, (volatile LAS unsigned*)((LAS unsigned char*)lds_raw + MISC_OFF) + 8);
#define MKFRAME() \
        int lane_ = lane_id(), bx_ = blockIdx.x; asm volatile("" : "+v"(lane_)); asm volatile("" : "+s"(bx_)); \
        Frame F; F.lds = (LAS unsigned char*)lds_raw; F.MISC = (volatile LAS unsigned*)(F.lds + MISC_OFF); \
        F.lane = lane_; F.wave = wave0; F.tid = wave0 * 64 + lane_; F.bx = bx_; \
        F.G = gridDim.x; F.vcu = (F.G % 8 == 0) ? (bx_ % 8) * (F.G / 8) + bx_ / 8 : bx_; \
        F.gw = F.vcu * NWAVES + F.wave; F.NGW = F.G * NWAVES; \
        F.ws = args.ws; F.ctl = (unsigned*)(args.ws + WS_CTL); F.out = args.out; unsigned char* ws = F.ws; (void)ws;
#define INP(k) (args.in[k])
#define IN(k) (((MK_MASK >> (k)) & 1) && lo <= (k) && (k) < hi)
#define FORCE_BAR() do { XcdBarrier bar; bar.bar = (unsigned*)(args.ws + WS_CTL) + CW_BAR; bar.x = xb_xcc_id(); bar.st = (volatile LAS unsigned*)((LAS unsigned char*)lds_raw + MISC_OFF) + 8; xcd_barrier(bar, wave0 == 0 && lane_id() == 0); } while (0)
#define SEAM(k) do { if (lo <= (k) && (k) + 1 < hi) FORCE_BAR(); } while (0)
    if (IN(0)) { MKFRAME() asm volatile("; PHASE_BEGIN 0"); p0_prologue(F, args); }
    SEAM(0);
    if (((MK_REP >> 0) & 1) && IN(0)) { for (int rep_ = 0; rep_ < MK_NREP; ++rep_) { { MKFRAME() p0_prologue(F, args); } FORCE_BAR(); } }
    if (IN(1)) { MKFRAME() asm volatile("; PHASE_BEGIN 1"); { ProbPlain P{(const char*)(ws + WS_X0B), (const char*)(ws + WS_WIN), (size_t)256 * D * 2, (size_t)256 * D * 2}; EpiWin E{(bf16_t*)(ws + WS_GATE), (bf16_t*)(ws + WS_H2)}; run_gemm(F, 64, 11, D, D, D, P, E); } }
    SEAM(1);
    if (((MK_REP >> 1) & 1) && IN(1)) { for (int rep_ = 0; rep_ < MK_NREP; ++rep_) { { MKFRAME() { ProbPlain P{(const char*)(ws + WS_X0B), (const char*)(ws + WS_WIN), (size_t)256 * D * 2, (size_t)256 * D * 2}; EpiWin E{(bf16_t*)(ws + WS_GATE), (bf16_t*)(ws + WS_H2)}; run_gemm(F, 64, 11, D, D, D, P, E); } } FORCE_BAR(); } }
    if (IN(2)) { MKFRAME() asm volatile("; PHASE_BEGIN 2"); conv_phase(F, INP(2), INP(3)); }
    SEAM(2);
    if (((MK_REP >> 2) & 1) && IN(2)) { for (int rep_ = 0; rep_ < MK_NREP; ++rep_) { { MKFRAME() conv_phase(F, INP(2), INP(3)); } FORCE_BAR(); } }
    if (IN(3)) { MKFRAME() asm volatile("; PHASE_BEGIN 3"); { ProbGates P{(const char*)(ws + WS_XC), (const char*)(ws + WS_WG)}; EpiGates E{(const bf16_t*)(ws + WS_XC), (const float*)(ws + WS_VEC), INP(5), INP(7), (float*)(ws + WS_A), (float*)(ws + WS_U)}; run_gemm(F, 64, 11, W, 384, 384, P, E); } }
    SEAM(3);
    if (((MK_REP >> 3) & 1) && IN(3)) { for (int rep_ = 0; rep_ < MK_NREP; ++rep_) { { MKFRAME() { ProbGates P{(const char*)(ws + WS_XC), (const char*)(ws + WS_WG)}; EpiGates E{(const bf16_t*)(ws + WS_XC), (const float*)(ws + WS_VEC), INP(5), INP(7), (float*)(ws + WS_A), (float*)(ws + WS_U)}; run_gemm(F, 64, 11, W, 384, 384, P, E); } } FORCE_BAR(); } }
    if (IN(4)) { MKFRAME() asm volatile("; PHASE_BEGIN 4"); rgscan1_phase(F); }
    SEAM(4);
    if (((MK_REP >> 4) & 1) && IN(4)) { for (int rep_ = 0; rep_ < MK_NREP; ++rep_) { { MKFRAME() rgscan1_phase(F); } FORCE_BAR(); } }
    if (IN(5)) { MKFRAME() asm volatile("; PHASE_BEGIN 5"); rgscan2_phase(F); }
    SEAM(5);
    if (((MK_REP >> 5) & 1) && IN(5)) { for (int rep_ = 0; rep_ < MK_NREP; ++rep_) { { MKFRAME() rgscan2_phase(F); } FORCE_BAR(); } }
    if (IN(6)) { MKFRAME() asm volatile("; PHASE_BEGIN 6"); { ProbPlain P{(const char*)(ws + WS_Y), (const char*)(ws + WS_WOUT), (size_t)256 * W * 2, (size_t)256 * W * 2}; EpiRes E{INP(0), (float*)(ws + WS_Z0)}; run_gemm(F, 64, 4, W, W, W, P, E); } }
    SEAM(6);
    if (((MK_REP >> 6) & 1) && IN(6)) { for (int rep_ = 0; rep_ < MK_NREP; ++rep_) { { MKFRAME() { ProbPlain P{(const char*)(ws + WS_Y), (const char*)(ws + WS_WOUT), (size_t)256 * W * 2, (size_t)256 * W * 2}; EpiRes E{INP(0), (float*)(ws + WS_Z0)}; run_gemm(F, 64, 4, W, W, W, P, E); } } FORCE_BAR(); } }
    if (IN(7)) { MKFRAME() asm volatile("; PHASE_BEGIN 7"); ln_phase(F, (const float*)(ws + WS_Z0), INP(32), INP(33), (float*)(ws + WS_XF), (bf16_t*)(ws + WS_XB0)); }
    SEAM(7);
    if (((MK_REP >> 7) & 1) && IN(7)) { for (int rep_ = 0; rep_ < MK_NREP; ++rep_) { { MKFRAME() ln_phase(F, (const float*)(ws + WS_Z0), INP(32), INP(33), (float*)(ws + WS_XF), (bf16_t*)(ws + WS_XB0)); } FORCE_BAR(); } }
    if (IN(8)) { MKFRAME() asm volatile("; PHASE_BEGIN 8"); { ProbPlain P{(const char*)(ws + WS_XB0), (const char*)(ws + WS_WPEER), (size_t)256 * D * 2, (size_t)256 * D * 2}; EpiScores E{(float*)(ws + WS_SC0)}; run_gemm(F, 64, 8, D, D, D, P, E); } }
    SEAM(8);
    if (((MK_REP >> 8) & 1) && IN(8)) { for (int rep_ = 0; rep_ < MK_NREP; ++rep_) { { MKFRAME() { ProbPlain P{(const char*)(ws + WS_XB0), (const char*)(ws + WS_WPEER), (size_t)256 * D * 2, (size_t)256 * D * 2}; EpiScores E{(float*)(ws + WS_SC0)}; run_gemm(F, 64, 8, D, D, D, P, E); } } FORCE_BAR(); } }
    if (IN(9)) { MKFRAME() asm volatile("; PHASE_BEGIN 9"); topk_phase(F, (const float*)(ws + WS_SC0), (int*)(ws + WS_EID0), (float*)(ws + WS_GW0)); }
    SEAM(9);
    if (((MK_REP >> 9) & 1) && IN(9)) { for (int rep_ = 0; rep_ < MK_NREP; ++rep_) { { MKFRAME() topk_phase(F, (const float*)(ws + WS_SC0), (int*)(ws + WS_EID0), (float*)(ws + WS_GW0)); } FORCE_BAR(); } }
    if (IN(10)) { MKFRAME() asm volatile("; PHASE_BEGIN 10"); gu_phase(F, (const float*)(ws + WS_XF), (const int*)(ws + WS_EID0), (float*)(ws + WS_PART0)); }
    SEAM(10);
    if (IN(11)) { MKFRAME() asm volatile("; PHASE_BEGIN 11"); gr_phase(F, (const float*)(ws + WS_PART0), (float*)(ws + WS_GW0)); }
    SEAM(11);
    if (IN(12)) { MKFRAME() asm volatile("; PHASE_BEGIN 12"); gv_phase(F, (const float*)(ws + WS_XF), (const int*)(ws + WS_EID0), (const float*)(ws + WS_GW0), (float*)(ws + WS_ZP0)); }
    SEAM(12);
    if (IN(13)) { MKFRAME() asm volatile("; PHASE_BEGIN 13"); ln_phase(F, (const float*)(ws + WS_ZP0), INP(32) + D, INP(33) + D, (float*)(ws + WS_XF), (bf16_t*)nullptr); }
    SEAM(13);
    if (((MK_REP >> 13) & 1) && IN(13)) { for (int rep_ = 0; rep_ < MK_NREP; ++rep_) { { MKFRAME() ln_phase(F, (const float*)(ws + WS_ZP0), INP(32) + D, INP(33) + D, (float*)(ws + WS_XF), (bf16_t*)nullptr); } FORCE_BAR(); } }
    if (IN(14)) { MKFRAME() asm volatile("; PHASE_BEGIN 14"); mix_phase(F, INP(10)); }
    SEAM(14);
    if (((MK_REP >> 14) & 1) && IN(14)) { for (int rep_ = 0; rep_ < MK_NREP; ++rep_) { { MKFRAME() mix_phase(F, INP(10)); } FORCE_BAR(); } }
    if (IN(15)) { MKFRAME() asm volatile("; PHASE_BEGIN 15"); { ProbRkv P{(const char*)(ws + WS_MIX), (const char*)(ws + WS_WRKV)}; EpiRkv E{(bf16_t*)(ws + WS_R), (bf16_t*)(ws + WS_LORA)}; run_gemm(F, 64, 15, D, D, D, P, E); } }
    SEAM(15);
    if (((MK_REP >> 15) & 1) && IN(15)) { for (int rep_ = 0; rep_ < MK_NREP; ++rep_) { { MKFRAME() { ProbRkv P{(const char*)(ws + WS_MIX), (const char*)(ws + WS_WRKV)}; EpiRkv E{(bf16_t*)(ws + WS_R), (bf16_t*)(ws + WS_LORA)}; run_gemm(F, 64, 15, D, D, D, P, E); } } FORCE_BAR(); } }
    if (IN(16)) { MKFRAME() asm volatile("; PHASE_BEGIN 16"); { ProbPlain P{(const char*)(ws + WS_LORA), (const char*)(ws + WS_WL2), (size_t)256 * 256 * 2, (size_t)256 * 256 * 2}; EpiLora2 E{(float*)(ws + WS_WDEC), (bf16_t*)(ws + WS_AA), INP(14), INP(17)}; static_assert(WS_G == WS_AA + (size_t)T * D * 2, "g follows aa"); run_gemm(F, 64, 12, 256, 256, 256, P, E); } }
    SEAM(16);
    if (((MK_REP >> 16) & 1) && IN(16)) { for (int rep_ = 0; rep_ < MK_NREP; ++rep_) { { MKFRAME() { ProbPlain P{(const char*)(ws + WS_LORA), (const char*)(ws + WS_WL2), (size_t)256 * 256 * 2, (size_t)256 * 256 * 2}; EpiLora2 E{(float*)(ws + WS_WDEC), (bf16_t*)(ws + WS_AA), INP(14), INP(17)}; static_assert(WS_G == WS_AA + (size_t)T * D * 2, "g follows aa"); run_gemm(F, 64, 12, 256, 256, 256, P, E); } } FORCE_BAR(); } }
    if (IN(17)) { MKFRAME() asm volatile("; PHASE_BEGIN 17"); rwprep_phase(F, args, MK_NBATCH); }
    SEAM(17);
    if (((MK_REP >> 17) & 1) && IN(17)) { for (int rep_ = 0; rep_ < MK_NREP; ++rep_) { { MKFRAME() rwprep_phase(F, args, MK_NBATCH); } FORCE_BAR(); } }
    if (IN(18)) { MKFRAME() asm volatile("; PHASE_BEGIN 18"); rwscan2_phase(F, args, (bf16_t*)(ws + WS_OG), MK_NBATCH); }
    SEAM(18);
    if (((MK_REP >> 18) & 1) && IN(18)) { for (int rep_ = 0; rep_ < MK_NREP; ++rep_) { { MKFRAME() rwscan2_phase(F, args, (bf16_t*)(ws + WS_XB1), MK_NBATCH); } FORCE_BAR(); } }
    if (IN(19)) { MKFRAME() asm volatile("; PHASE_BEGIN 19"); { ProbPlain P{(const char*)(ws + WS_OG), (const char*)(ws + WS_WO), (size_t)256 * D * 2, (size_t)256 * D * 2}; EpiRes E{(const float*)(ws + WS_XF), (float*)(ws + WS_Z1)}; run_gemm(F, 64, 4, D, D, D, P, E); } }
    SEAM(19);
    if (((MK_REP >> 19) & 1) && IN(19)) { for (int rep_ = 0; rep_ < MK_NREP; ++rep_) { { MKFRAME() { ProbPlain P{(const char*)(ws + WS_OG), (const char*)(ws + WS_WO), (size_t)256 * D * 2, (size_t)256 * D * 2}; EpiRes E{(const float*)(ws + WS_XF), (float*)(ws + WS_Z1)}; run_gemm(F, 64, 4, D, D, D, P, E); } } FORCE_BAR(); } }
    if (IN(20)) { MKFRAME() asm volatile("; PHASE_BEGIN 20"); ln_phase(F, (const float*)(ws + WS_Z1), INP(32) + 2 * D, INP(33) + 2 * D, (float*)(ws + WS_XF), (bf16_t*)(ws + WS_XB1)); { const size_t gt_ = (size_t)F.gw * 64 + F.lane, NGT_ = (size_t)F.NGW * 64; cvt_stream_fp8(INP(30) + (size_t)16384 * D, ws + WS_UB, (size_t)16384 * D / 16, gt_, NGT_, U_SCALE); cvt_stream_fp8(INP(31) + (size_t)16384 * D, ws + WS_VB, (size_t)16384 * D / 16, gt_, NGT_, V_SCALE); } }
    SEAM(20);
    if (((MK_REP >> 20) & 1) && IN(20)) { for (int rep_ = 0; rep_ < MK_NREP; ++rep_) { { MKFRAME() ln_phase(F, (const float*)(ws + WS_Z1), INP(32) + 2 * D, INP(33) + 2 * D, (float*)(ws + WS_XF), (bf16_t*)(ws + WS_XB1)); { const size_t gt_ = (size_t)F.gw * 64 + F.lane, NGT_ = (size_t)F.NGW * 64; cvt_stream_fp8(INP(30) + (size_t)16384 * D, ws + WS_UB, (size_t)16384 * D / 16, gt_, NGT_, U_SCALE); cvt_stream_fp8(INP(31) + (size_t)16384 * D, ws + WS_VB, (size_t)16384 * D / 16, gt_, NGT_, V_SCALE); } } FORCE_BAR(); } }
    if (IN(21)) { MKFRAME() asm volatile("; PHASE_BEGIN 21"); { ProbPlain P{(const char*)(ws + WS_XB1), (const char*)(ws + WS_WPEER + (size_t)2048 * D * 2), (size_t)256 * D * 2, (size_t)256 * D * 2}; EpiScores E{(float*)(ws + WS_SC1)}; run_gemm(F, 64, 8, D, D, D, P, E); } }
    SEAM(21);
    if (((MK_REP >> 21) & 1) && IN(21)) { for (int rep_ = 0; rep_ < MK_NREP; ++rep_) { { MKFRAME() { ProbPlain P{(const char*)(ws + WS_XB1), (const char*)(ws + WS_WPEER + (size_t)2048 * D * 2), (size_t)256 * D * 2, (size_t)256 * D * 2}; EpiScores E{(float*)(ws + WS_SC1)}; run_gemm(F, 64, 8, D, D, D, P, E); } } FORCE_BAR(); } }
    if (IN(22)) { MKFRAME() asm volatile("; PHASE_BEGIN 22"); topk_phase(F, (const float*)(ws + WS_SC1), (int*)(ws + WS_EID1), (float*)(ws + WS_GW1)); }
    SEAM(22);
    if (((MK_REP >> 22) & 1) && IN(22)) { for (int rep_ = 0; rep_ < MK_NREP; ++rep_) { { MKFRAME() topk_phase(F, (const float*)(ws + WS_SC1), (int*)(ws + WS_EID1), (float*)(ws + WS_GW1)); } FORCE_BAR(); } }
    if (IN(23)) { MKFRAME() asm volatile("; PHASE_BEGIN 23"); gu_phase(F, (const float*)(ws + WS_XF), (const int*)(ws + WS_EID1), (float*)(ws + WS_PART1)); }
    SEAM(23);
    if (IN(24)) { MKFRAME() asm volatile("; PHASE_BEGIN 24"); gr_phase(F, (const float*)(ws + WS_PART1), (float*)(ws + WS_GW1)); }
    SEAM(24);
    if (IN(25)) { MKFRAME() asm volatile("; PHASE_BEGIN 25"); gv_phase(F, (const float*)(ws + WS_XF), (const int*)(ws + WS_EID1), (const float*)(ws + WS_GW1), (float*)(ws + WS_ZP1)); }
    SEAM(25);
    if (IN(26)) { MKFRAME() asm volatile("; PHASE_BEGIN 26"); ln_phase(F, (const float*)(ws + WS_ZP1), INP(32) + 3 * D, INP(33) + 3 * D, F.out, (bf16_t*)nullptr); }
    SEAM(26);
    if (((MK_REP >> 26) & 1) && IN(26)) { for (int rep_ = 0; rep_ < MK_NREP; ++rep_) { { MKFRAME() ln_phase(F, (const float*)(ws + WS_ZP1), INP(32) + 3 * D, INP(33) + 3 * D, F.out, (bf16_t*)nullptr); } FORCE_BAR(); } }
#undef INP
#undef IN
#undef SEAM
#undef FORCE_BAR
#undef MKFRAME
}

static int g_grid = 0;
static inline bool mk_setup() {
    if (g_grid == 0) {
        int dev = 0, cus = 0;
        if (hipGetDevice(&dev) != hipSuccess || hipDeviceGetAttribute(&cus, hipDeviceAttributeMultiprocessorCount, dev) != hipSuccess) { g_grid = -1; return false; }
        if (hipFuncSetAttribute((const void*)mk_fwd, hipFuncAttributeMaxDynamicSharedMemorySize, LDS_BYTES) != hipSuccess) { fprintf(stderr, "hipFuncSetAttribute failed\n"); g_grid = -1; return false; }
        (void)hipGetLastError();
        g_grid = cus;
        if (g_grid != 256) fprintf(stderr, "warning: %d CUs (kernel assumes 256 workgroups)\n", g_grid);
    }
    return g_grid > 0;
}
static inline void mk_launch(hipStream_t stream, void* const* d_in, void* d_out, void* d_ws, int lo, int hi) {
    Args a{};
    for (int i = 0; i < 34; ++i) a.in[i] = (const float*)d_in[i];
    a.out = (float*)d_out; a.ws = (unsigned char*)d_ws; a.ph_lo = lo; a.ph_hi = hi;
    hipLaunchKernelGGL(mk_fwd, dim3(g_grid), dim3(NTHREADS), LDS_BYTES, stream, a);
}
}
extern "C" void kernel_launch(void* const* d_in, const int* in_sizes, int n_in, void* d_out, int out_size, void* d_ws, size_t ws_size, hipStream_t stream) {
    (void)in_sizes; (void)n_in; (void)out_size;
    if (!mk::mk_setup()) return;
    if (ws_size < mk::WS_END) { fprintf(stderr, "workspace too small: %zu\n", ws_size); return; }
    (void)hipMemsetAsync((char*)d_ws + mk::WS_CTL, 0, mk::CTL_ZERO_BYTES, stream);
#if MK_PER_PHASE
    for (int p = 0; p < mk::NPH; ++p) mk::mk_launch(stream, d_in, d_out, d_ws, p, p + 1);
#else
    mk::mk_launch(stream, d_in, d_out, d_ws, 0, mk::NPH);
#endif
}
```

```cpp
#include <hip/hip_runtime.h>
#include <cstdio>
#include <cstdint>

#define LAS __attribute__((address_space(3)))
#define GAS __attribute__((address_space(1)))
typedef unsigned short bf16_t;
typedef short bf16x8 __attribute__((ext_vector_type(8)));
typedef float f32x4 __attribute__((ext_vector_type(4)));
typedef float f32x2 __attribute__((ext_vector_type(2)));
typedef unsigned u32x4 __attribute__((ext_vector_type(4)));
typedef unsigned u32x2 __attribute__((ext_vector_type(2)));
typedef __bf16 bf16x2_t __attribute__((ext_vector_type(2)));

namespace mk {
constexpr int D = 1024, NB = 8, S = 2048, T = NB * S, W = 1408, NH = 16, HB = 88;
constexpr float ALPHA = 1.41421356237f, LN_EPS = 1e-5f;
constexpr int NWAVES = 8, NTHREADS = 512;

__device__ __forceinline__ unsigned f2bf(float f) { unsigned u = __builtin_bit_cast(unsigned, f); return (u + 0x7fffu + ((u >> 16) & 1u)) >> 16; }
__device__ __forceinline__ unsigned pk2(float lo, float hi) { return f2bf(lo) | (f2bf(hi) << 16); }
__device__ __forceinline__ float bf_lo(unsigned w) { return __builtin_bit_cast(float, w << 16); }
__device__ __forceinline__ float bf_hi(unsigned w) { return __builtin_bit_cast(float, w & 0xffff0000u); }
__device__ __forceinline__ float ldbf(const bf16_t* p) { return __builtin_bit_cast(float, ((unsigned)*p) << 16); }
__device__ __forceinline__ unsigned cvt_pk_bf16(float lo, float hi) { unsigned r; asm volatile("v_cvt_pk_bf16_f32 %0, %1, %2" : "=v"(r) : "v"(lo), "v"(hi)); return r; }
__device__ __forceinline__ unsigned cvt_pk_bf16_c(float lo, float hi) { f32x2 v = {lo, hi}; bf16x2_t b = __builtin_convertvector(v, bf16x2_t); return __builtin_bit_cast(unsigned, b); }
__device__ __forceinline__ float fast_exp(float x) { return __builtin_amdgcn_exp2f(x * 1.44269504089f); }
__device__ __forceinline__ float fast_rcp(float x) { return __builtin_amdgcn_rcpf(x); }
__device__ __forceinline__ float fast_sigmoid(float x) { return fast_rcp(1.f + fast_exp(-x)); }
__device__ __forceinline__ float fast_tanh(float x) { float e = fast_exp(-2.f * fabsf(x)); float t = (1.f - e) * fast_rcp(1.f + e); return x < 0.f ? -t : t; }
__device__ __forceinline__ float gelu_tanh(float x) { const float c = 0.7978845608028654f; float u = c * (x + 0.044715f * x * x * x); return x * fast_sigmoid(2.f * u); }
__device__ __forceinline__ float softplus_f(float x) { return x > 15.f ? x : __logf(1.f + fast_exp(x)); }
__device__ __forceinline__ int lane_id() { return (int)__builtin_amdgcn_mbcnt_hi(~0u, __builtin_amdgcn_mbcnt_lo(~0u, 0u)); }
__device__ __forceinline__ float wave_sum(float v) {
#pragma unroll
    for (int o = 1; o < 64; o <<= 1) v += __shfl_xor(v, o);
    return v;
}
template <int CTRL> __device__ __forceinline__ float dpp_f(float v) { return __builtin_bit_cast(float, __builtin_amdgcn_update_dpp(0, __builtin_bit_cast(int, v), CTRL, 0xf, 0xf, false)); }
#define DPP_QP_1032 0xB1
#define DPP_QP_2301 0x4E
#define DPP_ROW_HALF_MIRROR 0x141
#define DPP_ROW_MIRROR 0x140
#define DPP_ROW_ROR(n) (0x120 + (n))
__device__ __forceinline__ float sum8(float v) { v += dpp_f<DPP_QP_1032>(v); v += dpp_f<DPP_QP_2301>(v); v += dpp_f<DPP_ROW_HALF_MIRROR>(v); return v; }
__device__ __forceinline__ float sum16(float v) { v = sum8(v); v += dpp_f<DPP_ROW_ROR(8)>(v); return v; }

#define XB_TMO      128
#define XB_XCNT(j)  (256  + 64 * (j))
#define XB_XSUB(j)  (1280 + 64 * (j))
#define XB_XGEN(j)  (2304 + 64 * (j))
#define XB_TOP      3328
#define XB_TOPGEN   3392
#define XCD_BAR_WORDS 3456
#define XB_SPIN_CAP (1u << 20)
__device__ __forceinline__ unsigned xb_ld(unsigned* p)              { return __hip_atomic_load(p, __ATOMIC_RELAXED, __HIP_MEMORY_SCOPE_AGENT); }
__device__ __forceinline__ unsigned xb_add(unsigned* p, unsigned v) { return __hip_atomic_fetch_add(p, v, __ATOMIC_RELAXED, __HIP_MEMORY_SCOPE_AGENT); }
__device__ __forceinline__ unsigned xb_xcc_id() { return (unsigned)__builtin_amdgcn_s_getreg((3 << 11) | 20) & 0xFu; }
#define XB_SPIN(cond, bar) do { unsigned _sp = 0; while (cond) { __builtin_amdgcn_s_sleep(1); \
    if ((++_sp & 255u) == 0u) { if (xb_ld(&(bar)[XB_TMO])) break; if (_sp > XB_SPIN_CAP) { atomicAdd(&(bar)[XB_TMO], 1u); break; } } } } while (0)
struct XcdBarrier { unsigned* bar; unsigned x; volatile LAS unsigned* st; };
__device__ __forceinline__ XcdBarrier xcd_barrier_post(unsigned* bar, volatile LAS unsigned* st) {
    XcdBarrier b; b.bar = bar; b.x = xb_xcc_id(); b.st = st;
    if (threadIdx.x == 0) (void)xb_add(&bar[XB_XCNT(b.x)], 1u);
    return b;
}
__device__ __forceinline__ void xcd_barrier_complete(unsigned* bar, unsigned x, unsigned& nloc, unsigned& nx) {
    const unsigned G = gridDim.x * gridDim.y * gridDim.z;
    unsigned sum, cnt, mine, sp = 0u;
    for (;;) {
        sum = 0u; cnt = 0u; mine = 0u;
#pragma unroll
        for (unsigned j = 0; j < 16; ++j) { const unsigned c = xb_ld(&bar[XB_XCNT(j)]); sum += c; cnt += (c > 0u) ? 1u : 0u; mine = (j == x) ? c : mine; }
        if (sum == G) break;
        __builtin_amdgcn_s_sleep(1);
        if ((++sp & 255u) == 0u) { if (xb_ld(&bar[XB_TMO])) break; if (sp > XB_SPIN_CAP) { atomicAdd(&bar[XB_TMO], 1u); break; } }
    }
    nloc = mine > 0u ? mine : 1u; nx = cnt > 0u ? cnt : 1u;
}
__device__ __forceinline__ void xcd_barrier(const XcdBarrier& b, const bool leader) {
    asm volatile("s_waitcnt vmcnt(0)" ::: "memory");
    __syncthreads();
    if (leader) {
        unsigned* bar = b.bar;
        __builtin_amdgcn_s_waitcnt(0);
        unsigned nloc = b.st[0], nx = b.st[1];
        if (nloc == 0u) { xcd_barrier_complete(bar, b.x, nloc, nx); b.st[0] = nloc; b.st[1] = nx; }
        const unsigned old = xb_add(&bar[XB_XSUB(b.x)], 1u);
        const unsigned gen = old / nloc;
        if (old + 1u == (gen + 1u) * nloc) {
            __builtin_amdgcn_fence(__ATOMIC_RELEASE, "agent");
            asm volatile("s_waitcnt vmcnt(0)" ::: "memory");
            const unsigned og = xb_add(&bar[XB_TOP], 1u);
            const unsigned tg = og / nx;
            if (og + 1u == (tg + 1u) * nx) xb_add(&bar[XB_TOPGEN], 1u);
            else XB_SPIN(xb_ld(&bar[XB_TOPGEN]) == tg, bar);
            __builtin_amdgcn_fence(__ATOMIC_ACQUIRE, "agent");
            xb_add(&bar[XB_XGEN(b.x)], 1u);
            asm volatile("s_waitcnt vmcnt(0)" ::: "memory");
        } else {
            XB_SPIN(xb_ld(&bar[XB_XGEN(b.x)]) == gen, bar);
            __builtin_amdgcn_fence(__ATOMIC_ACQUIRE, "agent");
            asm volatile("s_waitcnt vmcnt(0)" ::: "memory");
        }
    }
    __syncthreads();
}

namespace pg8 {
constexpr int BM = 256, BK = 64, HALF = 128, HTB = HALF * BK * 2, STAGE_BYTES = 8 * HTB, NXCD = 8, WGM = 8;
__host__ __device__ __forceinline__ int lds_byte(int r, int c) { const int st = (r >> 4) * 2 + (c >> 5), rr = r & 15, cc = c & 31, ob = rr * 64 + cc * 2; return st * 1024 + (ob ^ (((ob >> 9) & 1) << 5)); }
__host__ __device__ __forceinline__ void stage_rc(int b, int& R, int& C) { const int st = b / 1024, sb = b % 1024, swz = sb ^ (((sb >> 9) & 1) << 5); R = (st >> 1) * 16 + swz / 64; C = (st & 1) * 32 + (swz % 64) / 2; }
__host__ __device__ __forceinline__ int perm32(int rho) { const int n = rho >> 4, i = rho & 15; return 8 * (i >> 2) + 4 * n + (i & 3); }

struct Unit { const char* A; const char* B; int pm, pn; };
template <class P> struct Order {
    int nM, nN, nwg, G, c; P p;
    __device__ __forceinline__ void init(int nM_, int nN_, int G_, int c_, const P& p_) { nM = nM_; nN = nN_; nwg = nM * nN; G = G_; c = c_; p = p_; }
    __device__ __forceinline__ bool next(int i, Unit& u) const {
        const long L = (long)i * G + c; if (L >= nwg) return false;
        int wgid = (int)L; { const int q = nwg / NXCD, r = nwg % NXCD, xcd = wgid % NXCD, off = wgid / NXCD; wgid = (xcd < r ? xcd * (q + 1) : r * (q + 1) + (xcd - r) * q) + off; }
        const int nig = WGM * nN, gid = wgid / nig, fm = gid * WGM, gsz = (nM - fm) < WGM ? (nM - fm) : WGM;
        u.pm = fm + ((wgid % nig) % gsz); u.pn = (wgid % nig) / gsz; p.locate(u); return true;
    }
};

template <class Epi, class Sched, bool ALIGN_EPI, bool SP2>
__device__ __forceinline__ void gemm_phase(LAS unsigned char* lds, const int tid, const int lda, const int ldb, const int K, const Sched& S, const Epi& E) {
    const int wid = __builtin_amdgcn_readfirstlane(tid >> 6), lane = tid & 63, wr = wid >> 2, wc = wid & 3, fr = lane & 15, fq = lane >> 4;
    const int nt = K / BK;
    unsigned voffA[2], voffB[2];
#pragma unroll
    for (int i = 0; i < 2; ++i) { int R, C; stage_rc(tid * 16 + i * 8192, R, C); const int Rb = Epi::PERM ? ((R & ~31) + perm32(R & 31)) : R;
        voffA[i] = (unsigned)(R * lda + C) * 2u; voffB[i] = (unsigned)(Rb * ldb + C) * 2u; }
    const size_t kstep = (size_t)(BK * 2);
    const size_t hstepA = (size_t)HALF * lda * 2, hstepB = (size_t)HALF * ldb * 2;
    const unsigned ldsw = (unsigned)wid * 1024u;
    const int aoff = lds_byte(wr * 64 + fr, fq * 8), boff = lds_byte(wc * 32 + fr, fq * 8);
#define PG8_SA(b, h) (((b) * 2 + (h)) * HTB)
#define PG8_SB(b, h) ((4 + (b) * 2 + (h)) * HTB)
#define PG8_STAGE(bufoff, gbase, voff) do { _Pragma("unroll") for (int _i = 0; _i < 2; ++_i) \
        __builtin_amdgcn_global_load_lds((const unsigned*)((const char*)(gbase) + (voff)[_i]), (LAS unsigned*)(lds + (bufoff) + ldsw + _i * 8192), 16, 0, 0); } while (0)
#define PG8_LDA(dst, b, h) do { _Pragma("unroll") for (int m = 0; m < 4; ++m) _Pragma("unroll") for (int k = 0; k < 2; ++k) dst[m][k] = *(const LAS bf16x8*)(lds + PG8_SA(b, h) + aoff + m * 2048 + k * 1024); } while (0)
#define PG8_LDB(dst, b, h) do { _Pragma("unroll") for (int n = 0; n < 2; ++n) _Pragma("unroll") for (int k = 0; k < 2; ++k) dst[n][k] = *(const LAS bf16x8*)(lds + PG8_SB(b, h) + boff + n * 2048 + k * 1024); } while (0)
#define PG8_MMA(ai, bj, At, Bt) do { __builtin_amdgcn_s_setprio(1); _Pragma("unroll") for (int m = 0; m < 4; ++m) _Pragma("unroll") for (int n = 0; n < 2; ++n) _Pragma("unroll") for (int k = 0; k < 2; ++k) \
        acc[ai][bj][m][n] = __builtin_amdgcn_mfma_f32_16x16x32_bf16(Bt[n][k], At[m][k], acc[ai][bj][m][n], 0, 0, 0); __builtin_amdgcn_s_setprio(0); } while (0)
#define PG8_WAIT_V(n) asm volatile("s_waitcnt vmcnt(" #n ")" ::: "memory")
#define PG8_WAIT_L(n) asm volatile("s_waitcnt lgkmcnt(" #n ")" ::: "memory")
#define PG8_BAR __builtin_amdgcn_s_barrier()
#define PG8_SCHED __builtin_amdgcn_sched_barrier(0)
    Unit cur, nxt; int ui = 0;
    if (!S.next(0, cur)) return;
    f32x4 acc[2][2][4][2];
#pragma unroll
    for (int a = 0; a < 2; ++a)
#pragma unroll
        for (int b = 0; b < 2; ++b)
#pragma unroll
            for (int m = 0; m < 4; ++m)
#pragma unroll
                for (int n = 0; n < 2; ++n) acc[a][b][m][n] = (f32x4){0.f, 0.f, 0.f, 0.f};
    bf16x8 At[4][2], B0[2][2], B1[2][2];
    const char* cA = cur.A; const char* cB = cur.B;
    if constexpr (SP2) {
        PG8_STAGE(PG8_SB(0, 0), cB, voffB); PG8_STAGE(PG8_SB(0, 1), cB + hstepB, voffB); PG8_STAGE(PG8_SA(0, 0), cA, voffA); PG8_STAGE(PG8_SA(0, 1), cA + hstepA, voffA);
        if (wr == 1) PG8_BAR;
        PG8_WAIT_V(2); PG8_BAR;
        PG8_STAGE(PG8_SB(1, 0), cB + kstep, voffB); PG8_STAGE(PG8_SA(1, 0), cA + kstep, voffA); PG8_STAGE(PG8_SB(1, 1), cB + hstepB + kstep, voffB);
        PG8_WAIT_V(6); PG8_BAR;
    } else {
        PG8_STAGE(PG8_SB(0, 0), cB, voffB); PG8_STAGE(PG8_SA(0, 0), cA, voffA); PG8_STAGE(PG8_SB(0, 1), cB + hstepB, voffB); PG8_STAGE(PG8_SA(0, 1), cA + hstepA, voffA);
        if (wr == 1) PG8_BAR;
        PG8_WAIT_V(4); PG8_BAR;
        PG8_STAGE(PG8_SB(1, 0), cB + kstep, voffB); PG8_STAGE(PG8_SA(1, 0), cA + kstep, voffA); PG8_STAGE(PG8_SB(1, 1), cB + hstepB + kstep, voffB);
        PG8_WAIT_V(6); PG8_BAR;
    }
    for (;;) {
        const bool has_next = S.next(ui + 1, nxt);
        const char* nA = has_next ? nxt.A : cA; const char* nB = has_next ? nxt.B : cB;
#pragma unroll 1
        for (int t = 0; t < nt; t += 2) {
            const bool last = (t == nt - 2);
            const char* a1 = cA + (size_t)(t + 1) * kstep;
            const char* a2 = last ? nA : cA + (size_t)(t + 2) * kstep; const char* b2 = last ? nB : cB + (size_t)(t + 2) * kstep;
            const char* a3 = a2 + kstep; const char* b3 = b2 + kstep;
            if constexpr (SP2) {
            PG8_LDB(B0, 0, 0); PG8_LDB(B1, 0, 1); PG8_SCHED; PG8_LDA(At, 0, 0); PG8_STAGE(PG8_SA(1, 1), a1 + hstepA, voffA);
            PG8_WAIT_V(8); PG8_WAIT_L(0); PG8_BAR; PG8_MMA(0, 0, At, B0); PG8_MMA(0, 1, At, B1); PG8_BAR; PG8_SCHED;
            PG8_LDA(At, 0, 1); PG8_STAGE(PG8_SB(0, 0), b2, voffB); PG8_STAGE(PG8_SB(0, 1), b2 + hstepB, voffB); PG8_STAGE(PG8_SA(0, 0), a2, voffA);
            PG8_WAIT_V(8); PG8_WAIT_L(0); PG8_BAR; PG8_MMA(1, 0, At, B0); PG8_MMA(1, 1, At, B1); PG8_BAR; PG8_SCHED;
            PG8_LDB(B0, 1, 0); PG8_LDB(B1, 1, 1); PG8_SCHED; PG8_LDA(At, 1, 0); PG8_STAGE(PG8_SA(0, 1), a2 + hstepA, voffA);
            PG8_WAIT_V(8); PG8_WAIT_L(0); PG8_BAR; PG8_MMA(0, 0, At, B0); PG8_MMA(0, 1, At, B1); PG8_BAR; PG8_SCHED;
            PG8_LDA(At, 1, 1); PG8_STAGE(PG8_SB(1, 0), b3, voffB); PG8_STAGE(PG8_SB(1, 1), b3 + hstepB, voffB); PG8_STAGE(PG8_SA(1, 0), a3, voffA);
            PG8_WAIT_V(8); PG8_WAIT_L(0); PG8_BAR; PG8_MMA(1, 0, At, B0); PG8_MMA(1, 1, At, B1); PG8_BAR; PG8_SCHED;
            } else {
            PG8_LDB(B0, 0, 0); PG8_SCHED; PG8_LDA(At, 0, 0); PG8_STAGE(PG8_SA(1, 1), a1 + hstepA, voffA);
            PG8_WAIT_L(8); PG8_BAR; PG8_WAIT_L(0); PG8_MMA(0, 0, At, B0); PG8_BAR; PG8_SCHED;
            PG8_LDB(B1, 0, 1); PG8_STAGE(PG8_SB(0, 0), b2, voffB);
            PG8_BAR; PG8_WAIT_L(0); PG8_MMA(0, 1, At, B1); PG8_BAR;
            PG8_LDA(At, 0, 1); PG8_STAGE(PG8_SA(0, 0), a2, voffA);
            PG8_BAR; PG8_WAIT_L(0); PG8_MMA(1, 0, At, B0); PG8_BAR; PG8_SCHED;
            PG8_STAGE(PG8_SB(0, 1), b2 + hstepB, voffB);
            PG8_WAIT_V(6); PG8_BAR; PG8_MMA(1, 1, At, B1); PG8_BAR;
            PG8_LDB(B0, 1, 0); PG8_SCHED; PG8_LDA(At, 1, 0); PG8_STAGE(PG8_SA(0, 1), a2 + hstepA, voffA);
            PG8_WAIT_L(8); PG8_BAR; PG8_WAIT_L(0); PG8_MMA(0, 0, At, B0); PG8_BAR; PG8_SCHED;
            PG8_LDB(B1, 1, 1); PG8_STAGE(PG8_SB(1, 0), b3, voffB);
            PG8_BAR; PG8_WAIT_L(0); PG8_MMA(0, 1, At, B1); PG8_BAR;
            PG8_LDA(At, 1, 1); PG8_STAGE(PG8_SA(1, 0), a3, voffA);
            PG8_BAR; PG8_WAIT_L(0); PG8_MMA(1, 0, At, B0); PG8_BAR; PG8_SCHED;
            PG8_STAGE(PG8_SB(1, 1), b3 + hstepB, voffB);
            PG8_WAIT_V(6); PG8_BAR; PG8_MMA(1, 1, At, B1); PG8_BAR;
            }
        }
        if constexpr (ALIGN_EPI) { if (wr == 0) PG8_BAR; }
        { int l_e = lane_id(); asm volatile("" : "+v"(l_e)); E(acc, cur, wr, wc, l_e & 15, l_e >> 4); }
        if (!has_next) break;
#pragma unroll
        for (int a = 0; a < 2; ++a)
#pragma unroll
            for (int b = 0; b < 2; ++b)
#pragma unroll
                for (int m = 0; m < 4; ++m)
#pragma unroll
                    for (int n = 0; n < 2; ++n) acc[a][b][m][n] = (f32x4){0.f, 0.f, 0.f, 0.f};
        cur = nxt; cA = nA; cB = nB; ++ui;
        if constexpr (ALIGN_EPI) { if (wr == 1) PG8_BAR; }
    }
    PG8_WAIT_V(0);
    if constexpr (!ALIGN_EPI) { if (wr == 0) PG8_BAR; }
    PG8_BAR;
#undef PG8_SA
#undef PG8_SB
#undef PG8_STAGE
#undef PG8_LDA
#undef PG8_LDB
#undef PG8_MMA
#undef PG8_WAIT_V
#undef PG8_WAIT_L
#undef PG8_BAR
#undef PG8_SCHED
}
}
}
namespace mk {
constexpr size_t MiB = 1u << 20;
constexpr size_t WS_CTL = 0, CTL_ZERO_BYTES = 65536;
constexpr size_t WS_WIN = 1 * MiB, WS_WG = 7 * MiB, WS_WOUT = 10 * MiB, WS_WPEER = 13 * MiB, WS_WRKV = 21 * MiB, WS_WL2 = 29 * MiB, WS_WO = 31 * MiB, WS_VEC = 33 * MiB;
constexpr size_t WS_UB = 34 * MiB, WS_VB = 66 * MiB;
constexpr size_t WS_X0B = 98 * MiB, WS_GATE = 130 * MiB, WS_H2 = 174 * MiB, WS_XC = 218 * MiB, WS_A = 262 * MiB, WS_U = 350 * MiB, WS_AGG = 438 * MiB;
constexpr size_t WS_Y = WS_H2, WS_Z0 = WS_A, WS_XF = 350 * MiB, WS_XB0 = 98 * MiB;
constexpr size_t WS_SC0 = 130 * MiB, WS_EID0 = 258 * MiB, WS_GW0 = 266 * MiB;
constexpr size_t WS_MIX = 34 * MiB, WS_R = 226 * MiB, WS_K = 258 * MiB, WS_V = 290 * MiB, WS_LORA = 322 * MiB, WS_WDEC = 98 * MiB, WS_AA = 162 * MiB, WS_G = 194 * MiB, WS_OG = WS_R;
constexpr size_t WS_Z1 = 98 * MiB, WS_XB1 = 162 * MiB;
constexpr size_t WS_SC1 = 194 * MiB, WS_EID1 = 322 * MiB, WS_GW1 = 330 * MiB;
constexpr size_t WS_PART0 = 130 * MiB, WS_ZP0 = 194 * MiB, WS_PART1 = 194 * MiB, WS_ZP1 = 258 * MiB;
constexpr size_t WS_DBG = 444 * MiB, WS_END = 512 * MiB;
constexpr int CW_BAR = 4096;
constexpr int LDS_BYTES = 163840, MISC_OFF = LDS_BYTES - 256;

struct Args { const float* in[34]; float* out; unsigned char* ws; int ph_lo, ph_hi; };

struct Frame {
    LAS unsigned char* lds; volatile LAS unsigned* MISC; unsigned* ctl; unsigned char* ws;
    int tid, lane, wave, vcu, G, gw, NGW, bx;
    float* out;
};
#define LDS_WAIT() asm volatile("s_waitcnt lgkmcnt(0)" ::: "memory")

__device__ __forceinline__ void transpose_item(const float* W, int K, int N, bf16_t* WT, int ldt, int row_off, int col_off, LAS float* scr, int item, int lane) {
    const int nblk = N / 32, kb = item / nblk, nb = item % nblk, k0 = 64 * kb, n0 = 32 * nb;
#pragma unroll 8
    for (int i = 0; i < 32; ++i) { const int kk = 2 * i + (lane >> 5); scr[kk * 33 + (lane & 31)] = W[(size_t)(k0 + kk) * N + n0 + (lane & 31)]; }
    LDS_WAIT(); asm volatile("" ::: "memory");
    const int c = lane & 7;
#pragma unroll
    for (int j = 0; j < 4; ++j) { const int n = (lane >> 3) + 8 * j; const LAS float* s = scr + (8 * c) * 33 + n;
        u32x4 o; o.x = pk2(s[0 * 33], s[1 * 33]); o.y = pk2(s[2 * 33], s[3 * 33]); o.z = pk2(s[4 * 33], s[5 * 33]); o.w = pk2(s[6 * 33], s[7 * 33]);
        *(u32x4*)(WT + (size_t)(row_off + n0 + n) * ldt + col_off + k0 + 8 * c) = o; }
    LDS_WAIT(); asm volatile("" ::: "memory");
    (void)K;
}
__device__ __forceinline__ int gates_koff(int q) { int s = 128 * (q > 0 ? q - 1 : 0); return s > 1024 ? 1024 : s; }

__device__ __forceinline__ void cvt_stream(const float* src, bf16_t* dst, size_t n8, size_t w, size_t nw) {
    for (size_t i = w; i < n8; i += nw) { const f32x4 a = *(const f32x4*)(src + i * 8), b = *(const f32x4*)(src + i * 8 + 4);
        u32x4 o; o.x = pk2(a.x, a.y); o.y = pk2(a.z, a.w); o.z = pk2(b.x, b.y); o.w = pk2(b.z, b.w); *(u32x4*)(dst + i * 8) = o; }
}

__device__ __forceinline__ void cvt_stream_fp8(const float* src, unsigned char* dst, size_t n16, size_t w, size_t nw, float scale) {
    for (size_t i = w; i < n16; i += nw) { const f32x4 a = *(const f32x4*)(src + i * 16) * scale, b = *(const f32x4*)(src + i * 16 + 4) * scale, c = *(const f32x4*)(src + i * 16 + 8) * scale, d = *(const f32x4*)(src + i * 16 + 12) * scale;
        u32x4 o; int t;
        t = __builtin_amdgcn_cvt_pk_fp8_f32(a.x, a.y, 0, false); o.x = (unsigned)__builtin_amdgcn_cvt_pk_fp8_f32(a.z, a.w, t, true);
        t = __builtin_amdgcn_cvt_pk_fp8_f32(b.x, b.y, 0, false); o.y = (unsigned)__builtin_amdgcn_cvt_pk_fp8_f32(b.z, b.w, t, true);
        t = __builtin_amdgcn_cvt_pk_fp8_f32(c.x, c.y, 0, false); o.z = (unsigned)__builtin_amdgcn_cvt_pk_fp8_f32(c.z, c.w, t, true);
        t = __builtin_amdgcn_cvt_pk_fp8_f32(d.x, d.y, 0, false); o.w = (unsigned)__builtin_amdgcn_cvt_pk_fp8_f32(d.z, d.w, t, true);
        *(u32x4*)(dst + ((i & 63) >> 3) * ((size_t)16384 * 128) + (i >> 6) * 128 + (i & 7) * 16) = o; }
}
constexpr float U_SCALE = 256.f, V_SCALE = 32.f;

__device__ __forceinline__ void p0_prologue(Frame& F, const Args& args) {
    LAS float* scr = (LAS float*)(F.lds + F.wave * 16384);
    const int gw = F.gw, NGW = F.NGW, lane = F.lane;
    bf16_t* Win_t = (bf16_t*)(F.ws + WS_WIN); bf16_t* Wout_t = (bf16_t*)(F.ws + WS_WOUT); bf16_t* Wrkv_t = (bf16_t*)(F.ws + WS_WRKV); bf16_t* Wl2_t = (bf16_t*)(F.ws + WS_WL2); bf16_t* Wo_t = (bf16_t*)(F.ws + WS_WO);
    for (int it = gw; it < 16 * 88; it += NGW) transpose_item(args.in[1], 1024, 2816, Win_t, 1024, 0, 0, scr, it, lane);
    for (int it = gw; it < 22 * 32; it += NGW) transpose_item(args.in[9], 1408, 1024, Wout_t, 1408, 0, 0, scr, it, lane);
    for (int it = gw; it < 512; it += NGW) transpose_item(args.in[11], 1024, 1024, Wrkv_t, 1024, 0, 0, scr, it, lane);
    for (int it = gw; it < 512; it += NGW) transpose_item(args.in[12], 1024, 1024, Wrkv_t, 1024, 1024, 0, scr, it, lane);
    for (int it = gw; it < 512; it += NGW) transpose_item(args.in[13], 1024, 1024, Wrkv_t, 1024, 2048, 0, scr, it, lane);
    for (int it = gw; it < 32; it += NGW) transpose_item(args.in[15], 1024, 64, Wrkv_t, 1024, 3072, 0, scr, it, lane);
    for (int it = gw; it < 32; it += NGW) transpose_item(args.in[18], 1024, 64, Wrkv_t, 1024, 3328, 0, scr, it, lane);
    for (int it = gw; it < 64; it += NGW) transpose_item(args.in[20], 1024, 128, Wrkv_t, 1024, 3584, 0, scr, it, lane);
    for (int it = gw; it < 512; it += NGW) transpose_item(args.in[27], 1024, 1024, Wo_t, 1024, 0, 0, scr, it, lane);
    for (int it = gw; it < 32; it += NGW) transpose_item(args.in[16], 64, 1024, Wl2_t, 256, 0, 0, scr, it, lane);
    for (int it = gw; it < 32; it += NGW) transpose_item(args.in[19], 64, 1024, Wl2_t, 256, 1024, 64, scr, it, lane);
    for (int it = gw; it < 64; it += NGW) transpose_item(args.in[21], 128, 1024, Wl2_t, 256, 2048, 128, scr, it, lane);
    const size_t gt = (size_t)gw * 64 + lane, NGT = (size_t)NGW * 64;
    const u32x4 z4 = {0u, 0u, 0u, 0u};
    for (size_t i = gt; i < (size_t)768 * 128; i += NGT) {
        const int row = 3072 + (int)(i / 128), r = row - 3072; const bool data = (r < 64) || (r >= 256 && r < 320) || (r >= 512 && r < 640);
        if (!data) *(u32x4*)(Wrkv_t + (size_t)row * 1024 + (i % 128) * 8) = z4; }
    for (size_t i = gt; i < (size_t)3072 * 32; i += NGT) {
        const int row = (int)(i / 32), c8 = (int)(i % 32) * 8, g = row >> 10; const int lo = g == 0 ? 0 : (g == 1 ? 64 : 128), hi = g == 0 ? 64 : (g == 1 ? 128 : 256);
        if (c8 < lo || c8 >= hi) *(u32x4*)(Wl2_t + (size_t)row * 256 + c8) = z4; }
    { bf16_t* Wg_t = (bf16_t*)(F.ws + WS_WG);
      for (size_t i = gt; i < (size_t)2816 * 48; i += NGT) {
          const int row = (int)(i / 48), k8 = (int)(i % 48) * 8, q = row >> 8, r = row & 255, gs = r >> 7, ch = 128 * q + (r & 127), h = ch / HB, j = ch % HB;
          const float* w = (gs ? args.in[6] : args.in[4]) + (size_t)h * HB * HB; const int kg0 = gates_koff(q) + k8;
          float v[8];
#pragma unroll
          for (int e = 0; e < 8; ++e) { const int kg = kg0 + e; v[e] = (kg / HB == h) ? w[(kg % HB) * HB + j] : 0.f; }
          u32x4 o; o.x = pk2(v[0], v[1]); o.y = pk2(v[2], v[3]); o.z = pk2(v[4], v[5]); o.w = pk2(v[6], v[7]);
          *(u32x4*)(Wg_t + (size_t)row * 384 + k8) = o; } }
    for (int it = gw; it < 4096; it += NGW) {
        const int layer = it >> 11, hp = (it >> 7) & 15, n0 = ((it >> 4) & 7) * 16, k0 = (it & 15) * 64;
        const float* keys = args.in[29] + ((size_t)layer * 16 + hp) * 128 * 128; const float* wq = args.in[28] + (size_t)layer * 1024 * 2048 + hp * 128;
        bf16_t* We = (bf16_t*)(F.ws + WS_WPEER) + (size_t)layer * 2048 * 1024;
        f32x4 acc[4];
#pragma unroll
        for (int s = 0; s < 4; ++s) acc[s] = (f32x4){0.f, 0.f, 0.f, 0.f};
        const int li = lane & 15, q = lane >> 4;
        for (int dc = 0; dc < 8; ++dc) {
            const int d = 16 * dc + 4 * q;
            const f32x4 a = *(const f32x4*)(keys + (size_t)(n0 + li) * 128 + d);
            f32x4 b[4];
#pragma unroll
            for (int s = 0; s < 4; ++s) b[s] = *(const f32x4*)(wq + (size_t)(k0 + 16 * s + li) * 2048 + d);
#pragma unroll
            for (int e = 0; e < 4; ++e)
#pragma unroll
                for (int s = 0; s < 4; ++s) acc[s] = __builtin_amdgcn_mfma_f32_16x16x4f32(a[e], b[s][e], acc[s], 0, 0, 0);
        }
#pragma unroll
        for (int s = 0; s < 4; ++s)
#pragma unroll
            for (int r = 0; r < 4; ++r) We[(size_t)(hp * 128 + n0 + 4 * q + r) * 1024 + k0 + 16 * s + li] = (bf16_t)f2bf(acc[s][r]);
    }
    cvt_stream(args.in[0], (bf16_t*)(F.ws + WS_X0B), (size_t)T * D / 8, gt, NGT);
    cvt_stream_fp8(args.in[30], F.ws + WS_UB, (size_t)16384 * D / 16, gt, NGT, U_SCALE);
    cvt_stream_fp8(args.in[31], F.ws + WS_VB, (size_t)16384 * D / 16, gt, NGT, V_SCALE);
    { float* sl = (float*)(F.ws + WS_VEC); for (size_t i = gt; i < (size_t)W; i += NGT) { const float l = args.in[8][i]; sl[i] = -8.f * (l < -15.f ? -l : log1pf(expf(-l))); } }
}

struct ProbPlain { const char* A; const char* B; size_t strideA, strideB;
    __device__ __forceinline__ void locate(pg8::Unit& u) const { u.A = A + (size_t)u.pm * strideA; u.B = B + (size_t)u.pn * strideB; } };
struct ProbGates { const char* A; const char* B;
    __device__ __forceinline__ void locate(pg8::Unit& u) const { u.A = A + (size_t)u.pm * (256 * W * 2) + gates_koff(u.pn) * 2; u.B = B + (size_t)u.pn * (256 * 384 * 2); } };
struct ProbRkv { const char* mix; const char* B;
    __device__ __forceinline__ void locate(pg8::Unit& u) const { const int pn = u.pn; const int j = pn < 4 ? 0 : (pn < 8 ? 2 : (pn < 12 ? 3 : (pn == 12 ? 1 : (pn == 13 ? 4 : 5))));
        u.A = mix + (size_t)j * ((size_t)T * D * 2) + (size_t)u.pm * (256 * D * 2); u.B = B + (size_t)pn * (256 * D * 2); } };

struct EpiWin { static constexpr bool PERM = true; bf16_t* gate; bf16_t* h2;
    __device__ __forceinline__ void operator()(const f32x4 (&acc)[2][2][4][2], const pg8::Unit& u, int wr, int wc, int fr, int fq) const {
        const int row0 = u.pm * 256 + wr * 64 + fr;
#pragma unroll
        for (int bj = 0; bj < 2; ++bj) { const int hb = 2 * u.pn + bj; const bool isg = hb < 11; bf16_t* base = isg ? gate : h2; const int col = 128 * (isg ? hb : hb - 11) + wc * 32 + 8 * fq;
#pragma unroll
            for (int ai = 0; ai < 2; ++ai)
#pragma unroll
                for (int m = 0; m < 4; ++m) { f32x4 v0 = acc[ai][bj][m][0], v1 = acc[ai][bj][m][1];
                    if (isg) {
#pragma unroll
                        for (int j = 0; j < 4; ++j) { v0[j] = gelu_tanh(v0[j]); v1[j] = gelu_tanh(v1[j]); } }
                    u32x4 w; w.x = cvt_pk_bf16(v0[0], v0[1]); w.y = cvt_pk_bf16(v0[2], v0[3]); w.z = cvt_pk_bf16(v1[0], v1[1]); w.w = cvt_pk_bf16(v1[2], v1[3]);
                    *(u32x4*)(base + (size_t)(row0 + ai * 128 + m * 16) * W + col) = w; } }
    } };
struct EpiGates { static constexpr bool PERM = false; const bf16_t* xc; const float* sl; const float* ba; const float* bx; bf16_t* a; bf16_t* uo;
    __device__ __forceinline__ void operator()(const f32x4 (&acc)[2][2][4][2], const pg8::Unit& u, int wr, int wc, int fr, int fq) const {
        const int row0 = u.pm * 256 + wr * 64 + fr;
#pragma unroll
        for (int ai = 0; ai < 2; ++ai)
#pragma unroll
            for (int m = 0; m < 4; ++m) {
#pragma unroll
                for (int n = 0; n < 2; ++n) { const int c = 128 * u.pn + wc * 32 + 16 * n + 4 * fq; const size_t off = (size_t)(row0 + ai * 128 + m * 16) * W + c;
                    const f32x4 s4 = *(const f32x4*)(sl + c), ba4 = *(const f32x4*)(ba + c), bx4 = *(const f32x4*)(bx + c);
                    const u32x2 xw = *(const u32x2*)(xc + off);
                    const f32x4 pa = acc[ai][0][m][n] + ba4, px = acc[ai][1][m][n] + bx4; f32x4 av, uv; const f32x4 xs = {bf_lo(xw.x), bf_hi(xw.x), bf_lo(xw.y), bf_hi(xw.y)};
#pragma unroll
                    for (int j = 0; j < 4; ++j) { const float r = fast_sigmoid(pa[j]), ig = fast_sigmoid(px[j]); const float la = s4[j] * r; const float aa = fast_exp(la);
                        av[j] = la; uv[j] = sqrtf(fmaxf(1.f - aa * aa, 0.f)) * ig * xs[j]; }
                    { u32x2 w1; w1.x = pk2(av[0], av[1]); w1.y = pk2(av[2], av[3]); *(u32x2*)(a + off) = w1; u32x2 w2; w2.x = pk2(uv[0], uv[1]); w2.y = pk2(uv[2], uv[3]); *(u32x2*)(uo + off) = w2; } __builtin_amdgcn_sched_barrier(0); }
                asm volatile("" ::: "memory"); }
    } };
struct EpiRes { static constexpr bool PERM = false; const float* res; float* z;
    __device__ __forceinline__ void operator()(const f32x4 (&acc)[2][2][4][2], const pg8::Unit& u, int wr, int wc, int fr, int fq) const {
        const int row0 = u.pm * 256 + wr * 64 + fr, col0 = u.pn * 256 + wc * 32 + 4 * fq;
#pragma unroll
        for (int ai = 0; ai < 2; ++ai)
#pragma unroll
            for (int m = 0; m < 4; ++m) { const size_t off = (size_t)(row0 + ai * 128 + m * 16) * D + col0;
#pragma unroll
                for (int bj = 0; bj < 2; ++bj)
#pragma unroll
                    for (int n = 0; n < 2; ++n) { const f32x4 r4 = *(const f32x4*)(res + off + bj * 128 + n * 16); *(f32x4*)(z + off + bj * 128 + n * 16) = r4 * ALPHA + acc[ai][bj][m][n]; } }
    } };
struct EpiScores { static constexpr bool PERM = false; float* sc;
    __device__ __forceinline__ void operator()(const f32x4 (&acc)[2][2][4][2], const pg8::Unit& u, int wr, int wc, int fr, int fq) const {
#pragma unroll
        for (int ai = 0; ai < 2; ++ai) { const int tb = 4 * u.pm + 2 * ai + wr;
#pragma unroll
            for (int bj = 0; bj < 2; ++bj) { const int hp = 2 * u.pn + bj; float* base = sc + ((size_t)(tb * 16 + hp) * 128) * 64;
#pragma unroll
                for (int m = 0; m < 4; ++m) { const int tl = 16 * m + fr;
#pragma unroll
                    for (int n = 0; n < 2; ++n) { const int nn = 32 * wc + 16 * n + 4 * fq;
#pragma unroll
                        for (int j = 0; j < 4; ++j) base[(size_t)(nn + j) * 64 + tl] = acc[ai][bj][m][n][j]; } } } }
    } };
struct EpiRkv { static constexpr bool PERM = true; bf16_t* r; bf16_t* lora;
    __device__ __forceinline__ void operator()(const f32x4 (&acc)[2][2][4][2], const pg8::Unit& u, int wr, int wc, int fr, int fq) const {
        const int row0 = u.pm * 256 + wr * 64 + fr, pn = u.pn;
        if (pn < 12) { bf16_t* base = r + (size_t)(pn >> 2) * ((size_t)T * D); const int col0 = (pn & 3) * 256 + wc * 32 + 8 * fq;
#pragma unroll
            for (int ai = 0; ai < 2; ++ai)
#pragma unroll
                for (int m = 0; m < 4; ++m)
#pragma unroll
                    for (int bj = 0; bj < 2; ++bj) { const f32x4 v0 = acc[ai][bj][m][0], v1 = acc[ai][bj][m][1];
                        u32x4 w; w.x = cvt_pk_bf16(v0[0], v0[1]); w.y = cvt_pk_bf16(v0[2], v0[3]); w.z = cvt_pk_bf16(v1[0], v1[1]); w.w = cvt_pk_bf16(v1[2], v1[3]);
                        *(u32x4*)(base + (size_t)(row0 + ai * 128 + m * 16) * D + col0 + bj * 128) = w; }
        } else {
            const int kind = pn - 12;
            const int lim = kind == 2 ? 128 : 64, dst0 = kind == 0 ? 0 : (kind == 1 ? 64 : 128);
#pragma unroll
            for (int bj = 0; bj < 2; ++bj) { const int cl = 128 * bj + wc * 32 + 8 * fq; if (cl < lim) {
#pragma unroll
                for (int ai = 0; ai < 2; ++ai)
#pragma unroll
                    for (int m = 0; m < 4; ++m) { f32x4 v0 = acc[ai][bj][m][0], v1 = acc[ai][bj][m][1];
#pragma unroll
                        for (int j = 0; j < 4; ++j) { if (kind == 0) { v0[j] = fast_tanh(v0[j]); v1[j] = fast_tanh(v1[j]); } else if (kind == 2) { v0[j] = fast_sigmoid(v0[j]); v1[j] = fast_sigmoid(v1[j]); } }
                        u32x4 w; w.x = cvt_pk_bf16(v0[0], v0[1]); w.y = cvt_pk_bf16(v0[2], v0[3]); w.z = cvt_pk_bf16(v1[0], v1[1]); w.w = cvt_pk_bf16(v1[2], v1[3]);
                        *(u32x4*)(lora + (size_t)(row0 + ai * 128 + m * 16) * 256 + dst0 + cl) = w; } } }
        }
    } };
struct EpiLora2 { static constexpr bool PERM = true; float* wdec; bf16_t* aa; const float* w0; const float* a0;
    __device__ __forceinline__ void operator()(const f32x4 (&acc)[2][2][4][2], const pg8::Unit& u, int wr, int wc, int fr, int fq) const {
        const int row0 = u.pm * 256 + wr * 64 + fr, pn = u.pn, kind = pn >> 2;
#pragma unroll
        for (int bj = 0; bj < 2; ++bj) { const int col = (pn & 3) * 256 + 128 * bj + wc * 32 + 8 * fq;
            f32x4 c0 = {0.f, 0.f, 0.f, 0.f}, c1 = c0;
            if (kind == 0) { c0 = *(const f32x4*)(w0 + col); c1 = *(const f32x4*)(w0 + col + 4); } else if (kind == 1) { c0 = *(const f32x4*)(a0 + col); c1 = *(const f32x4*)(a0 + col + 4); }
#pragma unroll
            for (int ai = 0; ai < 2; ++ai)
#pragma unroll
                for (int m = 0; m < 4; ++m) { f32x4 v0 = acc[ai][bj][m][0] + c0, v1 = acc[ai][bj][m][1] + c1; const size_t off = (size_t)(row0 + ai * 128 + m * 16) * D + col;
                    if (kind == 0) {
#pragma unroll
                        for (int j = 0; j < 4; ++j) { v0[j] = fast_exp(-0.60653066f * fast_sigmoid(v0[j])); v1[j] = fast_exp(-0.60653066f * fast_sigmoid(v1[j])); }
                        *(f32x4*)(wdec + off) = v0; *(f32x4*)(wdec + off + 4) = v1;
                    } else {
                        if (kind == 1) {
#pragma unroll
                            for (int j = 0; j < 4; ++j) { v0[j] = fast_sigmoid(v0[j]); v1[j] = fast_sigmoid(v1[j]); } }
                        u32x4 w; w.x = cvt_pk_bf16(v0[0], v0[1]); w.y = cvt_pk_bf16(v0[2], v0[3]); w.z = cvt_pk_bf16(v1[0], v1[1]); w.w = cvt_pk_bf16(v1[2], v1[3]);
                        *(u32x4*)(aa + (size_t)(kind - 1) * ((size_t)T * D) + off) = w; }
                    __builtin_amdgcn_sched_barrier(0); } }
    } };

template <class Epi, class Prob>
__device__ __forceinline__ void run_gemm(Frame& F, int nM, int nN, int lda, int ldb, int K, const Prob& P, const Epi& E) {
    pg8::Order<Prob> S; S.init(nM, nN, F.G, F.bx, P);
    pg8::gemm_phase<Epi, pg8::Order<Prob>, true, true>(F.lds, F.tid, lda, ldb, K, S, E);
}

__device__ __forceinline__ void conv_phase(Frame& F, const float* cw, const float* cb) {
    const bf16_t* h2 = (const bf16_t*)(F.ws + WS_H2); bf16_t* xc = (bf16_t*)(F.ws + WS_XC);
    const size_t gt = (size_t)F.gw * 64 + F.lane, NGT = (size_t)F.NGW * 64;
    for (size_t i = gt; i < (size_t)T * (W / 8); i += NGT) {
        const int t = (int)(i / (W / 8)), c = (int)(i % (W / 8)) * 8, s = t & (S - 1);
        float acc[8];
        { const f32x4 b0 = *(const f32x4*)(cb + c), b1 = *(const f32x4*)(cb + c + 4); acc[0] = b0.x; acc[1] = b0.y; acc[2] = b0.z; acc[3] = b0.w; acc[4] = b1.x; acc[5] = b1.y; acc[6] = b1.z; acc[7] = b1.w; }
#pragma unroll
        for (int j = 0; j < 4; ++j) { if (s - 3 + j >= 0) {
            const u32x4 hv = *(const u32x4*)(h2 + (size_t)(t - 3 + j) * W + c); const f32x4 w0 = *(const f32x4*)(cw + j * W + c), w1 = *(const f32x4*)(cw + j * W + c + 4);
            acc[0] += w0.x * bf_lo(hv.x); acc[1] += w0.y * bf_hi(hv.x); acc[2] += w0.z * bf_lo(hv.y); acc[3] += w0.w * bf_hi(hv.y);
            acc[4] += w1.x * bf_lo(hv.z); acc[5] += w1.y * bf_hi(hv.z); acc[6] += w1.z * bf_lo(hv.w); acc[7] += w1.w * bf_hi(hv.w); } }
        u32x4 o; o.x = pk2(acc[0], acc[1]); o.y = pk2(acc[2], acc[3]); o.z = pk2(acc[4], acc[5]); o.w = pk2(acc[6], acc[7]);
        *(u32x4*)(xc + (size_t)t * W + c) = o;
    }
}
constexpr int RG_CH = 32, RG_NCH = S / RG_CH;
__device__ __forceinline__ void rgscan1_phase(Frame& F) {
    const bf16_t* a = (const bf16_t*)(F.ws + WS_A); const bf16_t* u = (const bf16_t*)(F.ws + WS_U); float* agg = (float*)(F.ws + WS_AGG);
    for (int it = F.gw; it < NB * RG_NCH * 11; it += F.NGW) {
        const int cg = it % 11, ch = (it / 11) % RG_NCH, b = it / (11 * RG_NCH), c = cg * 128 + 2 * F.lane; const size_t t0 = (size_t)b * S + (size_t)ch * RG_CH;
        f32x2 P = {0.f, 0.f}, H = {0.f, 0.f};
#pragma unroll 8
        for (int s = 0; s < RG_CH; ++s) { const unsigned aw = *(const unsigned*)(a + (t0 + s) * W + c), uw = *(const unsigned*)(u + (t0 + s) * W + c); const f32x2 la = {bf_lo(aw), bf_hi(aw)}, uv = {bf_lo(uw), bf_hi(uw)};
            const f32x2 av = {fast_exp(la.x), fast_exp(la.y)}; H = av * H + uv; P = P + la; }
        P = (f32x2){fast_exp(P.x), fast_exp(P.y)};
        const size_t o = (size_t)(b * RG_NCH + ch) * W + c; *(f32x2*)(agg + o) = P; *(f32x2*)(agg + o + (size_t)NB * RG_NCH * W) = H;
    }
}
__device__ __forceinline__ void rgscan2_phase(Frame& F) {
    const bf16_t* a = (const bf16_t*)(F.ws + WS_A); const bf16_t* u = (const bf16_t*)(F.ws + WS_U); const float* agg = (const float*)(F.ws + WS_AGG);
    const bf16_t* gate = (const bf16_t*)(F.ws + WS_GATE); bf16_t* y = (bf16_t*)(F.ws + WS_Y);
    for (int it = F.gw; it < NB * RG_NCH * 11; it += F.NGW) {
        const int cg = it % 11, ch = (it / 11) % RG_NCH, b = it / (11 * RG_NCH), c = cg * 128 + 2 * F.lane; const size_t t0 = (size_t)b * S + (size_t)ch * RG_CH;
        f32x2 H = {0.f, 0.f};
        for (int j = 0; j < ch; ++j) { const size_t o = (size_t)(b * RG_NCH + j) * W + c; const f32x2 Pj = *(const f32x2*)(agg + o), Hj = *(const f32x2*)(agg + o + (size_t)NB * RG_NCH * W); H = Pj * H + Hj; }
#pragma unroll 8
        for (int s = 0; s < RG_CH; ++s) { const size_t o = (t0 + s) * W + c; const unsigned aw = *(const unsigned*)(a + o), uw = *(const unsigned*)(u + o); const f32x2 av = {fast_exp(bf_lo(aw)), fast_exp(bf_hi(aw))}, uv = {bf_lo(uw), bf_hi(uw)}; H = av * H + uv;
            const unsigned gw_ = *(const unsigned*)(gate + o); *(unsigned*)(y + o) = pk2(H.x * bf_lo(gw_), H.y * bf_hi(gw_)); }
    }
}
__device__ __forceinline__ void ln_phase(Frame& F, const float* z, const float* g, const float* bb, float* xf, bf16_t* xb) {
    for (int m = F.gw; m < T; m += F.NGW) {
        const f32x4* zr = (const f32x4*)(z + (size_t)m * D) + F.lane; f32x4 v[4]; float s = 0.f;
#pragma unroll
        for (int j = 0; j < 4; ++j) { v[j] = zr[64 * j]; s += (v[j].x + v[j].y) + (v[j].z + v[j].w); }
        const float mean = wave_sum(s) * (1.f / D); float s2 = 0.f;
#pragma unroll
        for (int j = 0; j < 4; ++j) { v[j] = v[j] - mean; s2 += (v[j].x * v[j].x + v[j].y * v[j].y) + (v[j].z * v[j].z + v[j].w * v[j].w); }
        const float rstd = 1.f / sqrtf(wave_sum(s2) * (1.f / D) + LN_EPS);
#pragma unroll
        for (int j = 0; j < 4; ++j) { const int c = 4 * F.lane + 256 * j; const f32x4 o = v[j] * rstd * *(const f32x4*)(g + c) + *(const f32x4*)(bb + c);
            *(f32x4*)(xf + (size_t)m * D + c) = o; if (xb) { u32x2 w; w.x = pk2(o.x, o.y); w.y = pk2(o.z, o.w); *(u32x2*)(xb + (size_t)m * D + c) = w; } }
    }
}
__device__ __forceinline__ void ce_desc(float& a, float& b) { const float hi = fmaxf(a, b), lo = fminf(a, b); a = hi; b = lo; }
__device__ __forceinline__ void sort16_desc(float (&a)[16]) {
#pragma unroll
    for (int k = 2; k <= 16; k <<= 1)
#pragma unroll
        for (int j = k >> 1; j > 0; j >>= 1)
#pragma unroll
            for (int i = 0; i < 16; ++i) { const int l = i ^ j; if (l > i) { if ((i & k) == 0) ce_desc(a[i], a[l]); else ce_desc(a[l], a[i]); } }
}
__device__ __forceinline__ void merge_top16(float (&t)[16], const float (&b)[16]) {
#pragma unroll
    for (int i = 0; i < 16; ++i) t[i] = fmaxf(t[i], b[15 - i]);
#pragma unroll
    for (int j = 8; j > 0; j >>= 1)
#pragma unroll
        for (int i = 0; i < 16; ++i) { const int l = i ^ j; if (l > i) ce_desc(t[i], t[l]); }
}
__device__ __forceinline__ float pack_idx7(float v, int n) { return __builtin_bit_cast(float, (__builtin_bit_cast(unsigned, v) & ~127u) | (unsigned)(127 - n)); }
__device__ __forceinline__ void top16_of_128(float (&s)[16], const float* p) {
    { float g[16];
#pragma unroll
      for (int i = 0; i < 16; ++i) g[i] = pack_idx7(p[(size_t)i * 64], i);
      sort16_desc(g);
#pragma unroll
      for (int i = 0; i < 16; ++i) s[i] = g[i]; }
#pragma unroll 1
    for (int grp = 1; grp < 8; ++grp) { float g[16];
#pragma unroll
        for (int i = 0; i < 16; ++i) g[i] = pack_idx7(p[(size_t)(16 * grp + i) * 64], 16 * grp + i);
        sort16_desc(g); merge_top16(s, g); }
}
__device__ __forceinline__ void topk_phase(Frame& F, const float* sc, int* eid, float* gwt) {
    for (int it = F.gw; it < (T / 64) * 8; it += F.NGW) {
        const int tb = it >> 3, h = it & 7, t = tb * 64 + F.lane;
        float s0[16], s1[16];
        const float* p0 = sc + ((size_t)(tb * 16 + 2 * h) * 128) * 64 + F.lane;
        top16_of_128(s0, p0); top16_of_128(s1, p0 + 128 * 64);
        float tt[16];
        { float g[16];
#define PAIR(i, j) __builtin_bit_cast(float, (__builtin_bit_cast(unsigned, s0[i] + s1[j]) & ~255u) | (unsigned)(255 - ((i) * 16 + (j))))
          const float NI = -__builtin_inff();
          g[0] = PAIR(0,0); g[1] = PAIR(0,1); g[2] = PAIR(0,2); g[3] = PAIR(0,3); g[4] = PAIR(0,4); g[5] = PAIR(0,5); g[6] = PAIR(0,6); g[7] = PAIR(0,7);
          g[8] = PAIR(0,8); g[9] = PAIR(0,9); g[10] = PAIR(0,10); g[11] = PAIR(0,11); g[12] = PAIR(0,12); g[13] = PAIR(0,13); g[14] = PAIR(0,14); g[15] = PAIR(0,15);
          sort16_desc(g);
#pragma unroll
          for (int i = 0; i < 16; ++i) tt[i] = g[i];
          g[0] = PAIR(1,0); g[1] = PAIR(1,1); g[2] = PAIR(1,2); g[3] = PAIR(1,3); g[4] = PAIR(1,4); g[5] = PAIR(1,5); g[6] = PAIR(1,6); g[7] = PAIR(1,7);
          g[8] = PAIR(2,0); g[9] = PAIR(2,1); g[10] = PAIR(2,2); g[11] = PAIR(2,3); g[12] = PAIR(2,4); g[13] = PAIR(3,0); g[14] = PAIR(3,1); g[15] = PAIR(3,2);
          sort16_desc(g); merge_top16(tt, g);
          g[0] = PAIR(3,3); g[1] = PAIR(4,0); g[2] = PAIR(4,1); g[3] = PAIR(4,2); g[4] = PAIR(5,0); g[5] = PAIR(5,1); g[6] = PAIR(6,0); g[7] = PAIR(6,1);
          g[8] = PAIR(7,0); g[9] = PAIR(7,1); g[10] = PAIR(8,0); g[11] = PAIR(9,0); g[12] = PAIR(10,0); g[13] = PAIR(11,0); g[14] = PAIR(12,0); g[15] = PAIR(13,0);
          sort16_desc(g); merge_top16(tt, g);
          g[0] = PAIR(14,0); g[1] = PAIR(15,0); g[2] = NI; g[3] = NI; g[4] = NI; g[5] = NI; g[6] = NI; g[7] = NI; g[8] = NI; g[9] = NI; g[10] = NI; g[11] = NI; g[12] = NI; g[13] = NI; g[14] = NI; g[15] = NI;
          ce_desc(g[0], g[1]); merge_top16(tt, g);
#undef PAIR
        }
        float e[16], sum = 0.f;
#pragma unroll
        for (int r = 0; r < 16; ++r) { e[r] = fast_exp(tt[r] - tt[0]); sum += e[r]; }
        const float inv = 1.f / sum;
        int ids[16];
#pragma unroll
        for (int r = 0; r < 16; ++r) { const unsigned code = 255u - (__builtin_bit_cast(unsigned, tt[r]) & 255u); const unsigned ci = code >> 4, cj = code & 15u; unsigned i0 = 0, i1 = 0;
#pragma unroll
            for (int i = 0; i < 16; ++i) { i0 = (ci == (unsigned)i) ? (127u - (__builtin_bit_cast(unsigned, s0[i]) & 127u)) : i0; i1 = (cj == (unsigned)i) ? (127u - (__builtin_bit_cast(unsigned, s1[i]) & 127u)) : i1; }
            ids[r] = (int)(i0 * 128u + i1); }
        int* ep = eid + (size_t)t * 128 + h * 16; float* gp = gwt + (size_t)t * 128 + h * 16;
#pragma unroll
        for (int r = 0; r < 16; r += 4) { *(int4*)(ep + r) = make_int4(ids[r], ids[r + 1], ids[r + 2], ids[r + 3]); *(f32x4*)(gp + r) = (f32x4){e[r] * inv, e[r + 1] * inv, e[r + 2] * inv, e[r + 3] * inv}; }
    }
}
__device__ __forceinline__ f32x2 fp8lo(unsigned w) { return __builtin_amdgcn_cvt_pk_f32_fp8((int)w, false); }
__device__ __forceinline__ f32x2 fp8hi(unsigned w) { return __builtin_amdgcn_cvt_pk_f32_fp8((int)w, true); }
__device__ __forceinline__ float gu_dot(const u32x4& r, const f32x2 (&xs)[8]) { f32x2 d = fp8lo(r.x) * xs[0]; d += fp8hi(r.x) * xs[1]; d += fp8lo(r.y) * xs[2]; d += fp8hi(r.y) * xs[3];
    d += fp8lo(r.z) * xs[4]; d += fp8hi(r.z) * xs[5]; d += fp8lo(r.w) * xs[6]; d += fp8hi(r.w) * xs[7]; return sum8(d.x + d.y); }
__device__ __forceinline__ void gu_phase(Frame& F, const float* xf, const int* eid, float* part) {
    const int j = F.bx & 7, sg = F.bx >> 3, lane = F.lane, e8 = lane >> 3, dch = lane & 7;
    const unsigned char* Ub = F.ws + WS_UB + (size_t)j * ((size_t)16384 * 128); float* pj = part + (size_t)j * T * 128; const unsigned lo16 = 16u * dch;
    constexpr int TPW = T / (32 * NWAVES); const int tb = sg * (T / 32) + F.wave * TPW;
    int e0 = eid[(size_t)tb * 128 + lane], e1 = eid[(size_t)tb * 128 + 64 + lane];
    f32x4 xq[4];
#pragma unroll
    for (int q = 0; q < 4; ++q) xq[q] = *(const f32x4*)(xf + (size_t)tb * D + 128 * j + 16 * dch + 4 * q);
#pragma unroll 1
    for (int it = 0; it < TPW; ++it) { const int t = tb + it;
        u32x4 ra[16];
#pragma unroll
        for (int i = 0; i < 16; ++i) { const int ia = __shfl(i < 8 ? e0 : e1, (8 * i + e8) & 63); ra[i] = *(const u32x4*)(Ub + ((unsigned)ia * 128u + lo16)); }
        f32x2 xs[8];
#pragma unroll
        for (int q = 0; q < 4; ++q) { const f32x4 x0 = xq[q] * (1.f / U_SCALE); xs[2 * q] = (f32x2){x0.x, x0.y}; xs[2 * q + 1] = (f32x2){x0.z, x0.w}; }
        const int tn = (it + 1 < TPW) ? t + 1 : t;
        e0 = eid[(size_t)tn * 128 + lane]; e1 = eid[(size_t)tn * 128 + 64 + lane];
#pragma unroll
        for (int q = 0; q < 4; ++q) xq[q] = *(const f32x4*)(xf + (size_t)tn * D + 128 * j + 16 * dch + 4 * q);
        float a0 = 0.f, a1 = 0.f;
#pragma unroll
        for (int i = 0; i < 16; ++i) { const float sa = gu_dot(ra[i], xs); if ((i & 7) == dch) { if (i < 8) a0 = sa; else a1 = sa; } }
        pj[(size_t)t * 128 + 8 * dch + e8] = a0; pj[(size_t)t * 128 + 64 + 8 * dch + e8] = a1;
    }
}
__device__ __forceinline__ void gr_phase(Frame& F, const float* part, float* gwt) {
    const size_t gt = (size_t)F.gw * 64 + F.lane, NGT = (size_t)F.NGW * 64;
    for (size_t i = gt; i < (size_t)T * 32; i += NGT) { f32x4 a = *(const f32x4*)(part + 4 * i);
#pragma unroll
        for (int jj = 1; jj < 8; ++jj) a += *(const f32x4*)(part + (size_t)jj * T * 128 + 4 * i);
        f32x4 g = *(const f32x4*)(gwt + 4 * i);
        g.x *= gelu_tanh(a.x) * (1.f / V_SCALE); g.y *= gelu_tanh(a.y) * (1.f / V_SCALE); g.z *= gelu_tanh(a.z) * (1.f / V_SCALE); g.w *= gelu_tanh(a.w) * (1.f / V_SCALE);
        *(f32x4*)(gwt + 4 * i) = g; }
}
__device__ __forceinline__ void gv_acc(f32x2 (&acc)[8], const u32x4& r, const float c) { const f32x2 c2 = {c, c};
    acc[0] += c2 * fp8lo(r.x); acc[1] += c2 * fp8hi(r.x); acc[2] += c2 * fp8lo(r.y); acc[3] += c2 * fp8hi(r.y); acc[4] += c2 * fp8lo(r.z); acc[5] += c2 * fp8hi(r.z); acc[6] += c2 * fp8lo(r.w); acc[7] += c2 * fp8hi(r.w); }
__device__ __forceinline__ void gv_phase(Frame& F, const float* xf, const int* eid, const float* coef, float* z) {
    const int j = F.bx & 7, sg = F.bx >> 3, lane = F.lane, e8 = lane >> 3, dch = lane & 7;
    const unsigned char* Vb = F.ws + WS_VB + (size_t)j * ((size_t)16384 * 128); const unsigned lo16 = 16u * dch;
    const bool b3 = lane & 8, b4 = lane & 16, b5 = lane & 32;
    const int dd = 128 * j + 16 * dch + 2 * ((b3 ? 4 : 0) + (b4 ? 2 : 0) + (b5 ? 1 : 0));
    constexpr int TPW = T / (32 * NWAVES); const int tb = sg * (T / 32) + F.wave * TPW;
    int e0 = eid[(size_t)tb * 128 + lane], e1 = eid[(size_t)tb * 128 + 64 + lane]; float c0 = coef[(size_t)tb * 128 + lane], c1 = coef[(size_t)tb * 128 + 64 + lane];
    f32x2 xr = *(const f32x2*)(xf + (size_t)tb * D + dd);
#pragma unroll 1
    for (int it = 0; it < TPW; ++it) { const int t = tb + it;
        u32x4 ra[16]; float cf[16];
#pragma unroll
        for (int i = 0; i < 16; ++i) { const int ia = __shfl(i < 8 ? e0 : e1, (8 * i + e8) & 63); ra[i] = *(const u32x4*)(Vb + ((unsigned)ia * 128u + lo16)); cf[i] = __shfl(i < 8 ? c0 : c1, (8 * i + e8) & 63); }
        const f32x2 xcur = xr; const int tn = (it + 1 < TPW) ? t + 1 : t;
        e0 = eid[(size_t)tn * 128 + lane]; e1 = eid[(size_t)tn * 128 + 64 + lane]; c0 = coef[(size_t)tn * 128 + lane]; c1 = coef[(size_t)tn * 128 + 64 + lane];
        xr = *(const f32x2*)(xf + (size_t)tn * D + dd);
        f32x2 acc[8];
#pragma unroll
        for (int m = 0; m < 8; ++m) acc[m] = (f32x2){0.f, 0.f};
#pragma unroll
        for (int i = 0; i < 16; ++i) gv_acc(acc, ra[i], cf[i]);
        f32x2 q[4], p[2], v;
#pragma unroll
        for (int i = 0; i < 4; ++i) { const f32x2 keep = b3 ? acc[4 + i] : acc[i], send = b3 ? acc[i] : acc[4 + i]; q[i] = keep + (f32x2){dpp_f<DPP_ROW_ROR(8)>(send.x), dpp_f<DPP_ROW_ROR(8)>(send.y)}; }
#pragma unroll
        for (int i = 0; i < 2; ++i) { const f32x2 keep = b4 ? q[2 + i] : q[i], send = b4 ? q[i] : q[2 + i]; p[i] = keep + (f32x2){__shfl_xor(send.x, 16), __shfl_xor(send.y, 16)}; }
        { const f32x2 keep = b5 ? p[1] : p[0], send = b5 ? p[0] : p[1]; v = keep + (f32x2){__shfl_xor(send.x, 32), __shfl_xor(send.y, 32)}; }
        *(f32x2*)(z + (size_t)t * D + dd) = xcur * ALPHA + v;
    }
}
__device__ __forceinline__ void mix_phase(Frame& F, const float* mix) {
    const float* xf = (const float*)(F.ws + WS_XF); bf16_t* mx = (bf16_t*)(F.ws + WS_MIX);
    const size_t gt = (size_t)F.gw * 64 + F.lane, NGT = (size_t)F.NGW * 64;
    for (size_t i = gt; i < (size_t)T * (D / 8); i += NGT) {
        const int t = (int)(i >> 7), c = (int)(i & 127) * 8, s = t & (S - 1);
        const f32x4 x0 = *(const f32x4*)(xf + (size_t)t * D + c), x1 = *(const f32x4*)(xf + (size_t)t * D + c + 4);
        f32x4 p0 = {0.f, 0.f, 0.f, 0.f}, p1 = p0;
        if (s > 0) { p0 = *(const f32x4*)(xf + (size_t)(t - 1) * D + c); p1 = *(const f32x4*)(xf + (size_t)(t - 1) * D + c + 4); }
        const f32x4 d0 = p0 - x0, d1 = p1 - x1;
#pragma unroll
        for (int m = 0; m < 6; ++m) { const f32x4 m0 = *(const f32x4*)(mix + m * D + c), m1 = *(const f32x4*)(mix + m * D + c + 4); const f32x4 o0 = x0 + d0 * m0, o1 = x1 + d1 * m1;
            u32x4 o; o.x = pk2(o0.x, o0.y); o.y = pk2(o0.z, o0.w); o.z = pk2(o1.x, o1.y); o.w = pk2(o1.z, o1.w);
            *(u32x4*)(mx + (size_t)m * ((size_t)T * D) + (size_t)t * D + c) = o; }
    }
}
typedef float f32x16 __attribute__((ext_vector_type(16)));
constexpr int RWL = 32, RW_NCH = S / RWL;
constexpr int PK_A2 = 0, PK_RT = 4096, PK_MBR = 8192, PK_BH = 10240, PK_N2 = 14336, PK_MKR = 16384, PK_KH = 18432, PK_VT = 22528, PK_GL = 26624, PK_BON = 26880, PK_BYTES = 27648;
constexpr size_t PK_BATCH = (size_t)1024 * PK_BYTES;
__device__ __forceinline__ unsigned char* pack_ptr(unsigned char* ws, float* out, int b, int hc) {
    unsigned char* base = b < 2 ? ws + 34 * MiB + (size_t)b * PK_BATCH : (b == 2 ? ws + 322 * MiB : (b < 6 ? ws + 414 * MiB + (size_t)(b - 3) * PK_BATCH : (unsigned char*)out + (size_t)(b - 6) * PK_BATCH));
    return base + (size_t)hc * PK_BYTES;
}
__device__ __forceinline__ bf16x8 frag_acc(const f32x16& x, const int s) {
    u32x4 w; w.x = cvt_pk_bf16_c(x[8 * s + 0], x[8 * s + 1]); w.y = cvt_pk_bf16_c(x[8 * s + 2], x[8 * s + 3]); w.z = cvt_pk_bf16_c(x[8 * s + 4], x[8 * s + 5]); w.w = cvt_pk_bf16_c(x[8 * s + 6], x[8 * s + 7]);
    return __builtin_bit_cast(bf16x8, w);
}
__device__ __forceinline__ f32x16 mfma32(bf16x8 a, bf16x8 b, f32x16 c) { return __builtin_amdgcn_mfma_f32_32x32x16_bf16(a, b, c, 0, 0, 0); }
__device__ __forceinline__ float wave_sum_fast(float v) { v = sum16(v); v += __shfl_xor(v, 16); v += __shfl_xor(v, 32); return v; }
#define F16ZERO (f32x16){0.f,0.f,0.f,0.f,0.f,0.f,0.f,0.f,0.f,0.f,0.f,0.f,0.f,0.f,0.f,0.f}

__device__ __forceinline__ void rwprep_phase(Frame& F, const Args& args, const int nbatch) {
    const int lane0 = F.lane;
    LAS unsigned char* wl = F.lds + F.wave * 18432;
    const bf16_t* R = (const bf16_t*)(F.ws + WS_R); const bf16_t* Kt_ = (const bf16_t*)(F.ws + WS_K); const bf16_t* Vt_ = (const bf16_t*)(F.ws + WS_V);
    const bf16_t* AA = (const bf16_t*)(F.ws + WS_AA); const float* WD = (const float*)(F.ws + WS_WDEC);
    for (int it = F.gw; it < nbatch * NH * RW_NCH; it += F.NGW) {
        int lane = lane0; asm volatile("" : "+v"(lane));
        const int r = lane & 31, hh = lane >> 5;
        const int b = it / (NH * RW_NCH), hc = it % (NH * RW_NCH), h = hc / RW_NCH, c = hc % RW_NCH, ch = h * 64 + lane;
        unsigned char* pk = pack_ptr(F.ws, F.out, b, hc);
        const float kkc = args.in[22][ch], kac = args.in[23][ch], rkc = args.in[24][ch];
        const size_t tok0 = (size_t)b * S + (size_t)c * RWL;
        const int posj = 16 * (lane >> 4) + ((lane & 3) | ((lane & 4) << 1) | ((lane & 8) >> 1));
        float gam = 1.f, bon = 0.f;
#pragma unroll 1
        for (int blk = 0; blk < 2; ++blk) {
            unsigned short rr[16], kr[16], ar[16]; float wv[16];
#pragma unroll
            for (int q = 0; q < 16; ++q) { const size_t off = (tok0 + 16 * blk + q) * D + ch; rr[q] = R[off]; kr[q] = Kt_[off]; ar[q] = AA[off]; wv[q] = WD[off]; }
#pragma unroll
            for (int q = 0; q < 16; ++q) { const int t = 16 * blk + q;
                const float rv = __builtin_bit_cast(float, (unsigned)rr[q] << 16), kv = __builtin_bit_cast(float, (unsigned)kr[q] << 16), al = __builtin_bit_cast(float, (unsigned)ar[q] << 16), w = wv[q];
                const float kkr = kv * kkc; const float ss = wave_sum_fast(kkr * kkr); const float kk = kkr / fmaxf(sqrtf(ss), 1e-12f);
                const float km = kv * (1.f + (al - 1.f) * kac);
                const float bs = wave_sum_fast(rv * km * rkc); bon = (lane == t) ? bs : bon;
                const float at = gam * (-kk); gam *= w; const float inv = 1.f / gam;
                const float bt = kk * al * inv, ktv = km * inv, rt = gam * rv;
                *(LAS bf16_t*)(wl + 0 + t * 144 + lane * 2) = (bf16_t)f2bf(at); *(LAS bf16_t*)(wl + 4608 + t * 144 + lane * 2) = (bf16_t)f2bf(bt);
                *(LAS bf16_t*)(wl + 9216 + t * 144 + lane * 2) = (bf16_t)f2bf(ktv); *(LAS bf16_t*)(wl + 13824 + t * 144 + lane * 2) = (bf16_t)f2bf(rt);
                *(bf16_t*)(pk + PK_RT + t * 128 + posj * 2) = (bf16_t)f2bf(rt);
            }
        }
        const float gamL = gam;
        *(float*)(pk + PK_GL + lane * 4) = gamL; if (lane < 32) *(float*)(pk + PK_BON + lane * 4) = bon;
#pragma unroll
        for (int m = 0; m < 4; ++m) { unsigned short e[8];
#pragma unroll
            for (int q = 0; q < 8; ++q) e[q] = Vt_[(tok0 + 8 * m + q) * D + ch];
            u32x4 o; o.x = e[0] | ((unsigned)e[1] << 16); o.y = e[2] | ((unsigned)e[3] << 16); o.z = e[4] | ((unsigned)e[5] << 16); o.w = e[6] | ((unsigned)e[7] << 16);
            *(u32x4*)(pk + PK_VT + lane * 64 + m * 16) = o; }
        LDS_WAIT(); asm volatile("" ::: "memory");
        bf16x8 idf[2];
#pragma unroll
        for (int s = 0; s < 2; ++s) { unsigned e[8];
#pragma unroll
            for (int j = 0; j < 8; ++j) e[j] = (r == 16 * s + 8 * hh + j) ? 0x3F80u : 0u;
            u32x4 w; w.x = e[0] | (e[1] << 16); w.y = e[2] | (e[3] << 16); w.z = e[4] | (e[5] << 16); w.w = e[6] | (e[7] << 16); idf[s] = __builtin_bit_cast(bf16x8, w); }
        bf16x8 xaf[2][2];
#pragma unroll
        for (int kt = 0; kt < 2; ++kt) {
            const int fo = r * 144 + (2 * kt) * 32 + hh * 16;
            f32x16 xb = F16ZERO, xk = F16ZERO, xa = F16ZERO;
            xb = mfma32(*(const LAS bf16x8*)(wl + 4608 + fo), idf[0], xb); xb = mfma32(*(const LAS bf16x8*)(wl + 4608 + fo + 32), idf[1], xb);
            xk = mfma32(*(const LAS bf16x8*)(wl + 9216 + fo), idf[0], xk); xk = mfma32(*(const LAS bf16x8*)(wl + 9216 + fo + 32), idf[1], xk);
            xa = mfma32(*(const LAS bf16x8*)(wl + 0 + fo), idf[0], xa); xa = mfma32(*(const LAS bf16x8*)(wl + 0 + fo + 32), idf[1], xa);
            xaf[kt][0] = frag_acc(xa, 0); xaf[kt][1] = frag_acc(xa, 1);
            const float gl = __shfl(gamL, 32 * kt + r);
#pragma unroll
            for (int g = 0; g < 4; ++g) {
                u32x2 w1; w1.x = pk2(xb[4 * g] * gl, xb[4 * g + 1] * gl); w1.y = pk2(xb[4 * g + 2] * gl, xb[4 * g + 3] * gl);
                *(u32x2*)(pk + PK_BH + (32 * kt + r) * 64 + 2 * (16 * (g >> 1) + 8 * hh + 4 * (g & 1))) = w1;
                u32x2 w2; w2.x = pk2(xk[4 * g] * gl, xk[4 * g + 1] * gl); w2.y = pk2(xk[4 * g + 2] * gl, xk[4 * g + 3] * gl);
                *(u32x2*)(pk + PK_KH + (32 * kt + r) * 64 + 2 * (8 * g + 4 * hh)) = w2; }
        }
        f32x16 pBA = F16ZERO, pBR = F16ZERO, pKR = F16ZERO, qAK = F16ZERO;
#pragma unroll
        for (int ks = 0; ks < 4; ++ks) {
            const int fo = r * 144 + ks * 32 + hh * 16;
            const bf16x8 fA = *(const LAS bf16x8*)(wl + 0 + fo), fB = *(const LAS bf16x8*)(wl + 4608 + fo), fK = *(const LAS bf16x8*)(wl + 9216 + fo), fR = *(const LAS bf16x8*)(wl + 13824 + fo);
            pBA = mfma32(fB, fA, pBA);
            pBR = mfma32(fB, fR, pBR);
            pKR = mfma32(fK, fR, pKR);
            qAK = mfma32(fA, fK, qAK);
        }
        LDS_WAIT(); asm volatile("" ::: "memory");
#pragma unroll
        for (int g = 0; g < 4; ++g) {
            float mb[4], mkv[4];
#pragma unroll
            for (int d = 0; d < 4; ++d) { const int reg = 4 * g + d, row = d + 8 * g + 4 * hh;
                *(LAS float*)(wl + 13824 + row * 144 + r * 4) = (row < r) ? pBA[reg] : 0.f;
                mb[d] = (row <= r) ? pBR[reg] : 0.f; mkv[d] = (row <= r) ? pKR[reg] : 0.f;
                qAK[reg] = (r < row) ? qAK[reg] : 0.f; }
            u32x2 w1; w1.x = pk2(mb[0], mb[1]); w1.y = pk2(mb[2], mb[3]); *(u32x2*)(pk + PK_MBR + r * 64 + 2 * (16 * (g >> 1) + 8 * hh + 4 * (g & 1))) = w1;
            u32x2 w2; w2.x = pk2(mkv[0], mkv[1]); w2.y = pk2(mkv[2], mkv[3]); *(u32x2*)(pk + PK_MKR + r * 64 + 2 * (8 * g + 4 * hh)) = w2;
        }
        *(LAS bf16x8*)(wl + lane * 96) = frag_acc(qAK, 0); *(LAS bf16x8*)(wl + lane * 96 + 16) = frag_acc(qAK, 1);
        *(LAS bf16x8*)(wl + lane * 96 + 32) = xaf[0][0]; *(LAS bf16x8*)(wl + lane * 96 + 48) = xaf[0][1]; *(LAS bf16x8*)(wl + lane * 96 + 64) = xaf[1][0]; *(LAS bf16x8*)(wl + lane * 96 + 80) = xaf[1][1];
        LDS_WAIT(); asm volatile("" ::: "memory");
        float tt[32]; int lmo = 13824;
#pragma unroll
        for (int cc = 31; cc >= 0; --cc) { float acc = (r == cc) ? 1.f : 0.f;
            if (cc < 31 && (cc & 1)) asm volatile("" : "+v"(lmo) : "v"(tt[cc + 1]));
#pragma unroll
            for (int q4 = 0; q4 < 8; ++q4) { if (4 * q4 + 3 > cc) { const f32x4 lm = *(const LAS f32x4*)(wl + lmo + cc * 144 + q4 * 16);
#pragma unroll
                for (int d = 0; d < 4; ++d) { const int i = 4 * q4 + d; if (i > cc) acc += tt[i] * lm[d]; } } }
            tt[cc] = acc; }
        f32x16 a2t0 = F16ZERO, a2t1 = F16ZERO, n2t = F16ZERO;
#pragma unroll
        for (int s = 0; s < 2; ++s) {
            float p[8];
#pragma unroll
            for (int j = 0; j < 8; ++j) p[j] = hh ? tt[16 * s + 8 * (j >> 2) + 4 + (j & 3)] : tt[16 * s + 8 * (j >> 2) + (j & 3)];
            u32x4 wp; wp.x = pk2(p[0], p[1]); wp.y = pk2(p[2], p[3]); wp.z = pk2(p[4], p[5]); wp.w = pk2(p[6], p[7]);
            const bf16x8 fTp = __builtin_bit_cast(bf16x8, wp);
            a2t0 = mfma32(*(const LAS bf16x8*)(wl + lane * 96 + 32 + 16 * s), fTp, a2t0); a2t1 = mfma32(*(const LAS bf16x8*)(wl + lane * 96 + 64 + 16 * s), fTp, a2t1);
            n2t = mfma32(*(const LAS bf16x8*)(wl + lane * 96 + 16 * s), fTp, n2t);
        }
#pragma unroll
        for (int g = 0; g < 4; ++g) {
            u32x2 w0; w0.x = pk2(a2t0[4 * g], a2t0[4 * g + 1]); w0.y = pk2(a2t0[4 * g + 2], a2t0[4 * g + 3]);
            u32x2 w1; w1.x = pk2(a2t1[4 * g], a2t1[4 * g + 1]); w1.y = pk2(a2t1[4 * g + 2], a2t1[4 * g + 3]);
            *(u32x2*)(pk + PK_A2 + r * 128 + 2 * (16 * (0 + (g >> 1)) + 8 * hh + 4 * (g & 1))) = w0;
            *(u32x2*)(pk + PK_A2 + r * 128 + 2 * (16 * (2 + (g >> 1)) + 8 * hh + 4 * (g & 1))) = w1;
            u32x2 w2; w2.x = pk2(n2t[4 * g], n2t[4 * g + 1]); w2.y = pk2(n2t[4 * g + 2], n2t[4 * g + 3]);
            *(u32x2*)(pk + PK_N2 + r * 64 + 2 * (8 * g + 4 * hh)) = w2;
        }
        LDS_WAIT(); asm volatile("" ::: "memory");
    }
}

constexpr int SC_OBUF = 4 * PK_BYTES, SC_BON = SC_OBUF + 2 * 8192;
template <int DBGMODE = 0> __device__ __forceinline__ void rwscan2_phase(Frame& F, const Args& args, bf16_t* OG, const int nbatch) {
    const int bx = F.bx; if (bx >= nbatch * NH) return;
    const int b = bx >> 4, h = bx & 15, lane = F.lane, r = lane & 31, hh = lane >> 5, wave = F.wave;
    const bf16_t* Vt_ = (const bf16_t*)(F.ws + WS_V); const bf16_t* G = (const bf16_t*)(F.ws + WS_G);
    const unsigned char* pk0 = pack_ptr(F.ws, F.out, b, h * RW_NCH);
    LAS unsigned char* lds = F.lds;
    const int dp0 = wave == 6 ? 0 : 14, dpn = wave == 6 ? 14 : 13;
#define SC_DMA(chunk) do { const unsigned char* src_ = pk0 + (size_t)(chunk) * PK_BYTES + lane * 16; LAS unsigned char* dst_ = lds + ((chunk) & 3) * PK_BYTES; \
        _Pragma("unroll") for (int p_ = 0; p_ < 14; ++p_) if (p_ < dpn) __builtin_amdgcn_global_load_lds((const unsigned*)(src_ + (dp0 + p_) * 1024), (LAS unsigned*)(dst_ + (dp0 + p_) * 1024), 16, 0, 0); } while (0)
#define SC_WAIT(k) do { if (wave == 6) { if ((k) == 2) asm volatile("s_waitcnt vmcnt(28)" ::: "memory"); else if ((k) == 1) asm volatile("s_waitcnt vmcnt(14)" ::: "memory"); else asm volatile("s_waitcnt vmcnt(0)" ::: "memory"); } \
        else { if ((k) == 2) asm volatile("s_waitcnt vmcnt(26)" ::: "memory"); else if ((k) == 1) asm volatile("s_waitcnt vmcnt(13)" ::: "memory"); else asm volatile("s_waitcnt vmcnt(0)" ::: "memory"); } } while (0)
    f32x16 Z0 = F16ZERO, Z1 = F16ZERO;
    const int eu0 = ((wave - 2) & 3) * 64 + lane, eu1 = eu0 + 256;
    u32x2 ev0 = {0u, 0u}, eg0 = ev0, ev1 = ev0, eg1 = ev0; f32x4 elg0 = {0.f, 0.f, 0.f, 0.f}, elb0 = elg0, elg1 = elg0, elb1 = elg0;
    if (wave >= 2 && wave < 6) { elg0 = *(const f32x4*)(args.in[25] + h * 64 + 4 * (eu0 & 15)); elb0 = *(const f32x4*)(args.in[26] + h * 64 + 4 * (eu0 & 15)); elg1 = *(const f32x4*)(args.in[25] + h * 64 + 4 * (eu1 & 15)); elb1 = *(const f32x4*)(args.in[26] + h * 64 + 4 * (eu1 & 15)); }
    if (wave >= 6) { SC_DMA(0); SC_DMA(1); SC_DMA(2); SC_WAIT(2); }
    asm volatile("" ::: "memory"); __builtin_amdgcn_s_barrier(); asm volatile("" ::: "memory");
    for (int c = 0; c <= RW_NCH; ++c) {
        if (wave >= 6) {
            if (DBGMODE == 1) {} else
            if (c + 3 < RW_NCH) { SC_DMA(c + 3); SC_WAIT(2); } else if (c + 2 < RW_NCH) { SC_WAIT(1); } else { SC_WAIT(0); }
        } else if (wave < 2) {
            if (c < RW_NCH && DBGMODE != 2) {
                const LAS unsigned char* sl = lds + (c & 3) * PK_BYTES; const int vh = wave;
                const bf16x8 zb0 = frag_acc(Z0, 0), zb1 = frag_acc(Z0, 1), zb2 = frag_acc(Z1, 0), zb3 = frag_acc(Z1, 1);
                const bf16x8 vt0 = *(const LAS bf16x8*)(sl + PK_VT + (32 * vh + r) * 64 + hh * 16), vt1 = *(const LAS bf16x8*)(sl + PK_VT + (32 * vh + r) * 64 + 32 + hh * 16);
                f32x16 U = F16ZERO, O = F16ZERO;
                { const LAS unsigned char* pa = sl + PK_A2 + r * 128 + hh * 16; const LAS unsigned char* pr = sl + PK_RT + r * 128 + hh * 16;
                  U = mfma32(*(const LAS bf16x8*)(pa), zb0, U); U = mfma32(*(const LAS bf16x8*)(pa + 32), zb1, U); U = mfma32(*(const LAS bf16x8*)(pa + 64), zb2, U); U = mfma32(*(const LAS bf16x8*)(pa + 96), zb3, U);
                  const LAS unsigned char* pn = sl + PK_N2 + r * 64 + hh * 16; U = mfma32(*(const LAS bf16x8*)(pn), vt0, U); U = mfma32(*(const LAS bf16x8*)(pn + 32), vt1, U);
                  O = mfma32(*(const LAS bf16x8*)(pr), zb0, O); O = mfma32(*(const LAS bf16x8*)(pr + 32), zb1, O); O = mfma32(*(const LAS bf16x8*)(pr + 64), zb2, O); O = mfma32(*(const LAS bf16x8*)(pr + 96), zb3, O);
                  const LAS unsigned char* pm = sl + PK_MKR + r * 64 + hh * 16; O = mfma32(*(const LAS bf16x8*)(pm), vt0, O); O = mfma32(*(const LAS bf16x8*)(pm + 32), vt1, O); }
                const bf16x8 ub0 = frag_acc(U, 0), ub1 = frag_acc(U, 1);
                { const LAS unsigned char* pb = sl + PK_MBR + r * 64 + hh * 16; O = mfma32(*(const LAS bf16x8*)(pb), ub0, O); O = mfma32(*(const LAS bf16x8*)(pb + 32), ub1, O); }
#pragma unroll
                for (int g = 0; g < 4; ++g) { const f32x4 g0 = *(const LAS f32x4*)(sl + PK_GL + 4 * (8 * g + 4 * hh)), g1 = *(const LAS f32x4*)(sl + PK_GL + 4 * (32 + 8 * g + 4 * hh));
#pragma unroll
                    for (int d = 0; d < 4; ++d) { Z0[4 * g + d] *= g0[d]; Z1[4 * g + d] *= g1[d]; } }
                { const LAS unsigned char* pb = sl + PK_BH + r * 64 + hh * 16; const LAS unsigned char* pkk = sl + PK_KH + r * 64 + hh * 16;
                  Z0 = mfma32(*(const LAS bf16x8*)(pb), ub0, Z0); Z0 = mfma32(*(const LAS bf16x8*)(pb + 32), ub1, Z0); Z0 = mfma32(*(const LAS bf16x8*)(pkk), vt0, Z0); Z0 = mfma32(*(const LAS bf16x8*)(pkk + 32), vt1, Z0);
                  Z1 = mfma32(*(const LAS bf16x8*)(pb + 2048), ub0, Z1); Z1 = mfma32(*(const LAS bf16x8*)(pb + 2048 + 32), ub1, Z1); Z1 = mfma32(*(const LAS bf16x8*)(pkk + 2048), vt0, Z1); Z1 = mfma32(*(const LAS bf16x8*)(pkk + 2048 + 32), vt1, Z1); }
                LAS float* ob = (LAS float*)(lds + SC_OBUF + (c & 1) * 8192);
#pragma unroll
                for (int reg = 0; reg < 16; ++reg) ob[((reg & 3) + 8 * (reg >> 2) + 4 * hh) * 64 + 32 * vh + r] = O[reg];
                if (vh == 0 && lane < 32) ((LAS float*)(lds + SC_BON))[(c & 1) * 32 + lane] = *(const LAS float*)(sl + PK_BON + lane * 4);
            }
        } else {
            u32x2 nv0 = ev0, ng0 = eg0, nv1 = ev1, ng1 = eg1;
            if (c < RW_NCH) { const size_t o0 = ((size_t)b * S + (size_t)c * RWL + (eu0 >> 4)) * D + h * 64 + 4 * (eu0 & 15), o1 = ((size_t)b * S + (size_t)c * RWL + (eu1 >> 4)) * D + h * 64 + 4 * (eu1 & 15);
                nv0 = *(const u32x2*)(Vt_ + o0); ng0 = *(const u32x2*)(G + o0); nv1 = *(const u32x2*)(Vt_ + o1); ng1 = *(const u32x2*)(G + o1); }
            if (c >= 1 && DBGMODE != 3) {
                const LAS float* ob = (const LAS float*)(lds + SC_OBUF + ((c - 1) & 1) * 8192); const LAS float* bn = (const LAS float*)(lds + SC_BON) + ((c - 1) & 1) * 32;
#pragma unroll
                for (int k2 = 0; k2 < 2; ++k2) { const int u = k2 ? eu1 : eu0, t = u >> 4, q = u & 15, c4 = h * 64 + 4 * q; const size_t off = ((size_t)b * S + (size_t)(c - 1) * RWL + t) * D + c4;
                    const f32x4 o4 = *(const LAS f32x4*)(ob + t * 64 + 4 * q); const float bs = bn[t];
                    const u32x2 vw = k2 ? ev1 : ev0, gw_ = k2 ? eg1 : eg0; const f32x4 lg4 = k2 ? elg1 : elg0, lb4 = k2 ? elb1 : elb0;
                    float sm = (o4.x + o4.y) + (o4.z + o4.w); sm = sum16(sm); const float mu = sm * (1.f / 64.f); const f32x4 dd = o4 - mu;
                    float vs = (dd.x * dd.x + dd.y * dd.y) + (dd.z * dd.z + dd.w * dd.w); vs = sum16(vs); const float rs = 1.f / sqrtf(vs * (1.f / 64.f) + 64e-5f);
                    const f32x4 v4 = {bf_lo(vw.x), bf_hi(vw.x), bf_lo(vw.y), bf_hi(vw.y)}, g4 = {bf_lo(gw_.x), bf_hi(gw_.x), bf_lo(gw_.y), bf_hi(gw_.y)};
                    const f32x4 res = (dd * rs * lg4 + lb4 + v4 * bs) * g4;
                    u32x2 w; w.x = pk2(res.x, res.y); w.y = pk2(res.z, res.w); *(u32x2*)(OG + off) = w; }
            }
            ev0 = nv0; eg0 = ng0; ev1 = nv1; eg1 = ng1;
        }
        asm volatile("s_waitcnt lgkmcnt(0)" ::: "memory");
        __builtin_amdgcn_s_barrier();
        asm volatile("" ::: "memory");
    }
#undef SC_DMA
#undef SC_WAIT
}
}
namespace mk {
constexpr int NPH = 27;
#ifndef MK_NBATCH
#define MK_NBATCH 8
#endif
#ifndef MK_MASK
#define MK_MASK 0xFFFFFFFFull
#endif
#ifndef MK_REP
#define MK_REP 0ull
#endif
#ifndef MK_NREP
#define MK_NREP 2
#endif
#ifndef MK_SCANDBG
#define MK_SCANDBG 0
#endif
__global__ void __launch_bounds__(NTHREADS, 2) mk_fwd(Args args) {
    extern __shared__ __attribute__((aligned(16))) unsigned char lds_raw[];
    { volatile LAS unsigned* M0 = (volatile LAS unsigned*)((LAS unsigned char*)lds_raw + MISC_OFF); if (threadIdx.x < 64) M0[threadIdx.x] = 0u; }
    __syncthreads();
    const int lo = args.ph_lo, hi = args.ph_hi;
    const int wave0 = __builtin_amdgcn_readfirstlane((int)threadIdx.x >> 6);
    if (hi - lo > 1) (void)xcd_barrier_post((unsigned*)(args.ws + WS_CTL) + CW_BAR, (volatile LAS unsigned*)((LAS unsigned char*)lds_raw + MISC_OFF) + 8);
#define MKFRAME() \
        int lane_ = lane_id(), bx_ = blockIdx.x; asm volatile("" : "+v"(lane_)); asm volatile("" : "+s"(bx_)); \
        Frame F; F.lds = (LAS unsigned char*)lds_raw; F.MISC = (volatile LAS unsigned*)(F.lds + MISC_OFF); \
        F.lane = lane_; F.wave = wave0; F.tid = wave0 * 64 + lane_; F.bx = bx_; \
        F.G = gridDim.x; F.vcu = (F.G % 8 == 0) ? (bx_ % 8) * (F.G / 8) + bx_ / 8 : bx_; \
        F.gw = F.vcu * NWAVES + F.wave; F.NGW = F.G * NWAVES; \
        F.ws = args.ws; F.ctl = (unsigned*)(args.ws + WS_CTL); F.out = args.out; unsigned char* ws = F.ws; (void)ws;
#define INP(k) (args.in[k])
#define IN(k) (((MK_MASK >> (k)) & 1) && lo <= (k) && (k) < hi)
#define FORCE_BAR() do { XcdBarrier bar; bar.bar = (unsigned*)(args.ws + WS_CTL) + CW_BAR; bar.x = xb_xcc_id(); bar.st = (volatile LAS unsigned*)((LAS unsigned char*)lds_raw + MISC_OFF) + 8; xcd_barrier(bar, wave0 == 0 && lane_id() == 0); } while (0)
#define SEAM(k) do { if (lo <= (k) && (k) + 1 < hi) FORCE_BAR(); } while (0)
    if (IN(0)) { MKFRAME() asm volatile("; PHASE_BEGIN 0"); p0_prologue(F, args); }
    SEAM(0);
    if (((MK_REP >> 0) & 1) && IN(0)) { for (int rep_ = 0; rep_ < MK_NREP; ++rep_) { { MKFRAME() p0_prologue(F, args); } FORCE_BAR(); } }
    if (IN(1)) { MKFRAME() asm volatile("; PHASE_BEGIN 1"); { ProbPlain P{(const char*)(ws + WS_X0B), (const char*)(ws + WS_WIN), (size_t)256 * D * 2, (size_t)256 * D * 2}; EpiWin E{(bf16_t*)(ws + WS_GATE), (bf16_t*)(ws + WS_H2)}; run_gemm(F, 64, 11, D, D, D, P, E); } }
    SEAM(1);
    if (((MK_REP >> 1) & 1) && IN(1)) { for (int rep_ = 0; rep_ < MK_NREP; ++rep_) { { MKFRAME() { ProbPlain P{(const char*)(ws + WS_X0B), (const char*)(ws + WS_WIN), (size_t)256 * D * 2, (size_t)256 * D * 2}; EpiWin E{(bf16_t*)(ws + WS_GATE), (bf16_t*)(ws + WS_H2)}; run_gemm(F, 64, 11, D, D, D, P, E); } } FORCE_BAR(); } }
    if (IN(2)) { MKFRAME() asm volatile("; PHASE_BEGIN 2"); conv_phase(F, INP(2), INP(3)); }
    SEAM(2);
    if (((MK_REP >> 2) & 1) && IN(2)) { for (int rep_ = 0; rep_ < MK_NREP; ++rep_) { { MKFRAME() conv_phase(F, INP(2), INP(3)); } FORCE_BAR(); } }
    if (IN(3)) { MKFRAME() asm volatile("; PHASE_BEGIN 3"); { ProbGates P{(const char*)(ws + WS_XC), (const char*)(ws + WS_WG)}; EpiGates E{(const bf16_t*)(ws + WS_XC), (const float*)(ws + WS_VEC), INP(5), INP(7), (bf16_t*)(ws + WS_A), (bf16_t*)(ws + WS_U)}; run_gemm(F, 64, 11, W, 384, 384, P, E); } }
    SEAM(3);
    if (((MK_REP >> 3) & 1) && IN(3)) { for (int rep_ = 0; rep_ < MK_NREP; ++rep_) { { MKFRAME() { ProbGates P{(const char*)(ws + WS_XC), (const char*)(ws + WS_WG)}; EpiGates E{(const bf16_t*)(ws + WS_XC), (const float*)(ws + WS_VEC), INP(5), INP(7), (bf16_t*)(ws + WS_A), (bf16_t*)(ws + WS_U)}; run_gemm(F, 64, 11, W, 384, 384, P, E); } } FORCE_BAR(); } }
    if (IN(4)) { MKFRAME() asm volatile("; PHASE_BEGIN 4"); rgscan1_phase(F); }
    SEAM(4);
    if (((MK_REP >> 4) & 1) && IN(4)) { for (int rep_ = 0; rep_ < MK_NREP; ++rep_) { { MKFRAME() rgscan1_phase(F); } FORCE_BAR(); } }
    if (IN(5)) { MKFRAME() asm volatile("; PHASE_BEGIN 5"); rgscan2_phase(F); }
    SEAM(5);
    if (((MK_REP >> 5) & 1) && IN(5)) { for (int rep_ = 0; rep_ < MK_NREP; ++rep_) { { MKFRAME() rgscan2_phase(F); } FORCE_BAR(); } }
    if (IN(6)) { MKFRAME() asm volatile("; PHASE_BEGIN 6"); { ProbPlain P{(const char*)(ws + WS_Y), (const char*)(ws + WS_WOUT), (size_t)256 * W * 2, (size_t)256 * W * 2}; EpiRes E{INP(0), (float*)(ws + WS_Z0)}; run_gemm(F, 64, 4, W, W, W, P, E); } }
    SEAM(6);
    if (((MK_REP >> 6) & 1) && IN(6)) { for (int rep_ = 0; rep_ < MK_NREP; ++rep_) { { MKFRAME() { ProbPlain P{(const char*)(ws + WS_Y), (const char*)(ws + WS_WOUT), (size_t)256 * W * 2, (size_t)256 * W * 2}; EpiRes E{INP(0), (float*)(ws + WS_Z0)}; run_gemm(F, 64, 4, W, W, W, P, E); } } FORCE_BAR(); } }
    if (IN(7)) { MKFRAME() asm volatile("; PHASE_BEGIN 7"); ln_phase(F, (const float*)(ws + WS_Z0), INP(32), INP(33), (float*)(ws + WS_XF), (bf16_t*)(ws + WS_XB0)); }
    SEAM(7);
    if (((MK_REP >> 7) & 1) && IN(7)) { for (int rep_ = 0; rep_ < MK_NREP; ++rep_) { { MKFRAME() ln_phase(F, (const float*)(ws + WS_Z0), INP(32), INP(33), (float*)(ws + WS_XF), (bf16_t*)(ws + WS_XB0)); } FORCE_BAR(); } }
    if (IN(8)) { MKFRAME() asm volatile("; PHASE_BEGIN 8"); { ProbPlain P{(const char*)(ws + WS_XB0), (const char*)(ws + WS_WPEER), (size_t)256 * D * 2, (size_t)256 * D * 2}; EpiScores E{(float*)(ws + WS_SC0)}; run_gemm(F, 64, 8, D, D, D, P, E); } }
    SEAM(8);
    if (((MK_REP >> 8) & 1) && IN(8)) { for (int rep_ = 0; rep_ < MK_NREP; ++rep_) { { MKFRAME() { ProbPlain P{(const char*)(ws + WS_XB0), (const char*)(ws + WS_WPEER), (size_t)256 * D * 2, (size_t)256 * D * 2}; EpiScores E{(float*)(ws + WS_SC0)}; run_gemm(F, 64, 8, D, D, D, P, E); } } FORCE_BAR(); } }
    if (IN(9)) { MKFRAME() asm volatile("; PHASE_BEGIN 9"); topk_phase(F, (const float*)(ws + WS_SC0), (int*)(ws + WS_EID0), (float*)(ws + WS_GW0)); }
    SEAM(9);
    if (((MK_REP >> 9) & 1) && IN(9)) { for (int rep_ = 0; rep_ < MK_NREP; ++rep_) { { MKFRAME() topk_phase(F, (const float*)(ws + WS_SC0), (int*)(ws + WS_EID0), (float*)(ws + WS_GW0)); } FORCE_BAR(); } }
    if (IN(10)) { MKFRAME() asm volatile("; PHASE_BEGIN 10"); gu_phase(F, (const float*)(ws + WS_XF), (const int*)(ws + WS_EID0), (float*)(ws + WS_PART0)); }
    SEAM(10);
    if (((MK_REP >> 10) & 1) && IN(10)) { for (int rep_ = 0; rep_ < MK_NREP; ++rep_) { { MKFRAME() gu_phase(F, (const float*)(ws + WS_XF), (const int*)(ws + WS_EID0), (float*)(ws + WS_PART0)); } FORCE_BAR(); } }
    if (IN(11)) { MKFRAME() asm volatile("; PHASE_BEGIN 11"); gr_phase(F, (const float*)(ws + WS_PART0), (float*)(ws + WS_GW0)); }
    SEAM(11);
    if (IN(12)) { MKFRAME() asm volatile("; PHASE_BEGIN 12"); gv_phase(F, (const float*)(ws + WS_XF), (const int*)(ws + WS_EID0), (const float*)(ws + WS_GW0), (float*)(ws + WS_ZP0)); }
    SEAM(12);
    if (((MK_REP >> 12) & 1) && IN(12)) { for (int rep_ = 0; rep_ < MK_NREP; ++rep_) { { MKFRAME() gv_phase(F, (const float*)(ws + WS_XF), (const int*)(ws + WS_EID0), (const float*)(ws + WS_GW0), (float*)(ws + WS_ZP0)); } FORCE_BAR(); } }
    if (IN(13)) { MKFRAME() asm volatile("; PHASE_BEGIN 13"); ln_phase(F, (const float*)(ws + WS_ZP0), INP(32) + D, INP(33) + D, (float*)(ws + WS_XF), (bf16_t*)nullptr); }
    SEAM(13);
    if (((MK_REP >> 13) & 1) && IN(13)) { for (int rep_ = 0; rep_ < MK_NREP; ++rep_) { { MKFRAME() ln_phase(F, (const float*)(ws + WS_ZP0), INP(32) + D, INP(33) + D, (float*)(ws + WS_XF), (bf16_t*)nullptr); } FORCE_BAR(); } }
    if (IN(14)) { MKFRAME() asm volatile("; PHASE_BEGIN 14"); mix_phase(F, INP(10)); }
    SEAM(14);
    if (((MK_REP >> 14) & 1) && IN(14)) { for (int rep_ = 0; rep_ < MK_NREP; ++rep_) { { MKFRAME() mix_phase(F, INP(10)); } FORCE_BAR(); } }
    if (IN(15)) { MKFRAME() asm volatile("; PHASE_BEGIN 15"); { ProbRkv P{(const char*)(ws + WS_MIX), (const char*)(ws + WS_WRKV)}; EpiRkv E{(bf16_t*)(ws + WS_R), (bf16_t*)(ws + WS_LORA)}; run_gemm(F, 64, 15, D, D, D, P, E); } }
    SEAM(15);
    if (((MK_REP >> 15) & 1) && IN(15)) { for (int rep_ = 0; rep_ < MK_NREP; ++rep_) { { MKFRAME() { ProbRkv P{(const char*)(ws + WS_MIX), (const char*)(ws + WS_WRKV)}; EpiRkv E{(bf16_t*)(ws + WS_R), (bf16_t*)(ws + WS_LORA)}; run_gemm(F, 64, 15, D, D, D, P, E); } } FORCE_BAR(); } }
    if (IN(16)) { MKFRAME() asm volatile("; PHASE_BEGIN 16"); { ProbPlain P{(const char*)(ws + WS_LORA), (const char*)(ws + WS_WL2), (size_t)256 * 256 * 2, (size_t)256 * 256 * 2}; EpiLora2 E{(float*)(ws + WS_WDEC), (bf16_t*)(ws + WS_AA), INP(14), INP(17)}; static_assert(WS_G == WS_AA + (size_t)T * D * 2, "g follows aa"); run_gemm(F, 64, 12, 256, 256, 256, P, E); } }
    SEAM(16);
    if (((MK_REP >> 16) & 1) && IN(16)) { for (int rep_ = 0; rep_ < MK_NREP; ++rep_) { { MKFRAME() { ProbPlain P{(const char*)(ws + WS_LORA), (const char*)(ws + WS_WL2), (size_t)256 * 256 * 2, (size_t)256 * 256 * 2}; EpiLora2 E{(float*)(ws + WS_WDEC), (bf16_t*)(ws + WS_AA), INP(14), INP(17)}; static_assert(WS_G == WS_AA + (size_t)T * D * 2, "g follows aa"); run_gemm(F, 64, 12, 256, 256, 256, P, E); } } FORCE_BAR(); } }
    if (IN(17)) { MKFRAME() asm volatile("; PHASE_BEGIN 17"); rwprep_phase(F, args, MK_NBATCH); }
    SEAM(17);
    if (((MK_REP >> 17) & 1) && IN(17)) { for (int rep_ = 0; rep_ < MK_NREP; ++rep_) { { MKFRAME() rwprep_phase(F, args, MK_NBATCH); } FORCE_BAR(); } }
    if (IN(18)) { MKFRAME() asm volatile("; PHASE_BEGIN 18"); rwscan2_phase(F, args, (bf16_t*)(ws + WS_OG), MK_NBATCH); }
    SEAM(18);
    if (((MK_REP >> 18) & 1) && IN(18)) { for (int rep_ = 0; rep_ < MK_NREP; ++rep_) { { MKFRAME() rwscan2_phase<MK_SCANDBG>(F, args, (bf16_t*)(ws + WS_XB1), MK_NBATCH); } FORCE_BAR(); } }
    if (IN(19)) { MKFRAME() asm volatile("; PHASE_BEGIN 19"); { ProbPlain P{(const char*)(ws + WS_OG), (const char*)(ws + WS_WO), (size_t)256 * D * 2, (size_t)256 * D * 2}; EpiRes E{(const float*)(ws + WS_XF), (float*)(ws + WS_Z1)}; run_gemm(F, 64, 4, D, D, D, P, E); } }
    SEAM(19);
    if (((MK_REP >> 19) & 1) && IN(19)) { for (int rep_ = 0; rep_ < MK_NREP; ++rep_) { { MKFRAME() { ProbPlain P{(const char*)(ws + WS_OG), (const char*)(ws + WS_WO), (size_t)256 * D * 2, (size_t)256 * D * 2}; EpiRes E{(const float*)(ws + WS_XF), (float*)(ws + WS_Z1)}; run_gemm(F, 64, 4, D, D, D, P, E); } } FORCE_BAR(); } }
    if (IN(20)) { MKFRAME() asm volatile("; PHASE_BEGIN 20"); ln_phase(F, (const float*)(ws + WS_Z1), INP(32) + 2 * D, INP(33) + 2 * D, (float*)(ws + WS_XF), (bf16_t*)(ws + WS_XB1)); { const size_t gt_ = (size_t)F.gw * 64 + F.lane, NGT_ = (size_t)F.NGW * 64; cvt_stream_fp8(INP(30) + (size_t)16384 * D, ws + WS_UB, (size_t)16384 * D / 16, gt_, NGT_, U_SCALE); cvt_stream_fp8(INP(31) + (size_t)16384 * D, ws + WS_VB, (size_t)16384 * D / 16, gt_, NGT_, V_SCALE); } }
    SEAM(20);
    if (((MK_REP >> 20) & 1) && IN(20)) { for (int rep_ = 0; rep_ < MK_NREP; ++rep_) { { MKFRAME() ln_phase(F, (const float*)(ws + WS_Z1), INP(32) + 2 * D, INP(33) + 2 * D, (float*)(ws + WS_XF), (bf16_t*)(ws + WS_XB1)); { const size_t gt_ = (size_t)F.gw * 64 + F.lane, NGT_ = (size_t)F.NGW * 64; cvt_stream_fp8(INP(30) + (size_t)16384 * D, ws + WS_UB, (size_t)16384 * D / 16, gt_, NGT_, U_SCALE); cvt_stream_fp8(INP(31) + (size_t)16384 * D, ws + WS_VB, (size_t)16384 * D / 16, gt_, NGT_, V_SCALE); } } FORCE_BAR(); } }
    if (IN(21)) { MKFRAME() asm volatile("; PHASE_BEGIN 21"); { ProbPlain P{(const char*)(ws + WS_XB1), (const char*)(ws + WS_WPEER + (size_t)2048 * D * 2), (size_t)256 * D * 2, (size_t)256 * D * 2}; EpiScores E{(float*)(ws + WS_SC1)}; run_gemm(F, 64, 8, D, D, D, P, E); } }
    SEAM(21);
    if (((MK_REP >> 21) & 1) && IN(21)) { for (int rep_ = 0; rep_ < MK_NREP; ++rep_) { { MKFRAME() { ProbPlain P{(const char*)(ws + WS_XB1), (const char*)(ws + WS_WPEER + (size_t)2048 * D * 2), (size_t)256 * D * 2, (size_t)256 * D * 2}; EpiScores E{(float*)(ws + WS_SC1)}; run_gemm(F, 64, 8, D, D, D, P, E); } } FORCE_BAR(); } }
    if (IN(22)) { MKFRAME() asm volatile("; PHASE_BEGIN 22"); topk_phase(F, (const float*)(ws + WS_SC1), (int*)(ws + WS_EID1), (float*)(ws + WS_GW1)); }
    SEAM(22);
    if (((MK_REP >> 22) & 1) && IN(22)) { for (int rep_ = 0; rep_ < MK_NREP; ++rep_) { { MKFRAME() topk_phase(F, (const float*)(ws + WS_SC1), (int*)(ws + WS_EID1), (float*)(ws + WS_GW1)); } FORCE_BAR(); } }
    if (IN(23)) { MKFRAME() asm volatile("; PHASE_BEGIN 23"); gu_phase(F, (const float*)(ws + WS_XF), (const int*)(ws + WS_EID1), (float*)(ws + WS_PART1)); }
    SEAM(23);
    if (((MK_REP >> 23) & 1) && IN(23)) { for (int rep_ = 0; rep_ < MK_NREP; ++rep_) { { MKFRAME() gu_phase(F, (const float*)(ws + WS_XF), (const int*)(ws + WS_EID1), (float*)(ws + WS_PART1)); } FORCE_BAR(); } }
    if (IN(24)) { MKFRAME() asm volatile("; PHASE_BEGIN 24"); gr_phase(F, (const float*)(ws + WS_PART1), (float*)(ws + WS_GW1)); }
    SEAM(24);
    if (IN(25)) { MKFRAME() asm volatile("; PHASE_BEGIN 25"); gv_phase(F, (const float*)(ws + WS_XF), (const int*)(ws + WS_EID1), (const float*)(ws + WS_GW1), (float*)(ws + WS_ZP1)); }
    SEAM(25);
    if (((MK_REP >> 25) & 1) && IN(25)) { for (int rep_ = 0; rep_ < MK_NREP; ++rep_) { { MKFRAME() gv_phase(F, (const float*)(ws + WS_XF), (const int*)(ws + WS_EID1), (const float*)(ws + WS_GW1), (float*)(ws + WS_ZP1)); } FORCE_BAR(); } }
    if (IN(26)) { MKFRAME() asm volatile("; PHASE_BEGIN 26"); ln_phase(F, (const float*)(ws + WS_ZP1), INP(32) + 3 * D, INP(33) + 3 * D, F.out, (bf16_t*)nullptr); }
    SEAM(26);
    if (((MK_REP >> 26) & 1) && IN(26)) { for (int rep_ = 0; rep_ < MK_NREP; ++rep_) { { MKFRAME() ln_phase(F, (const float*)(ws + WS_ZP1), INP(32) + 3 * D, INP(33) + 3 * D, F.out, (bf16_t*)nullptr); } FORCE_BAR(); } }
#undef INP
#undef IN
#undef SEAM
#undef FORCE_BAR
#undef MKFRAME
}

static int g_grid = 0;
static inline bool mk_setup() {
    if (g_grid == 0) {
        int dev = 0, cus = 0;
        if (hipGetDevice(&dev) != hipSuccess || hipDeviceGetAttribute(&cus, hipDeviceAttributeMultiprocessorCount, dev) != hipSuccess) { g_grid = -1; return false; }
        if (hipFuncSetAttribute((const void*)mk_fwd, hipFuncAttributeMaxDynamicSharedMemorySize, LDS_BYTES) != hipSuccess) { fprintf(stderr, "hipFuncSetAttribute failed\n"); g_grid = -1; return false; }
        (void)hipGetLastError();
        g_grid = cus;
        if (g_grid != 256) fprintf(stderr, "warning: %d CUs (kernel assumes 256 workgroups)\n", g_grid);
    }
    return g_grid > 0;
}
static inline void mk_launch(hipStream_t stream, void* const* d_in, void* d_out, void* d_ws, int lo, int hi) {
    Args a{};
    for (int i = 0; i < 34; ++i) a.in[i] = (const float*)d_in[i];
    a.out = (float*)d_out; a.ws = (unsigned char*)d_ws; a.ph_lo = lo; a.ph_hi = hi;
    hipLaunchKernelGGL(mk_fwd, dim3(g_grid), dim3(NTHREADS), LDS_BYTES, stream, a);
}
}
extern "C" void kernel_launch(void* const* d_in, const int* in_sizes, int n_in, void* d_out, int out_size, void* d_ws, size_t ws_size, hipStream_t stream) {
    (void)in_sizes; (void)n_in; (void)out_size;
    if (!mk::mk_setup()) return;
    if (ws_size < mk::WS_END) { fprintf(stderr, "workspace too small: %zu\n", ws_size); return; }
    (void)hipMemsetAsync((char*)d_ws + mk::WS_CTL, 0, mk::CTL_ZERO_BYTES, stream);
#if MK_PER_PHASE
    for (int p = 0; p < mk::NPH; ++p) mk::mk_launch(stream, d_in, d_out, d_ws, p, p + 1);
#else
    mk::mk_launch(stream, d_in, d_out, d_ws, 0, mk::NPH);
#endif
}
```

```cpp
#include <hip/hip_runtime.h>
#include <cstdio>
#include <cstdint>

#define LAS __attribute__((address_space(3)))
#define GAS __attribute__((address_space(1)))
typedef unsigned short bf16_t;
typedef short bf16x8 __attribute__((ext_vector_type(8)));
typedef float f32x4 __attribute__((ext_vector_type(4)));
typedef float f32x2 __attribute__((ext_vector_type(2)));
typedef unsigned u32x4 __attribute__((ext_vector_type(4)));
typedef unsigned u32x2 __attribute__((ext_vector_type(2)));
typedef __bf16 bf16x2_t __attribute__((ext_vector_type(2)));

typedef float f32x16 __attribute__((ext_vector_type(16)));
#define F16ZERO (f32x16){0.f,0.f,0.f,0.f,0.f,0.f,0.f,0.f,0.f,0.f,0.f,0.f,0.f,0.f,0.f,0.f}
namespace mk {
__device__ __forceinline__ f32x16 mfma32(bf16x8 a, bf16x8 b, f32x16 c) { return __builtin_amdgcn_mfma_f32_32x32x16_bf16(a, b, c, 0, 0, 0); }
constexpr int D = 1024, NB = 8, S = 2048, T = NB * S, W = 1408, NH = 16, HB = 88;
constexpr float ALPHA = 1.41421356237f, LN_EPS = 1e-5f;
constexpr int NWAVES = 8, NTHREADS = 512;

__device__ __forceinline__ unsigned f2bf(float f) { unsigned u = __builtin_bit_cast(unsigned, f); return (u + 0x7fffu + ((u >> 16) & 1u)) >> 16; }
__device__ __forceinline__ unsigned pk2(float lo, float hi) { return f2bf(lo) | (f2bf(hi) << 16); }
__device__ __forceinline__ float bf_lo(unsigned w) { return __builtin_bit_cast(float, w << 16); }
__device__ __forceinline__ float bf_hi(unsigned w) { return __builtin_bit_cast(float, w & 0xffff0000u); }
__device__ __forceinline__ float ldbf(const bf16_t* p) { return __builtin_bit_cast(float, ((unsigned)*p) << 16); }
__device__ __forceinline__ unsigned cvt_pk_bf16(float lo, float hi) { unsigned r; asm volatile("v_cvt_pk_bf16_f32 %0, %1, %2" : "=v"(r) : "v"(lo), "v"(hi)); return r; }
__device__ __forceinline__ unsigned cvt_pk_bf16_c(float lo, float hi) { f32x2 v = {lo, hi}; bf16x2_t b = __builtin_convertvector(v, bf16x2_t); return __builtin_bit_cast(unsigned, b); }
__device__ __forceinline__ float fast_exp(float x) { return __builtin_amdgcn_exp2f(x * 1.44269504089f); }
__device__ __forceinline__ float fast_rcp(float x) { return __builtin_amdgcn_rcpf(x); }
__device__ __forceinline__ float fast_sigmoid(float x) { return fast_rcp(1.f + fast_exp(-x)); }
__device__ __forceinline__ float fast_tanh(float x) { float e = fast_exp(-2.f * fabsf(x)); float t = (1.f - e) * fast_rcp(1.f + e); return x < 0.f ? -t : t; }
__device__ __forceinline__ float gelu_tanh(float x) { const float c = 0.7978845608028654f; float u = c * (x + 0.044715f * x * x * x); return x * fast_sigmoid(2.f * u); }
__device__ __forceinline__ float softplus_f(float x) { return x > 15.f ? x : __logf(1.f + fast_exp(x)); }
__device__ __forceinline__ int lane_id() { return (int)__builtin_amdgcn_mbcnt_hi(~0u, __builtin_amdgcn_mbcnt_lo(~0u, 0u)); }
__device__ __forceinline__ float wave_sum(float v) {
#pragma unroll
    for (int o = 1; o < 64; o <<= 1) v += __shfl_xor(v, o);
    return v;
}
template <int CTRL> __device__ __forceinline__ float dpp_f(float v) { return __builtin_bit_cast(float, __builtin_amdgcn_update_dpp(0, __builtin_bit_cast(int, v), CTRL, 0xf, 0xf, false)); }
#define DPP_QP_1032 0xB1
#define DPP_QP_2301 0x4E
#define DPP_ROW_HALF_MIRROR 0x141
#define DPP_ROW_MIRROR 0x140
#define DPP_ROW_ROR(n) (0x120 + (n))
__device__ __forceinline__ float sum8(float v) { v += dpp_f<DPP_QP_1032>(v); v += dpp_f<DPP_QP_2301>(v); v += dpp_f<DPP_ROW_HALF_MIRROR>(v); return v; }
__device__ __forceinline__ float sum16(float v) { v = sum8(v); v += dpp_f<DPP_ROW_ROR(8)>(v); return v; }

#define XB_TMO      128
#define XB_XCNT(j)  (256  + 64 * (j))
#define XB_XSUB(j)  (1280 + 64 * (j))
#define XB_XGEN(j)  (2304 + 64 * (j))
#define XB_TOP      3328
#define XB_TOPGEN   3392
#define XCD_BAR_WORDS 3456
#define XB_SPIN_CAP (1u << 20)
__device__ __forceinline__ unsigned xb_ld(unsigned* p)              { return __hip_atomic_load(p, __ATOMIC_RELAXED, __HIP_MEMORY_SCOPE_AGENT); }
__device__ __forceinline__ unsigned xb_add(unsigned* p, unsigned v) { return __hip_atomic_fetch_add(p, v, __ATOMIC_RELAXED, __HIP_MEMORY_SCOPE_AGENT); }
__device__ __forceinline__ unsigned xb_xcc_id() { return (unsigned)__builtin_amdgcn_s_getreg((3 << 11) | 20) & 0xFu; }
#define XB_SPIN(cond, bar) do { unsigned _sp = 0; while (cond) { __builtin_amdgcn_s_sleep(1); \
    if ((++_sp & 255u) == 0u) { if (xb_ld(&(bar)[XB_TMO])) break; if (_sp > XB_SPIN_CAP) { atomicAdd(&(bar)[XB_TMO], 1u); break; } } } } while (0)
struct XcdBarrier { unsigned* bar; unsigned x; volatile LAS unsigned* st; };
__device__ __forceinline__ XcdBarrier xcd_barrier_post(unsigned* bar, volatile LAS unsigned* st) {
    XcdBarrier b; b.bar = bar; b.x = xb_xcc_id(); b.st = st;
    if (threadIdx.x == 0) (void)xb_add(&bar[XB_XCNT(b.x)], 1u);
    return b;
}
__device__ __forceinline__ void xcd_barrier_complete(unsigned* bar, unsigned x, unsigned& nloc, unsigned& nx) {
    const unsigned G = gridDim.x * gridDim.y * gridDim.z;
    unsigned sum, cnt, mine, sp = 0u;
    for (;;) {
        sum = 0u; cnt = 0u; mine = 0u;
#pragma unroll
        for (unsigned j = 0; j < 16; ++j) { const unsigned c = xb_ld(&bar[XB_XCNT(j)]); sum += c; cnt += (c > 0u) ? 1u : 0u; mine = (j == x) ? c : mine; }
        if (sum == G) break;
        __builtin_amdgcn_s_sleep(1);
        if ((++sp & 255u) == 0u) { if (xb_ld(&bar[XB_TMO])) break; if (sp > XB_SPIN_CAP) { atomicAdd(&bar[XB_TMO], 1u); break; } }
    }
    nloc = mine > 0u ? mine : 1u; nx = cnt > 0u ? cnt : 1u;
}
__device__ __forceinline__ void xcd_barrier(const XcdBarrier& b, const bool leader) {
    asm volatile("s_waitcnt vmcnt(0)" ::: "memory");
    __syncthreads();
    if (leader) {
        unsigned* bar = b.bar;
        __builtin_amdgcn_s_waitcnt(0);
        unsigned nloc = b.st[0], nx = b.st[1];
        if (nloc == 0u) { xcd_barrier_complete(bar, b.x, nloc, nx); b.st[0] = nloc; b.st[1] = nx; }
        const unsigned old = xb_add(&bar[XB_XSUB(b.x)], 1u);
        const unsigned gen = old / nloc;
        if (old + 1u == (gen + 1u) * nloc) {
            __builtin_amdgcn_fence(__ATOMIC_RELEASE, "agent");
            asm volatile("s_waitcnt vmcnt(0)" ::: "memory");
            const unsigned og = xb_add(&bar[XB_TOP], 1u);
            const unsigned tg = og / nx;
            if (og + 1u == (tg + 1u) * nx) xb_add(&bar[XB_TOPGEN], 1u);
            else XB_SPIN(xb_ld(&bar[XB_TOPGEN]) == tg, bar);
            __builtin_amdgcn_fence(__ATOMIC_ACQUIRE, "agent");
            xb_add(&bar[XB_XGEN(b.x)], 1u);
            asm volatile("s_waitcnt vmcnt(0)" ::: "memory");
        } else {
            XB_SPIN(xb_ld(&bar[XB_XGEN(b.x)]) == gen, bar);
            __builtin_amdgcn_fence(__ATOMIC_ACQUIRE, "agent");
            asm volatile("s_waitcnt vmcnt(0)" ::: "memory");
        }
    }
    __syncthreads();
}

namespace pg8 {
constexpr int BM = 256, BK = 64, HALF = 128, HTB = HALF * BK * 2, STAGE_BYTES = 8 * HTB, NXCD = 8, WGM = 8;
__host__ __device__ __forceinline__ int lds_byte(int r, int c) { const int st = (r >> 4) * 2 + (c >> 5), rr = r & 15, cc = c & 31, ob = rr * 64 + cc * 2; return st * 1024 + (ob ^ (((ob >> 9) & 1) << 5)); }
__host__ __device__ __forceinline__ void stage_rc(int b, int& R, int& C) { const int st = b / 1024, sb = b % 1024, swz = sb ^ (((sb >> 9) & 1) << 5); R = (st >> 1) * 16 + swz / 64; C = (st & 1) * 32 + (swz % 64) / 2; }
__host__ __device__ __forceinline__ int perm32(int rho) { const int n = rho >> 4, i = rho & 15; return 8 * (i >> 2) + 4 * n + (i & 3); }

struct Unit { const char* A; const char* B; int pm, pn; };
template <class P> struct Order {
    int nM, nN, nwg, G, c; P p;
    __device__ __forceinline__ void init(int nM_, int nN_, int G_, int c_, const P& p_) { nM = nM_; nN = nN_; nwg = nM * nN; G = G_; c = c_; p = p_; }
    __device__ __forceinline__ bool next(int i, Unit& u) const {
        const long L = (long)i * G + c; if (L >= nwg) return false;
        int wgid = (int)L; { const int q = nwg / NXCD, r = nwg % NXCD, xcd = wgid % NXCD, off = wgid / NXCD; wgid = (xcd < r ? xcd * (q + 1) : r * (q + 1) + (xcd - r) * q) + off; }
        const int nig = WGM * nN, gid = wgid / nig, fm = gid * WGM, gsz = (nM - fm) < WGM ? (nM - fm) : WGM;
        u.pm = fm + ((wgid % nig) % gsz); u.pn = (wgid % nig) / gsz; p.locate(u); return true;
    }
};

template <class Epi, class Sched, bool ALIGN_EPI, bool SP2>
__device__ __forceinline__ void gemm_phase(LAS unsigned char* lds, const int tid, const int lda, const int ldb, const int K, const Sched& S, const Epi& E) {
    const int wid = __builtin_amdgcn_readfirstlane(tid >> 6), lane = tid & 63, wr = wid >> 2, wc = wid & 3, fr = lane & 15, fq = lane >> 4;
    const int nt = K / BK;
    unsigned voffA[2], voffB[2];
#pragma unroll
    for (int i = 0; i < 2; ++i) { int R, C; stage_rc(tid * 16 + i * 8192, R, C); const int Rb = Epi::PERM ? ((R & ~31) + perm32(R & 31)) : R;
        voffA[i] = (unsigned)(R * lda + C) * 2u; voffB[i] = (unsigned)(Rb * ldb + C) * 2u; }
    const size_t kstep = (size_t)(BK * 2);
    const size_t hstepA = (size_t)HALF * lda * 2, hstepB = (size_t)HALF * ldb * 2;
    const unsigned ldsw = (unsigned)wid * 1024u;
    const int aoff = lds_byte(wr * 64 + fr, fq * 8), boff = lds_byte(wc * 32 + fr, fq * 8);
#define PG8_SA(b, h) (((b) * 2 + (h)) * HTB)
#define PG8_SB(b, h) ((4 + (b) * 2 + (h)) * HTB)
#define PG8_STAGE(bufoff, gbase, voff) do { _Pragma("unroll") for (int _i = 0; _i < 2; ++_i) \
        __builtin_amdgcn_global_load_lds((const unsigned*)((const char*)(gbase) + (voff)[_i]), (LAS unsigned*)(lds + (bufoff) + ldsw + _i * 8192), 16, 0, 0); } while (0)
#define PG8_LDA(dst, b, h) do { _Pragma("unroll") for (int m = 0; m < 4; ++m) _Pragma("unroll") for (int k = 0; k < 2; ++k) dst[m][k] = *(const LAS bf16x8*)(lds + PG8_SA(b, h) + aoff + m * 2048 + k * 1024); } while (0)
#define PG8_LDB(dst, b, h) do { _Pragma("unroll") for (int n = 0; n < 2; ++n) _Pragma("unroll") for (int k = 0; k < 2; ++k) dst[n][k] = *(const LAS bf16x8*)(lds + PG8_SB(b, h) + boff + n * 2048 + k * 1024); } while (0)
#define PG8_MMA(ai, bj, At, Bt) do { __builtin_amdgcn_s_setprio(1); _Pragma("unroll") for (int m = 0; m < 4; ++m) _Pragma("unroll") for (int n = 0; n < 2; ++n) _Pragma("unroll") for (int k = 0; k < 2; ++k) \
        acc[ai][bj][m][n] = __builtin_amdgcn_mfma_f32_16x16x32_bf16(Bt[n][k], At[m][k], acc[ai][bj][m][n], 0, 0, 0); __builtin_amdgcn_s_setprio(0); } while (0)
#define PG8_WAIT_V(n) asm volatile("s_waitcnt vmcnt(" #n ")" ::: "memory")
#define PG8_WAIT_L(n) asm volatile("s_waitcnt lgkmcnt(" #n ")" ::: "memory")
#define PG8_BAR __builtin_amdgcn_s_barrier()
#define PG8_SCHED __builtin_amdgcn_sched_barrier(0)
    Unit cur, nxt; int ui = 0;
    if (!S.next(0, cur)) return;
    f32x4 acc[2][2][4][2];
#pragma unroll
    for (int a = 0; a < 2; ++a)
#pragma unroll
        for (int b = 0; b < 2; ++b)
#pragma unroll
            for (int m = 0; m < 4; ++m)
#pragma unroll
                for (int n = 0; n < 2; ++n) acc[a][b][m][n] = (f32x4){0.f, 0.f, 0.f, 0.f};
    bf16x8 At[4][2], B0[2][2], B1[2][2];
    const char* cA = cur.A; const char* cB = cur.B;
    if constexpr (SP2) {
        PG8_STAGE(PG8_SB(0, 0), cB, voffB); PG8_STAGE(PG8_SB(0, 1), cB + hstepB, voffB); PG8_STAGE(PG8_SA(0, 0), cA, voffA); PG8_STAGE(PG8_SA(0, 1), cA + hstepA, voffA);
        if (wr == 1) PG8_BAR;
        PG8_WAIT_V(2); PG8_BAR;
        PG8_STAGE(PG8_SB(1, 0), cB + kstep, voffB); PG8_STAGE(PG8_SA(1, 0), cA + kstep, voffA); PG8_STAGE(PG8_SB(1, 1), cB + hstepB + kstep, voffB);
        PG8_WAIT_V(6); PG8_BAR;
    } else {
        PG8_STAGE(PG8_SB(0, 0), cB, voffB); PG8_STAGE(PG8_SA(0, 0), cA, voffA); PG8_STAGE(PG8_SB(0, 1), cB + hstepB, voffB); PG8_STAGE(PG8_SA(0, 1), cA + hstepA, voffA);
        if (wr == 1) PG8_BAR;
        PG8_WAIT_V(4); PG8_BAR;
        PG8_STAGE(PG8_SB(1, 0), cB + kstep, voffB); PG8_STAGE(PG8_SA(1, 0), cA + kstep, voffA); PG8_STAGE(PG8_SB(1, 1), cB + hstepB + kstep, voffB);
        PG8_WAIT_V(6); PG8_BAR;
    }
    for (;;) {
        const bool has_next = S.next(ui + 1, nxt);
        const char* nA = has_next ? nxt.A : cA; const char* nB = has_next ? nxt.B : cB;
#pragma unroll 1
        for (int t = 0; t < nt; t += 2) {
            const bool last = (t == nt - 2);
            const char* a1 = cA + (size_t)(t + 1) * kstep;
            const char* a2 = last ? nA : cA + (size_t)(t + 2) * kstep; const char* b2 = last ? nB : cB + (size_t)(t + 2) * kstep;
            const char* a3 = a2 + kstep; const char* b3 = b2 + kstep;
            if constexpr (SP2) {
            PG8_LDB(B0, 0, 0); PG8_LDB(B1, 0, 1); PG8_SCHED; PG8_LDA(At, 0, 0); PG8_STAGE(PG8_SA(1, 1), a1 + hstepA, voffA);
            PG8_WAIT_V(8); PG8_WAIT_L(0); PG8_BAR; PG8_MMA(0, 0, At, B0); PG8_MMA(0, 1, At, B1); PG8_BAR; PG8_SCHED;
            PG8_LDA(At, 0, 1); PG8_STAGE(PG8_SB(0, 0), b2, voffB); PG8_STAGE(PG8_SB(0, 1), b2 + hstepB, voffB); PG8_STAGE(PG8_SA(0, 0), a2, voffA);
            PG8_WAIT_V(8); PG8_WAIT_L(0); PG8_BAR; PG8_MMA(1, 0, At, B0); PG8_MMA(1, 1, At, B1); PG8_BAR; PG8_SCHED;
            PG8_LDB(B0, 1, 0); PG8_LDB(B1, 1, 1); PG8_SCHED; PG8_LDA(At, 1, 0); PG8_STAGE(PG8_SA(0, 1), a2 + hstepA, voffA);
            PG8_WAIT_V(8); PG8_WAIT_L(0); PG8_BAR; PG8_MMA(0, 0, At, B0); PG8_MMA(0, 1, At, B1); PG8_BAR; PG8_SCHED;
            PG8_LDA(At, 1, 1); PG8_STAGE(PG8_SB(1, 0), b3, voffB); PG8_STAGE(PG8_SB(1, 1), b3 + hstepB, voffB); PG8_STAGE(PG8_SA(1, 0), a3, voffA);
            PG8_WAIT_V(8); PG8_WAIT_L(0); PG8_BAR; PG8_MMA(1, 0, At, B0); PG8_MMA(1, 1, At, B1); PG8_BAR; PG8_SCHED;
            } else {
            PG8_LDB(B0, 0, 0); PG8_SCHED; PG8_LDA(At, 0, 0); PG8_STAGE(PG8_SA(1, 1), a1 + hstepA, voffA);
            PG8_WAIT_L(8); PG8_BAR; PG8_WAIT_L(0); PG8_MMA(0, 0, At, B0); PG8_BAR; PG8_SCHED;
            PG8_LDB(B1, 0, 1); PG8_STAGE(PG8_SB(0, 0), b2, voffB);
            PG8_BAR; PG8_WAIT_L(0); PG8_MMA(0, 1, At, B1); PG8_BAR;
            PG8_LDA(At, 0, 1); PG8_STAGE(PG8_SA(0, 0), a2, voffA);
            PG8_BAR; PG8_WAIT_L(0); PG8_MMA(1, 0, At, B0); PG8_BAR; PG8_SCHED;
            PG8_STAGE(PG8_SB(0, 1), b2 + hstepB, voffB);
            PG8_WAIT_V(6); PG8_BAR; PG8_MMA(1, 1, At, B1); PG8_BAR;
            PG8_LDB(B0, 1, 0); PG8_SCHED; PG8_LDA(At, 1, 0); PG8_STAGE(PG8_SA(0, 1), a2 + hstepA, voffA);
            PG8_WAIT_L(8); PG8_BAR; PG8_WAIT_L(0); PG8_MMA(0, 0, At, B0); PG8_BAR; PG8_SCHED;
            PG8_LDB(B1, 1, 1); PG8_STAGE(PG8_SB(1, 0), b3, voffB);
            PG8_BAR; PG8_WAIT_L(0); PG8_MMA(0, 1, At, B1); PG8_BAR;
            PG8_LDA(At, 1, 1); PG8_STAGE(PG8_SA(1, 0), a3, voffA);
            PG8_BAR; PG8_WAIT_L(0); PG8_MMA(1, 0, At, B0); PG8_BAR; PG8_SCHED;
            PG8_STAGE(PG8_SB(1, 1), b3 + hstepB, voffB);
            PG8_WAIT_V(6); PG8_BAR; PG8_MMA(1, 1, At, B1); PG8_BAR;
            }
        }
        if constexpr (ALIGN_EPI) { if (wr == 0) PG8_BAR; }
        { int l_e = lane_id(); asm volatile("" : "+v"(l_e)); E(acc, cur, wr, wc, l_e & 15, l_e >> 4); }
        if (!has_next) break;
#pragma unroll
        for (int a = 0; a < 2; ++a)
#pragma unroll
            for (int b = 0; b < 2; ++b)
#pragma unroll
                for (int m = 0; m < 4; ++m)
#pragma unroll
                    for (int n = 0; n < 2; ++n) acc[a][b][m][n] = (f32x4){0.f, 0.f, 0.f, 0.f};
        cur = nxt; cA = nA; cB = nB; ++ui;
        if constexpr (ALIGN_EPI) { if (wr == 1) PG8_BAR; }
    }
    PG8_WAIT_V(0);
    if constexpr (!ALIGN_EPI) { if (wr == 0) PG8_BAR; }
    PG8_BAR;
#undef PG8_SA
#undef PG8_SB
#undef PG8_STAGE
#undef PG8_LDA
#undef PG8_LDB
#undef PG8_MMA
#undef PG8_WAIT_V
#undef PG8_WAIT_L
#undef PG8_BAR
#undef PG8_SCHED
}
}
}
namespace mk {
constexpr size_t MiB = 1u << 20;
constexpr size_t WS_CTL = 0, CTL_ZERO_BYTES = 65536;
constexpr size_t WS_WIN = 1 * MiB, WS_WG = 7 * MiB, WS_WOUT = 10 * MiB, WS_WPEER = 13 * MiB, WS_WRKV = 21 * MiB, WS_WL2 = 29 * MiB, WS_WO = 31 * MiB, WS_VEC = 33 * MiB;
constexpr size_t WS_UB = 34 * MiB, WS_VB = 66 * MiB;
constexpr size_t WS_X0B = 98 * MiB, WS_GATE = 130 * MiB, WS_H2 = 174 * MiB, WS_XC = 218 * MiB, WS_A = 262 * MiB, WS_U = 350 * MiB, WS_AGG = 438 * MiB;
constexpr size_t WS_Y = WS_H2, WS_Z0 = WS_A, WS_XF = 350 * MiB, WS_XB0 = 98 * MiB;
constexpr size_t WS_SC0 = 130 * MiB, WS_EID0 = 258 * MiB, WS_GW0 = 266 * MiB;
constexpr size_t WS_MIX = 34 * MiB, WS_R = 226 * MiB, WS_K = 258 * MiB, WS_V = 290 * MiB, WS_LORA = 322 * MiB, WS_WDEC = 98 * MiB, WS_AA = 162 * MiB, WS_G = 194 * MiB, WS_OG = WS_R;
constexpr size_t WS_Z1 = 98 * MiB, WS_XB1 = 34 * MiB, WS_UB1 = 162 * MiB, WS_VB1 = 178 * MiB;
constexpr size_t WS_SC1 = 194 * MiB, WS_EID1 = 322 * MiB, WS_GW1 = 330 * MiB;
constexpr size_t WS_PART0 = 130 * MiB, WS_ZP0 = 274 * MiB, WS_PART1 = 66 * MiB, WS_ZP1 = 194 * MiB;
constexpr size_t WS_DBG = 444 * MiB, WS_END = 512 * MiB;
constexpr int CW_BAR = 4096;
constexpr int LDS_BYTES = 163840, MISC_OFF = LDS_BYTES - 256;

struct Args { const float* in[34]; float* out; unsigned char* ws; int ph_lo, ph_hi; };

struct Frame {
    LAS unsigned char* lds; volatile LAS unsigned* MISC; unsigned* ctl; unsigned char* ws;
    int tid, lane, wave, vcu, G, gw, NGW, bx;
    float* out;
};
#define LDS_WAIT() asm volatile("s_waitcnt lgkmcnt(0)" ::: "memory")

__device__ __forceinline__ void transpose_item(const float* W, int K, int N, bf16_t* WT, int ldt, int row_off, int col_off, LAS float* scr, int item, int lane) {
    const int nblk = N / 32, kb = item / nblk, nb = item % nblk, k0 = 64 * kb, n0 = 32 * nb;
#pragma unroll 8
    for (int i = 0; i < 32; ++i) { const int kk = 2 * i + (lane >> 5); scr[kk * 33 + (lane & 31)] = W[(size_t)(k0 + kk) * N + n0 + (lane & 31)]; }
    LDS_WAIT(); asm volatile("" ::: "memory");
    const int c = lane & 7;
#pragma unroll
    for (int j = 0; j < 4; ++j) { const int n = (lane >> 3) + 8 * j; const LAS float* s = scr + (8 * c) * 33 + n;
        u32x4 o; o.x = pk2(s[0 * 33], s[1 * 33]); o.y = pk2(s[2 * 33], s[3 * 33]); o.z = pk2(s[4 * 33], s[5 * 33]); o.w = pk2(s[6 * 33], s[7 * 33]);
        *(u32x4*)(WT + (size_t)(row_off + n0 + n) * ldt + col_off + k0 + 8 * c) = o; }
    LDS_WAIT(); asm volatile("" ::: "memory");
    (void)K;
}
__device__ __forceinline__ int gates_koff(int q) { int s = 128 * (q > 0 ? q - 1 : 0); return s > 1024 ? 1024 : s; }

__device__ __forceinline__ void cvt_stream(const float* src, bf16_t* dst, size_t n8, size_t w, size_t nw) {
    for (size_t i = w; i < n8; i += nw) { const f32x4 a = *(const f32x4*)(src + i * 8), b = *(const f32x4*)(src + i * 8 + 4);
        u32x4 o; o.x = pk2(a.x, a.y); o.y = pk2(a.z, a.w); o.z = pk2(b.x, b.y); o.w = pk2(b.z, b.w); *(u32x4*)(dst + i * 8) = o; }
}

__device__ __forceinline__ void cvt_stream_fp8(const float* src, unsigned char* dst, size_t n16, size_t w, size_t nw, float scale) {
    for (size_t i = w; i < n16; i += nw) { const f32x4 a = *(const f32x4*)(src + i * 16) * scale, b = *(const f32x4*)(src + i * 16 + 4) * scale, c = *(const f32x4*)(src + i * 16 + 8) * scale, d = *(const f32x4*)(src + i * 16 + 12) * scale;
        u32x4 o; int t;
        t = __builtin_amdgcn_cvt_pk_fp8_f32(a.x, a.y, 0, false); o.x = (unsigned)__builtin_amdgcn_cvt_pk_fp8_f32(a.z, a.w, t, true);
        t = __builtin_amdgcn_cvt_pk_fp8_f32(b.x, b.y, 0, false); o.y = (unsigned)__builtin_amdgcn_cvt_pk_fp8_f32(b.z, b.w, t, true);
        t = __builtin_amdgcn_cvt_pk_fp8_f32(c.x, c.y, 0, false); o.z = (unsigned)__builtin_amdgcn_cvt_pk_fp8_f32(c.z, c.w, t, true);
        t = __builtin_amdgcn_cvt_pk_fp8_f32(d.x, d.y, 0, false); o.w = (unsigned)__builtin_amdgcn_cvt_pk_fp8_f32(d.z, d.w, t, true);
        *(u32x4*)(dst + ((i & 63) >> 3) * ((size_t)16384 * 128) + (i >> 6) * 128 + (i & 7) * 16) = o; }
}
constexpr float U_SCALE = 256.f, V_SCALE = 32.f;

__device__ __forceinline__ void p0_prologue(Frame& F, const Args& args) {
    LAS float* scr = (LAS float*)(F.lds + F.wave * 16384);
    const int gw = F.gw, NGW = F.NGW, lane = F.lane;
    bf16_t* Win_t = (bf16_t*)(F.ws + WS_WIN); bf16_t* Wout_t = (bf16_t*)(F.ws + WS_WOUT); bf16_t* Wrkv_t = (bf16_t*)(F.ws + WS_WRKV); bf16_t* Wl2_t = (bf16_t*)(F.ws + WS_WL2); bf16_t* Wo_t = (bf16_t*)(F.ws + WS_WO);
    for (int it = gw; it < 16 * 88; it += NGW) transpose_item(args.in[1], 1024, 2816, Win_t, 1024, 0, 0, scr, it, lane);
    for (int it = gw; it < 22 * 32; it += NGW) transpose_item(args.in[9], 1408, 1024, Wout_t, 1408, 0, 0, scr, it, lane);
    for (int it = gw; it < 512; it += NGW) transpose_item(args.in[11], 1024, 1024, Wrkv_t, 1024, 0, 0, scr, it, lane);
    for (int it = gw; it < 512; it += NGW) transpose_item(args.in[12], 1024, 1024, Wrkv_t, 1024, 1024, 0, scr, it, lane);
    for (int it = gw; it < 512; it += NGW) transpose_item(args.in[13], 1024, 1024, Wrkv_t, 1024, 2048, 0, scr, it, lane);
    for (int it = gw; it < 32; it += NGW) transpose_item(args.in[15], 1024, 64, Wrkv_t, 1024, 3072, 0, scr, it, lane);
    for (int it = gw; it < 32; it += NGW) transpose_item(args.in[18], 1024, 64, Wrkv_t, 1024, 3328, 0, scr, it, lane);
    for (int it = gw; it < 64; it += NGW) transpose_item(args.in[20], 1024, 128, Wrkv_t, 1024, 3584, 0, scr, it, lane);
    for (int it = gw; it < 512; it += NGW) transpose_item(args.in[27], 1024, 1024, Wo_t, 1024, 0, 0, scr, it, lane);
    for (int it = gw; it < 32; it += NGW) transpose_item(args.in[16], 64, 1024, Wl2_t, 256, 0, 0, scr, it, lane);
    for (int it = gw; it < 32; it += NGW) transpose_item(args.in[19], 64, 1024, Wl2_t, 256, 1024, 64, scr, it, lane);
    for (int it = gw; it < 64; it += NGW) transpose_item(args.in[21], 128, 1024, Wl2_t, 256, 2048, 128, scr, it, lane);
    const size_t gt = (size_t)gw * 64 + lane, NGT = (size_t)NGW * 64;
    const u32x4 z4 = {0u, 0u, 0u, 0u};
    for (size_t i = gt; i < (size_t)768 * 128; i += NGT) {
        const int row = 3072 + (int)(i / 128), r = row - 3072; const bool data = (r < 64) || (r >= 256 && r < 320) || (r >= 512 && r < 640);
        if (!data) *(u32x4*)(Wrkv_t + (size_t)row * 1024 + (i % 128) * 8) = z4; }
    for (size_t i = gt; i < (size_t)3072 * 32; i += NGT) {
        const int row = (int)(i / 32), c8 = (int)(i % 32) * 8, g = row >> 10; const int lo = g == 0 ? 0 : (g == 1 ? 64 : 128), hi = g == 0 ? 64 : (g == 1 ? 128 : 256);
        if (c8 < lo || c8 >= hi) *(u32x4*)(Wl2_t + (size_t)row * 256 + c8) = z4; }
    { bf16_t* Wg_t = (bf16_t*)(F.ws + WS_WG);
      for (size_t i = gt; i < (size_t)2816 * 48; i += NGT) {
          const int row = (int)(i / 48), k8 = (int)(i % 48) * 8, q = row >> 8, r = row & 255, gs = r >> 7, ch = 128 * q + (r & 127), h = ch / HB, j = ch % HB;
          const float* w = (gs ? args.in[6] : args.in[4]) + (size_t)h * HB * HB; const int kg0 = gates_koff(q) + k8;
          float v[8];
#pragma unroll
          for (int e = 0; e < 8; ++e) { const int kg = kg0 + e; v[e] = (kg / HB == h) ? w[(kg % HB) * HB + j] : 0.f; }
          u32x4 o; o.x = pk2(v[0], v[1]); o.y = pk2(v[2], v[3]); o.z = pk2(v[4], v[5]); o.w = pk2(v[6], v[7]);
          *(u32x4*)(Wg_t + (size_t)row * 384 + k8) = o; } }
    for (int it = gw; it < 4096; it += NGW) {
        const int layer = it >> 11, hp = (it >> 7) & 15, n0 = ((it >> 4) & 7) * 16, k0 = (it & 15) * 64;
        const float* keys = args.in[29] + ((size_t)layer * 16 + hp) * 128 * 128; const float* wq = args.in[28] + (size_t)layer * 1024 * 2048 + hp * 128;
        bf16_t* We = (bf16_t*)(F.ws + WS_WPEER) + (size_t)layer * 2048 * 1024;
        f32x4 acc[4];
#pragma unroll
        for (int s = 0; s < 4; ++s) acc[s] = (f32x4){0.f, 0.f, 0.f, 0.f};
        const int li = lane & 15, q = lane >> 4;
        for (int dc = 0; dc < 8; ++dc) {
            const int d = 16 * dc + 4 * q;
            const f32x4 a = *(const f32x4*)(keys + (size_t)(n0 + li) * 128 + d);
            f32x4 b[4];
#pragma unroll
            for (int s = 0; s < 4; ++s) b[s] = *(const f32x4*)(wq + (size_t)(k0 + 16 * s + li) * 2048 + d);
#pragma unroll
            for (int e = 0; e < 4; ++e)
#pragma unroll
                for (int s = 0; s < 4; ++s) acc[s] = __builtin_amdgcn_mfma_f32_16x16x4f32(a[e], b[s][e], acc[s], 0, 0, 0);
        }
#pragma unroll
        for (int s = 0; s < 4; ++s)
#pragma unroll
            for (int r = 0; r < 4; ++r) We[(size_t)(hp * 128 + n0 + 4 * q + r) * 1024 + k0 + 16 * s + li] = (bf16_t)f2bf(acc[s][r]);
    }
    cvt_stream(args.in[0], (bf16_t*)(F.ws + WS_X0B), (size_t)T * D / 8, gt, NGT);
    cvt_stream_fp8(args.in[30], F.ws + WS_UB, (size_t)16384 * D / 16, gt, NGT, U_SCALE);
    cvt_stream_fp8(args.in[31], F.ws + WS_VB, (size_t)16384 * D / 16, gt, NGT, V_SCALE);
    { float* sl = (float*)(F.ws + WS_VEC); for (size_t i = gt; i < (size_t)W; i += NGT) { const float l = args.in[8][i]; sl[i] = -8.f * (l < -15.f ? -l : log1pf(expf(-l))); } }
}

struct ProbPlain { const char* A; const char* B; size_t strideA, strideB;
    __device__ __forceinline__ void locate(pg8::Unit& u) const { u.A = A + (size_t)u.pm * strideA; u.B = B + (size_t)u.pn * strideB; } };
struct ProbGates { const char* A; const char* B;
    __device__ __forceinline__ void locate(pg8::Unit& u) const { u.A = A + (size_t)u.pm * (256 * W * 2) + gates_koff(u.pn) * 2; u.B = B + (size_t)u.pn * (256 * 384 * 2); } };
struct ProbRkv { const char* mix; const char* B;
    __device__ __forceinline__ void locate(pg8::Unit& u) const { const int pn = u.pn; const int j = pn < 4 ? 0 : (pn < 8 ? 2 : (pn < 12 ? 3 : (pn == 12 ? 1 : (pn == 13 ? 4 : 5))));
        u.A = mix + (size_t)j * ((size_t)T * D * 2) + (size_t)u.pm * (256 * D * 2); u.B = B + (size_t)pn * (256 * D * 2); } };

struct EpiWin { static constexpr bool PERM = true; bf16_t* gate; bf16_t* h2;
    __device__ __forceinline__ void operator()(const f32x4 (&acc)[2][2][4][2], const pg8::Unit& u, int wr, int wc, int fr, int fq) const {
        const int row0 = u.pm * 256 + wr * 64 + fr;
#pragma unroll
        for (int bj = 0; bj < 2; ++bj) { const int hb = 2 * u.pn + bj; const bool isg = hb < 11; bf16_t* base = isg ? gate : h2; const int col = 128 * (isg ? hb : hb - 11) + wc * 32 + 8 * fq;
#pragma unroll
            for (int ai = 0; ai < 2; ++ai)
#pragma unroll
                for (int m = 0; m < 4; ++m) { f32x4 v0 = acc[ai][bj][m][0], v1 = acc[ai][bj][m][1];
                    if (isg) {
#pragma unroll
                        for (int j = 0; j < 4; ++j) { v0[j] = gelu_tanh(v0[j]); v1[j] = gelu_tanh(v1[j]); } }
                    u32x4 w; w.x = cvt_pk_bf16(v0[0], v0[1]); w.y = cvt_pk_bf16(v0[2], v0[3]); w.z = cvt_pk_bf16(v1[0], v1[1]); w.w = cvt_pk_bf16(v1[2], v1[3]);
                    *(u32x4*)(base + (size_t)(row0 + ai * 128 + m * 16) * W + col) = w; } }
    } };
struct EpiGates { static constexpr bool PERM = false; const bf16_t* xc; const float* sl; const float* ba; const float* bx; bf16_t* a; bf16_t* uo;
    __device__ __forceinline__ void operator()(const f32x4 (&acc)[2][2][4][2], const pg8::Unit& u, int wr, int wc, int fr, int fq) const {
        const int row0 = u.pm * 256 + wr * 64 + fr;
#pragma unroll
        for (int ai = 0; ai < 2; ++ai)
#pragma unroll
            for (int m = 0; m < 4; ++m) {
#pragma unroll
                for (int n = 0; n < 2; ++n) { const int c = 128 * u.pn + wc * 32 + 16 * n + 4 * fq; const size_t off = (size_t)(row0 + ai * 128 + m * 16) * W + c;
                    const f32x4 s4 = *(const f32x4*)(sl + c), ba4 = *(const f32x4*)(ba + c), bx4 = *(const f32x4*)(bx + c);
                    const u32x2 xw = *(const u32x2*)(xc + off);
                    const f32x4 pa = acc[ai][0][m][n] + ba4, px = acc[ai][1][m][n] + bx4; f32x4 av, uv; const f32x4 xs = {bf_lo(xw.x), bf_hi(xw.x), bf_lo(xw.y), bf_hi(xw.y)};
#pragma unroll
                    for (int j = 0; j < 4; ++j) { const float r = fast_sigmoid(pa[j]), ig = fast_sigmoid(px[j]); const float la = s4[j] * r; const float aa = fast_exp(la);
                        av[j] = la; uv[j] = sqrtf(fmaxf(1.f - aa * aa, 0.f)) * ig * xs[j]; }
                    { u32x2 w1; w1.x = pk2(av[0], av[1]); w1.y = pk2(av[2], av[3]); *(u32x2*)(a + off) = w1; u32x2 w2; w2.x = pk2(uv[0], uv[1]); w2.y = pk2(uv[2], uv[3]); *(u32x2*)(uo + off) = w2; } }
                if (m == 3) asm volatile("" ::: "memory"); }
    } };
struct EpiRes { static constexpr bool PERM = false; const float* res; float* z;
    __device__ __forceinline__ void operator()(const f32x4 (&acc)[2][2][4][2], const pg8::Unit& u, int wr, int wc, int fr, int fq) const {
        const int row0 = u.pm * 256 + wr * 64 + fr, col0 = u.pn * 256 + wc * 32 + 4 * fq;
#pragma unroll
        for (int ai = 0; ai < 2; ++ai)
#pragma unroll
            for (int m = 0; m < 4; ++m) { const size_t off = (size_t)(row0 + ai * 128 + m * 16) * D + col0;
#pragma unroll
                for (int bj = 0; bj < 2; ++bj)
#pragma unroll
                    for (int n = 0; n < 2; ++n) { const f32x4 r4 = *(const f32x4*)(res + off + bj * 128 + n * 16); *(f32x4*)(z + off + bj * 128 + n * 16) = r4 * ALPHA + acc[ai][bj][m][n]; } }
    } };
struct EpiScores { static constexpr bool PERM = false; float* sc;
    __device__ __forceinline__ void operator()(const f32x4 (&acc)[2][2][4][2], const pg8::Unit& u, int wr, int wc, int fr, int fq) const {
#pragma unroll
        for (int ai = 0; ai < 2; ++ai) { const int tb = 4 * u.pm + 2 * ai + wr;
#pragma unroll
            for (int bj = 0; bj < 2; ++bj) { const int hp = 2 * u.pn + bj; float* base = sc + ((size_t)(tb * 16 + hp) * 128) * 64;
#pragma unroll
                for (int m = 0; m < 4; ++m) { const int tl = 16 * m + fr;
#pragma unroll
                    for (int n = 0; n < 2; ++n) { const int nn = 32 * wc + 16 * n + 4 * fq;
#pragma unroll
                        for (int j = 0; j < 4; ++j) base[(size_t)(nn + j) * 64 + tl] = acc[ai][bj][m][n][j]; } } } }
    } };
struct EpiRkv { static constexpr bool PERM = true; bf16_t* r; bf16_t* lora;
    __device__ __forceinline__ void operator()(const f32x4 (&acc)[2][2][4][2], const pg8::Unit& u, int wr, int wc, int fr, int fq) const {
        const int row0 = u.pm * 256 + wr * 64 + fr, pn = u.pn;
        if (pn < 12) { bf16_t* base = r + (size_t)(pn >> 2) * ((size_t)T * D); const int col0 = (pn & 3) * 256 + wc * 32 + 8 * fq;
#pragma unroll
            for (int ai = 0; ai < 2; ++ai)
#pragma unroll
                for (int m = 0; m < 4; ++m)
#pragma unroll
                    for (int bj = 0; bj < 2; ++bj) { const f32x4 v0 = acc[ai][bj][m][0], v1 = acc[ai][bj][m][1];
                        u32x4 w; w.x = cvt_pk_bf16(v0[0], v0[1]); w.y = cvt_pk_bf16(v0[2], v0[3]); w.z = cvt_pk_bf16(v1[0], v1[1]); w.w = cvt_pk_bf16(v1[2], v1[3]);
                        *(u32x4*)(base + (size_t)(row0 + ai * 128 + m * 16) * D + col0 + bj * 128) = w; }
        } else {
            const int kind = pn - 12;
            const int lim = kind == 2 ? 128 : 64, dst0 = kind == 0 ? 0 : (kind == 1 ? 64 : 128);
#pragma unroll
            for (int bj = 0; bj < 2; ++bj) { const int cl = 128 * bj + wc * 32 + 8 * fq; if (cl < lim) {
#pragma unroll
                for (int ai = 0; ai < 2; ++ai)
#pragma unroll
                    for (int m = 0; m < 4; ++m) { f32x4 v0 = acc[ai][bj][m][0], v1 = acc[ai][bj][m][1];
#pragma unroll
                        for (int j = 0; j < 4; ++j) { if (kind == 0) { v0[j] = fast_tanh(v0[j]); v1[j] = fast_tanh(v1[j]); } else if (kind == 2) { v0[j] = fast_sigmoid(v0[j]); v1[j] = fast_sigmoid(v1[j]); } }
                        u32x4 w; w.x = cvt_pk_bf16(v0[0], v0[1]); w.y = cvt_pk_bf16(v0[2], v0[3]); w.z = cvt_pk_bf16(v1[0], v1[1]); w.w = cvt_pk_bf16(v1[2], v1[3]);
                        *(u32x4*)(lora + (size_t)(row0 + ai * 128 + m * 16) * 256 + dst0 + cl) = w; } } }
        }
    } };
struct EpiLora2 { static constexpr bool PERM = true; float* wdec; bf16_t* aa; const float* w0; const float* a0;
    __device__ __forceinline__ void operator()(const f32x4 (&acc)[2][2][4][2], const pg8::Unit& u, int wr, int wc, int fr, int fq) const {
        const int row0 = u.pm * 256 + wr * 64 + fr, pn = u.pn, kind = pn >> 2;
#pragma unroll
        for (int bj = 0; bj < 2; ++bj) { const int col = (pn & 3) * 256 + 128 * bj + wc * 32 + 8 * fq;
            f32x4 c0 = {0.f, 0.f, 0.f, 0.f}, c1 = c0;
            if (kind == 0) { c0 = *(const f32x4*)(w0 + col); c1 = *(const f32x4*)(w0 + col + 4); } else if (kind == 1) { c0 = *(const f32x4*)(a0 + col); c1 = *(const f32x4*)(a0 + col + 4); }
#pragma unroll
            for (int ai = 0; ai < 2; ++ai)
#pragma unroll
                for (int m = 0; m < 4; ++m) { f32x4 v0 = acc[ai][bj][m][0] + c0, v1 = acc[ai][bj][m][1] + c1; const size_t off = (size_t)(row0 + ai * 128 + m * 16) * D + col;
                    if (kind == 0) {
#pragma unroll
                        for (int j = 0; j < 4; ++j) { v0[j] = fast_exp(-0.60653066f * fast_sigmoid(v0[j])); v1[j] = fast_exp(-0.60653066f * fast_sigmoid(v1[j])); }
                        *(f32x4*)(wdec + off) = v0; *(f32x4*)(wdec + off + 4) = v1;
                    } else {
                        if (kind == 1) {
#pragma unroll
                            for (int j = 0; j < 4; ++j) { v0[j] = fast_sigmoid(v0[j]); v1[j] = fast_sigmoid(v1[j]); } }
                        u32x4 w; w.x = cvt_pk_bf16(v0[0], v0[1]); w.y = cvt_pk_bf16(v0[2], v0[3]); w.z = cvt_pk_bf16(v1[0], v1[1]); w.w = cvt_pk_bf16(v1[2], v1[3]);
                        *(u32x4*)(aa + (size_t)(kind - 1) * ((size_t)T * D) + off) = w; } } }
    } };

template <class Epi, class Prob>
__device__ __forceinline__ void run_gemm(Frame& F, int nM, int nN, int lda, int ldb, int K, const Prob& P, const Epi& E) {
    pg8::Order<Prob> S; S.init(nM, nN, F.G, F.bx, P);
    pg8::gemm_phase<Epi, pg8::Order<Prob>, true, true>(F.lds, F.tid, lda, ldb, K, S, E);
}

__device__ __forceinline__ void conv_phase(Frame& F, const float* cw, const float* cb) {
    const bf16_t* h2 = (const bf16_t*)(F.ws + WS_H2); bf16_t* xc = (bf16_t*)(F.ws + WS_XC);
    const size_t gt = (size_t)F.gw * 64 + F.lane, NGT = (size_t)F.NGW * 64;
    for (size_t i = gt; i < (size_t)T * (W / 8); i += NGT) {
        const int t = (int)(i / (W / 8)), c = (int)(i % (W / 8)) * 8, s = t & (S - 1);
        float acc[8];
        { const f32x4 b0 = *(const f32x4*)(cb + c), b1 = *(const f32x4*)(cb + c + 4); acc[0] = b0.x; acc[1] = b0.y; acc[2] = b0.z; acc[3] = b0.w; acc[4] = b1.x; acc[5] = b1.y; acc[6] = b1.z; acc[7] = b1.w; }
#pragma unroll
        for (int j = 0; j < 4; ++j) { if (s - 3 + j >= 0) {
            const u32x4 hv = *(const u32x4*)(h2 + (size_t)(t - 3 + j) * W + c); const f32x4 w0 = *(const f32x4*)(cw + j * W + c), w1 = *(const f32x4*)(cw + j * W + c + 4);
            acc[0] += w0.x * bf_lo(hv.x); acc[1] += w0.y * bf_hi(hv.x); acc[2] += w0.z * bf_lo(hv.y); acc[3] += w0.w * bf_hi(hv.y);
            acc[4] += w1.x * bf_lo(hv.z); acc[5] += w1.y * bf_hi(hv.z); acc[6] += w1.z * bf_lo(hv.w); acc[7] += w1.w * bf_hi(hv.w); } }
        u32x4 o; o.x = pk2(acc[0], acc[1]); o.y = pk2(acc[2], acc[3]); o.z = pk2(acc[4], acc[5]); o.w = pk2(acc[6], acc[7]);
        *(u32x4*)(xc + (size_t)t * W + c) = o;
    }
}
constexpr int RG_CH = 32, RG_NCH = S / RG_CH;
__device__ __forceinline__ void rgscan1_phase(Frame& F) {
    const bf16_t* a = (const bf16_t*)(F.ws + WS_A); const bf16_t* u = (const bf16_t*)(F.ws + WS_U); float* agg = (float*)(F.ws + WS_AGG);
    for (int it = F.gw; it < NB * RG_NCH * 11; it += F.NGW) {
        const int cg = it % 11, ch = (it / 11) % RG_NCH, b = it / (11 * RG_NCH), c = cg * 128 + 2 * F.lane; const size_t t0 = (size_t)b * S + (size_t)ch * RG_CH;
        f32x2 P = {0.f, 0.f}, H = {0.f, 0.f};
#pragma unroll 8
        for (int s = 0; s < RG_CH; ++s) { const unsigned aw = *(const unsigned*)(a + (t0 + s) * W + c), uw = *(const unsigned*)(u + (t0 + s) * W + c); const f32x2 la = {bf_lo(aw), bf_hi(aw)}, uv = {bf_lo(uw), bf_hi(uw)};
            const f32x2 av = {fast_exp(la.x), fast_exp(la.y)}; H = av * H + uv; P = P + la; }
        P = (f32x2){fast_exp(P.x), fast_exp(P.y)};
        const size_t o = (size_t)(b * RG_NCH + ch) * W + c; *(f32x2*)(agg + o) = P; *(f32x2*)(agg + o + (size_t)NB * RG_NCH * W) = H;
    }
}
__device__ __forceinline__ void rgscan2_phase(Frame& F) {
    const bf16_t* a = (const bf16_t*)(F.ws + WS_A); const bf16_t* u = (const bf16_t*)(F.ws + WS_U); const float* agg = (const float*)(F.ws + WS_AGG);
    const bf16_t* gate = (const bf16_t*)(F.ws + WS_GATE); bf16_t* y = (bf16_t*)(F.ws + WS_Y);
    for (int it = F.gw; it < NB * RG_NCH * 11; it += F.NGW) {
        const int cg = it % 11, ch = (it / 11) % RG_NCH, b = it / (11 * RG_NCH), c = cg * 128 + 2 * F.lane; const size_t t0 = (size_t)b * S + (size_t)ch * RG_CH;
        f32x2 H = {0.f, 0.f};
        for (int j = 0; j < ch; ++j) { const size_t o = (size_t)(b * RG_NCH + j) * W + c; const f32x2 Pj = *(const f32x2*)(agg + o), Hj = *(const f32x2*)(agg + o + (size_t)NB * RG_NCH * W); H = Pj * H + Hj; }
#pragma unroll 8
        for (int s = 0; s < RG_CH; ++s) { const size_t o = (t0 + s) * W + c; const unsigned aw = *(const unsigned*)(a + o), uw = *(const unsigned*)(u + o); const f32x2 av = {fast_exp(bf_lo(aw)), fast_exp(bf_hi(aw))}, uv = {bf_lo(uw), bf_hi(uw)}; H = av * H + uv;
            const unsigned gw_ = *(const unsigned*)(gate + o); *(unsigned*)(y + o) = pk2(H.x * bf_lo(gw_), H.y * bf_hi(gw_)); }
    }
}
__device__ __forceinline__ void ln_phase(Frame& F, const float* z, const float* g, const float* bb, float* xf, bf16_t* xb) {
    for (int m = F.gw; m < T; m += F.NGW) {
        const f32x4* zr = (const f32x4*)(z + (size_t)m * D) + F.lane; f32x4 v[4]; float s = 0.f;
#pragma unroll
        for (int j = 0; j < 4; ++j) { v[j] = zr[64 * j]; s += (v[j].x + v[j].y) + (v[j].z + v[j].w); }
        const float mean = wave_sum(s) * (1.f / D); float s2 = 0.f;
#pragma unroll
        for (int j = 0; j < 4; ++j) { v[j] = v[j] - mean; s2 += (v[j].x * v[j].x + v[j].y * v[j].y) + (v[j].z * v[j].z + v[j].w * v[j].w); }
        const float rstd = 1.f / sqrtf(wave_sum(s2) * (1.f / D) + LN_EPS);
#pragma unroll
        for (int j = 0; j < 4; ++j) { const int c = 4 * F.lane + 256 * j; const f32x4 o = v[j] * rstd * *(const f32x4*)(g + c) + *(const f32x4*)(bb + c);
            *(f32x4*)(xf + (size_t)m * D + c) = o; if (xb) { u32x2 w; w.x = pk2(o.x, o.y); w.y = pk2(o.z, o.w); *(u32x2*)(xb + (size_t)m * D + c) = w; } }
    }
}
__device__ __forceinline__ void ce_desc(float& a, float& b) { const float hi = fmaxf(a, b), lo = fminf(a, b); a = hi; b = lo; }
__device__ __forceinline__ void sort16_desc(float (&a)[16]) {
#pragma unroll
    for (int k = 2; k <= 16; k <<= 1)
#pragma unroll
        for (int j = k >> 1; j > 0; j >>= 1)
#pragma unroll
            for (int i = 0; i < 16; ++i) { const int l = i ^ j; if (l > i) { if ((i & k) == 0) ce_desc(a[i], a[l]); else ce_desc(a[l], a[i]); } }
}
__device__ __forceinline__ void merge_top16(float (&t)[16], const float (&b)[16]) {
#pragma unroll
    for (int i = 0; i < 16; ++i) t[i] = fmaxf(t[i], b[15 - i]);
#pragma unroll
    for (int j = 8; j > 0; j >>= 1)
#pragma unroll
        for (int i = 0; i < 16; ++i) { const int l = i ^ j; if (l > i) ce_desc(t[i], t[l]); }
}
__device__ __forceinline__ float pack_idx7(float v, int n) { return __builtin_bit_cast(float, (__builtin_bit_cast(unsigned, v) & ~127u) | (unsigned)(127 - n)); }
__device__ __forceinline__ void top16_of_128(float (&s)[16], const float* p) {
    { float g[16];
#pragma unroll
      for (int i = 0; i < 16; ++i) g[i] = pack_idx7(p[(size_t)i * 64], i);
      sort16_desc(g);
#pragma unroll
      for (int i = 0; i < 16; ++i) s[i] = g[i]; }
#pragma unroll 1
    for (int grp = 1; grp < 8; ++grp) { float g[16];
#pragma unroll
        for (int i = 0; i < 16; ++i) g[i] = pack_idx7(p[(size_t)(16 * grp + i) * 64], 16 * grp + i);
        sort16_desc(g); merge_top16(s, g); }
}
__device__ __forceinline__ void topk_phase(Frame& F, const float* sc, int* eid, float* gwt) {
    for (int it = F.gw; it < (T / 64) * 8; it += F.NGW) {
        const int tb = it >> 3, h = it & 7, t = tb * 64 + F.lane;
        float s0[16], s1[16];
        const float* p0 = sc + ((size_t)(tb * 16 + 2 * h) * 128) * 64 + F.lane;
        top16_of_128(s0, p0); top16_of_128(s1, p0 + 128 * 64);
        float tt[16];
        { float g[16];
#define PAIR(i, j) __builtin_bit_cast(float, (__builtin_bit_cast(unsigned, s0[i] + s1[j]) & ~255u) | (unsigned)(255 - ((i) * 16 + (j))))
          const float NI = -__builtin_inff();
          g[0] = PAIR(0,0); g[1] = PAIR(0,1); g[2] = PAIR(0,2); g[3] = PAIR(0,3); g[4] = PAIR(0,4); g[5] = PAIR(0,5); g[6] = PAIR(0,6); g[7] = PAIR(0,7);
          g[8] = PAIR(0,8); g[9] = PAIR(0,9); g[10] = PAIR(0,10); g[11] = PAIR(0,11); g[12] = PAIR(0,12); g[13] = PAIR(0,13); g[14] = PAIR(0,14); g[15] = PAIR(0,15);
          sort16_desc(g);
#pragma unroll
          for (int i = 0; i < 16; ++i) tt[i] = g[i];
          g[0] = PAIR(1,0); g[1] = PAIR(1,1); g[2] = PAIR(1,2); g[3] = PAIR(1,3); g[4] = PAIR(1,4); g[5] = PAIR(1,5); g[6] = PAIR(1,6); g[7] = PAIR(1,7);
          g[8] = PAIR(2,0); g[9] = PAIR(2,1); g[10] = PAIR(2,2); g[11] = PAIR(2,3); g[12] = PAIR(2,4); g[13] = PAIR(3,0); g[14] = PAIR(3,1); g[15] = PAIR(3,2);
          sort16_desc(g); merge_top16(tt, g);
          g[0] = PAIR(3,3); g[1] = PAIR(4,0); g[2] = PAIR(4,1); g[3] = PAIR(4,2); g[4] = PAIR(5,0); g[5] = PAIR(5,1); g[6] = PAIR(6,0); g[7] = PAIR(6,1);
          g[8] = PAIR(7,0); g[9] = PAIR(7,1); g[10] = PAIR(8,0); g[11] = PAIR(9,0); g[12] = PAIR(10,0); g[13] = PAIR(11,0); g[14] = PAIR(12,0); g[15] = PAIR(13,0);
          sort16_desc(g); merge_top16(tt, g);
          g[0] = PAIR(14,0); g[1] = PAIR(15,0); g[2] = NI; g[3] = NI; g[4] = NI; g[5] = NI; g[6] = NI; g[7] = NI; g[8] = NI; g[9] = NI; g[10] = NI; g[11] = NI; g[12] = NI; g[13] = NI; g[14] = NI; g[15] = NI;
          ce_desc(g[0], g[1]); merge_top16(tt, g);
#undef PAIR
        }
        float e[16], sum = 0.f;
#pragma unroll
        for (int r = 0; r < 16; ++r) { e[r] = fast_exp(tt[r] - tt[0]); sum += e[r]; }
        const float inv = 1.f / sum;
        int ids[16];
#pragma unroll
        for (int r = 0; r < 16; ++r) { const unsigned code = 255u - (__builtin_bit_cast(unsigned, tt[r]) & 255u); const unsigned ci = code >> 4, cj = code & 15u; unsigned i0 = 0, i1 = 0;
#pragma unroll
            for (int i = 0; i < 16; ++i) { i0 = (ci == (unsigned)i) ? (127u - (__builtin_bit_cast(unsigned, s0[i]) & 127u)) : i0; i1 = (cj == (unsigned)i) ? (127u - (__builtin_bit_cast(unsigned, s1[i]) & 127u)) : i1; }
            ids[r] = (int)(i0 * 128u + i1); }
        int* ep = eid + (size_t)t * 128 + h * 16; float* gp = gwt + (size_t)t * 128 + h * 16;
#pragma unroll
        for (int r = 0; r < 16; r += 4) { *(int4*)(ep + r) = make_int4(ids[r], ids[r + 1], ids[r + 2], ids[r + 3]); *(f32x4*)(gp + r) = (f32x4){e[r] * inv, e[r + 1] * inv, e[r + 2] * inv, e[r + 3] * inv}; }
    }
}
__device__ __forceinline__ f32x2 fp8lo(unsigned w) { return __builtin_amdgcn_cvt_pk_f32_fp8((int)w, false); }
__device__ __forceinline__ f32x2 fp8hi(unsigned w) { return __builtin_amdgcn_cvt_pk_f32_fp8((int)w, true); }
__device__ __forceinline__ float gu_dot(const u32x4& r, const f32x2 (&xs)[8]) { f32x2 d = fp8lo(r.x) * xs[0]; d += fp8hi(r.x) * xs[1]; d += fp8lo(r.y) * xs[2]; d += fp8hi(r.y) * xs[3];
    d += fp8lo(r.z) * xs[4]; d += fp8hi(r.z) * xs[5]; d += fp8lo(r.w) * xs[6]; d += fp8hi(r.w) * xs[7]; return sum8(d.x + d.y); }
__device__ __forceinline__ void gu_phase(Frame& F, const float* xf, const int* eid, float* part, const unsigned char* utab) {
    const int j = F.bx & 7, sg = F.bx >> 3, lane = F.lane, e8 = lane >> 3, dch = lane & 7;
    const unsigned char* Ub = utab + (size_t)j * ((size_t)16384 * 128); float* pj = part + (size_t)j * T * 128; const unsigned lo16 = 16u * dch;
    constexpr int TPW = T / (32 * NWAVES); const int tb = sg * (T / 32) + F.wave * TPW;
    int e0 = eid[(size_t)tb * 128 + lane], e1 = eid[(size_t)tb * 128 + 64 + lane];
    f32x4 xq[4];
#pragma unroll
    for (int q = 0; q < 4; ++q) xq[q] = *(const f32x4*)(xf + (size_t)tb * D + 128 * j + 16 * dch + 4 * q);
#pragma unroll 1
    for (int it = 0; it < TPW; ++it) { const int t = tb + it;
        u32x4 ra[16];
#pragma unroll
        for (int i = 0; i < 16; ++i) { const int ia = __shfl(i < 8 ? e0 : e1, (8 * i + e8) & 63); ra[i] = *(const u32x4*)(Ub + ((unsigned)ia * 128u + lo16)); }
        f32x2 xs[8];
#pragma unroll
        for (int q = 0; q < 4; ++q) { const f32x4 x0 = xq[q] * (1.f / U_SCALE); xs[2 * q] = (f32x2){x0.x, x0.y}; xs[2 * q + 1] = (f32x2){x0.z, x0.w}; }
        const int tn = (it + 1 < TPW) ? t + 1 : t;
        e0 = eid[(size_t)tn * 128 + lane]; e1 = eid[(size_t)tn * 128 + 64 + lane];
#pragma unroll
        for (int q = 0; q < 4; ++q) xq[q] = *(const f32x4*)(xf + (size_t)tn * D + 128 * j + 16 * dch + 4 * q);
        float a0 = 0.f, a1 = 0.f;
#pragma unroll
        for (int i = 0; i < 16; ++i) { const float sa = gu_dot(ra[i], xs); if ((i & 7) == dch) { if (i < 8) a0 = sa; else a1 = sa; } }
        pj[(size_t)t * 128 + 8 * dch + e8] = a0; pj[(size_t)t * 128 + 64 + 8 * dch + e8] = a1;
    }
}
__device__ __forceinline__ void gu2_phase(Frame& F, const float* xf, const int* eid, float* part) {
    const int j = F.bx & 7, sg = F.bx >> 3, lane = F.lane, e8 = lane >> 3, dch = lane & 7;
    const __amdgpu_buffer_rsrc_t ub = __builtin_amdgcn_make_buffer_rsrc((void*)(F.ws + WS_UB + (size_t)j * ((size_t)16384 * 128)), (short)0, 16384 * 128, 0x00020000);
    float* pj = part + (size_t)j * T * 128; const int lo16 = 16 * dch;
    constexpr int TPW = T / (32 * NWAVES); const int tb = sg * (T / 32) + F.wave * TPW;
    int ea0 = eid[(size_t)tb * 128 + lane], ea1 = eid[(size_t)tb * 128 + 64 + lane], eb0 = eid[(size_t)(tb + 1) * 128 + lane], eb1 = eid[(size_t)(tb + 1) * 128 + 64 + lane];
#pragma unroll 1
    for (int it = 0; it < TPW / 2; ++it) { const int t0 = tb + 2 * it, t1 = t0 + 1;
        u32x4 ra[16], rb[16];
#pragma unroll
        for (int i = 0; i < 16; ++i) { const int ia = __shfl(i < 8 ? ea0 : ea1, (8 * i + e8) & 63), ib = __shfl(i < 8 ? eb0 : eb1, (8 * i + e8) & 63);
            ra[i] = __builtin_bit_cast(u32x4, __builtin_amdgcn_raw_buffer_load_b128(ub, ia * 128 + lo16, 0, 0)); rb[i] = __builtin_bit_cast(u32x4, __builtin_amdgcn_raw_buffer_load_b128(ub, ib * 128 + lo16, 0, 0)); }
        const int tn = (it + 1 < TPW / 2) ? t0 + 2 : t0;
        ea0 = eid[(size_t)tn * 128 + lane]; ea1 = eid[(size_t)tn * 128 + 64 + lane]; eb0 = eid[(size_t)(tn + 1) * 128 + lane]; eb1 = eid[(size_t)(tn + 1) * 128 + 64 + lane];
        float a0 = 0.f, a1 = 0.f, b0 = 0.f, b1 = 0.f;
        { f32x2 xs[8];
#pragma unroll
          for (int q = 0; q < 4; ++q) { const f32x4 x0 = *(const f32x4*)(xf + (size_t)t0 * D + 128 * j + 16 * dch + 4 * q) * (1.f / U_SCALE); xs[2 * q] = (f32x2){x0.x, x0.y}; xs[2 * q + 1] = (f32x2){x0.z, x0.w}; }
#pragma unroll
          for (int i = 0; i < 16; ++i) { const float sa = gu_dot(ra[i], xs); if ((i & 7) == dch) { if (i < 8) a0 = sa; else a1 = sa; } } }
        { f32x2 xs[8];
#pragma unroll
          for (int q = 0; q < 4; ++q) { const f32x4 x0 = *(const f32x4*)(xf + (size_t)t1 * D + 128 * j + 16 * dch + 4 * q) * (1.f / U_SCALE); xs[2 * q] = (f32x2){x0.x, x0.y}; xs[2 * q + 1] = (f32x2){x0.z, x0.w}; }
#pragma unroll
          for (int i = 0; i < 16; ++i) { const float sb = gu_dot(rb[i], xs); if ((i & 7) == dch) { if (i < 8) b0 = sb; else b1 = sb; } } }
        pj[(size_t)t0 * 128 + 8 * dch + e8] = a0; pj[(size_t)t0 * 128 + 64 + 8 * dch + e8] = a1; pj[(size_t)t1 * 128 + 8 * dch + e8] = b0; pj[(size_t)t1 * 128 + 64 + 8 * dch + e8] = b1;
    }
}
__device__ __forceinline__ void gr_phase(Frame& F, const float* part, float* gwt) {
    const size_t gt = (size_t)F.gw * 64 + F.lane, NGT = (size_t)F.NGW * 64;
    for (size_t i = gt; i < (size_t)T * 32; i += NGT) { f32x4 a = *(const f32x4*)(part + 4 * i);
#pragma unroll
        for (int jj = 1; jj < 8; ++jj) a += *(const f32x4*)(part + (size_t)jj * T * 128 + 4 * i);
        f32x4 g = *(const f32x4*)(gwt + 4 * i);
        g.x *= gelu_tanh(a.x) * (1.f / V_SCALE); g.y *= gelu_tanh(a.y) * (1.f / V_SCALE); g.z *= gelu_tanh(a.z) * (1.f / V_SCALE); g.w *= gelu_tanh(a.w) * (1.f / V_SCALE);
        *(f32x4*)(gwt + 4 * i) = g; }
}
__device__ __forceinline__ void gv_acc(f32x2 (&acc)[8], const u32x4& r, const float c) { const f32x2 c2 = {c, c};
    acc[0] += c2 * fp8lo(r.x); acc[1] += c2 * fp8hi(r.x); acc[2] += c2 * fp8lo(r.y); acc[3] += c2 * fp8hi(r.y); acc[4] += c2 * fp8lo(r.z); acc[5] += c2 * fp8hi(r.z); acc[6] += c2 * fp8lo(r.w); acc[7] += c2 * fp8hi(r.w); }
__device__ __forceinline__ void gv_phase(Frame& F, const float* xf, const int* eid, const float* coef, float* z, const unsigned char* vtab) {
    const int j = F.bx & 7, sg = F.bx >> 3, lane = F.lane, e8 = lane >> 3, dch = lane & 7;
    const unsigned char* Vb = vtab + (size_t)j * ((size_t)16384 * 128); const unsigned lo16 = 16u * dch;
    const bool b3 = lane & 8, b4 = lane & 16, b5 = lane & 32;
    const int dd = 128 * j + 16 * dch + 2 * ((b3 ? 4 : 0) + (b4 ? 2 : 0) + (b5 ? 1 : 0));
    constexpr int TPW = T / (32 * NWAVES); const int tb = sg * (T / 32) + F.wave * TPW;
    int e0 = eid[(size_t)tb * 128 + lane], e1 = eid[(size_t)tb * 128 + 64 + lane]; float c0 = coef[(size_t)tb * 128 + lane], c1 = coef[(size_t)tb * 128 + 64 + lane];
    f32x2 xr = *(const f32x2*)(xf + (size_t)tb * D + dd);
#pragma unroll 1
    for (int it = 0; it < TPW; ++it) { const int t = tb + it;
        u32x4 ra[16]; float cf[16];
#pragma unroll
        for (int i = 0; i < 16; ++i) { const int ia = __shfl(i < 8 ? e0 : e1, (8 * i + e8) & 63); ra[i] = *(const u32x4*)(Vb + ((unsigned)ia * 128u + lo16)); cf[i] = __shfl(i < 8 ? c0 : c1, (8 * i + e8) & 63); }
        const f32x2 xcur = xr; const int tn = (it + 1 < TPW) ? t + 1 : t;
        e0 = eid[(size_t)tn * 128 + lane]; e1 = eid[(size_t)tn * 128 + 64 + lane]; c0 = coef[(size_t)tn * 128 + lane]; c1 = coef[(size_t)tn * 128 + 64 + lane];
        xr = *(const f32x2*)(xf + (size_t)tn * D + dd);
        f32x2 acc[8];
#pragma unroll
        for (int m = 0; m < 8; ++m) acc[m] = (f32x2){0.f, 0.f};
#pragma unroll
        for (int i = 0; i < 16; ++i) gv_acc(acc, ra[i], cf[i]);
        f32x2 q[4], p[2], v;
#pragma unroll
        for (int i = 0; i < 4; ++i) { const f32x2 keep = b3 ? acc[4 + i] : acc[i], send = b3 ? acc[i] : acc[4 + i]; q[i] = keep + (f32x2){dpp_f<DPP_ROW_ROR(8)>(send.x), dpp_f<DPP_ROW_ROR(8)>(send.y)}; }
#pragma unroll
        for (int i = 0; i < 2; ++i) { const f32x2 keep = b4 ? q[2 + i] : q[i], send = b4 ? q[i] : q[2 + i]; p[i] = keep + (f32x2){__shfl_xor(send.x, 16), __shfl_xor(send.y, 16)}; }
        { const f32x2 keep = b5 ? p[1] : p[0], send = b5 ? p[0] : p[1]; v = keep + (f32x2){__shfl_xor(send.x, 32), __shfl_xor(send.y, 32)}; }
        *(f32x2*)(z + (size_t)t * D + dd) = xcur * ALPHA + v;
    }
}
__device__ __forceinline__ void ld_row8(const float* zrow, int lane, f32x4 (&v)[4]) {
#pragma unroll
    for (int j = 0; j < 2; ++j) { v[2 * j] = *(const f32x4*)(zrow + 8 * lane + 512 * j); v[2 * j + 1] = *(const f32x4*)(zrow + 8 * lane + 512 * j + 4); }
}
__device__ __forceinline__ void ln_row8(const f32x4 (&vin)[4], const float* g, const float* bb, int lane, f32x4 (&o)[4]) {
    f32x4 v[4]; float s = 0.f;
#pragma unroll
    for (int q = 0; q < 4; ++q) { v[q] = vin[q]; s += (v[q].x + v[q].y) + (v[q].z + v[q].w); }
    const float mean = wave_sum(s) * (1.f / D); float s2 = 0.f;
#pragma unroll
    for (int q = 0; q < 4; ++q) { v[q] = v[q] - mean; s2 += (v[q].x * v[q].x + v[q].y * v[q].y) + (v[q].z * v[q].z + v[q].w * v[q].w); }
    const float rstd = 1.f / sqrtf(wave_sum(s2) * (1.f / D) + LN_EPS);
#pragma unroll
    for (int q = 0; q < 4; ++q) { const int c = 8 * lane + 512 * (q >> 1) + 4 * (q & 1); o[q] = v[q] * rstd * *(const f32x4*)(g + c) + *(const f32x4*)(bb + c); }
}
__device__ __forceinline__ void lnmix_phase(Frame& F, const float* z, const float* g, const float* bb, float* xf, const float* mix, bf16_t* mx) {
    const int lane = F.lane;
    for (int blk = F.gw; blk < T / 8; blk += F.NGW) { const int t0 = blk * 8;
        f32x4 xp[4], zc[4], zn[4];
        ld_row8(z + (size_t)t0 * D, lane, zn);
        if ((t0 & (S - 1)) == 0) {
#pragma unroll
            for (int q = 0; q < 4; ++q) xp[q] = (f32x4){0.f, 0.f, 0.f, 0.f};
        } else { ld_row8(z + (size_t)(t0 - 1) * D, lane, zc); ln_row8(zc, g, bb, lane, xp); }
#pragma unroll 1
        for (int rr = 0; rr < 8; ++rr) { const int t = t0 + rr; f32x4 x[4];
#pragma unroll
            for (int q = 0; q < 4; ++q) zc[q] = zn[q];
            ld_row8(z + (size_t)(rr < 7 ? t + 1 : t) * D, lane, zn);
            ln_row8(zc, g, bb, lane, x);
#pragma unroll
            for (int q = 0; q < 4; ++q) *(f32x4*)(xf + (size_t)t * D + 8 * lane + 512 * (q >> 1) + 4 * (q & 1)) = x[q];
#pragma unroll
            for (int m = 0; m < 6; ++m)
#pragma unroll
                for (int j = 0; j < 2; ++j) { const int c = 8 * lane + 512 * j; const f32x4 m0 = *(const f32x4*)(mix + m * D + c), m1 = *(const f32x4*)(mix + m * D + c + 4);
                    const f32x4 o0 = x[2 * j] + (xp[2 * j] - x[2 * j]) * m0, o1 = x[2 * j + 1] + (xp[2 * j + 1] - x[2 * j + 1]) * m1;
                    u32x4 o; o.x = pk2(o0.x, o0.y); o.y = pk2(o0.z, o0.w); o.z = pk2(o1.x, o1.y); o.w = pk2(o1.z, o1.w);
                    *(u32x4*)(mx + (size_t)m * ((size_t)T * D) + (size_t)t * D + c) = o; }
#pragma unroll
            for (int q = 0; q < 4; ++q) xp[q] = x[q];
        }
    }
}
__device__ __forceinline__ void mix_phase(Frame& F, const float* mix) {
    const float* xf = (const float*)(F.ws + WS_XF); bf16_t* mx = (bf16_t*)(F.ws + WS_MIX);
    const size_t gt = (size_t)F.gw * 64 + F.lane, NGT = (size_t)F.NGW * 64;
    for (size_t i = gt; i < (size_t)T * (D / 8); i += NGT) {
        const int t = (int)(i >> 7), c = (int)(i & 127) * 8, s = t & (S - 1);
        const f32x4 x0 = *(const f32x4*)(xf + (size_t)t * D + c), x1 = *(const f32x4*)(xf + (size_t)t * D + c + 4);
        f32x4 p0 = {0.f, 0.f, 0.f, 0.f}, p1 = p0;
        if (s > 0) { p0 = *(const f32x4*)(xf + (size_t)(t - 1) * D + c); p1 = *(const f32x4*)(xf + (size_t)(t - 1) * D + c + 4); }
        const f32x4 d0 = p0 - x0, d1 = p1 - x1;
#pragma unroll
        for (int m = 0; m < 6; ++m) { const f32x4 m0 = *(const f32x4*)(mix + m * D + c), m1 = *(const f32x4*)(mix + m * D + c + 4); const f32x4 o0 = x0 + d0 * m0, o1 = x1 + d1 * m1;
            u32x4 o; o.x = pk2(o0.x, o0.y); o.y = pk2(o0.z, o0.w); o.z = pk2(o1.x, o1.y); o.w = pk2(o1.z, o1.w);
            *(u32x4*)(mx + (size_t)m * ((size_t)T * D) + (size_t)t * D + c) = o; }
    }
}
constexpr int RWL = 32, RW_NCH = S / RWL;
constexpr int PK_A2 = 0, PK_RT = 4096, PK_MBR = 8192, PK_BH = 10240, PK_N2 = 14336, PK_MKR = 16384, PK_KH = 18432, PK_VT = 22528, PK_GL = 26624, PK_BON = 26880, PK_BYTES = 27648;
constexpr size_t PK_BATCH = (size_t)1024 * PK_BYTES;
__device__ __forceinline__ unsigned char* pack_ptr(unsigned char* ws, float* out, int b, int hc) {
    unsigned char* base = b < 2 ? ws + 34 * MiB + (size_t)b * PK_BATCH : (b == 2 ? ws + 322 * MiB : (b < 6 ? ws + 414 * MiB + (size_t)(b - 3) * PK_BATCH : (unsigned char*)out + (size_t)(b - 6) * PK_BATCH));
    return base + (size_t)hc * PK_BYTES;
}
__device__ __forceinline__ bf16x8 frag_acc(const f32x16& x, const int s) {
    u32x4 w; w.x = cvt_pk_bf16_c(x[8 * s + 0], x[8 * s + 1]); w.y = cvt_pk_bf16_c(x[8 * s + 2], x[8 * s + 3]); w.z = cvt_pk_bf16_c(x[8 * s + 4], x[8 * s + 5]); w.w = cvt_pk_bf16_c(x[8 * s + 6], x[8 * s + 7]);
    return __builtin_bit_cast(bf16x8, w);
}
__device__ __forceinline__ float wave_sum_fast(float v) { v = sum16(v); v += __shfl_xor(v, 16); v += __shfl_xor(v, 32); return v; }

template <int DBGMODE = 0> __device__ __forceinline__ void rwprep_phase(Frame& F, const Args& args, const int nbatch) {
    const int lane0 = F.lane;
    LAS unsigned char* wl = F.lds + F.wave * 18432;
    const bf16_t* R = (const bf16_t*)(F.ws + WS_R); const bf16_t* Kt_ = (const bf16_t*)(F.ws + WS_K); const bf16_t* Vt_ = (const bf16_t*)(F.ws + WS_V);
    const bf16_t* AA = (const bf16_t*)(F.ws + WS_AA); const float* WD = (const float*)(F.ws + WS_WDEC);
    for (int it = F.gw; it < nbatch * NH * RW_NCH; it += F.NGW) {
        int lane = lane0; asm volatile("" : "+v"(lane));
        const int r = lane & 31, hh = lane >> 5;
        const int b = it / (NH * RW_NCH), hc = it % (NH * RW_NCH), h = hc / RW_NCH, c = hc % RW_NCH, ch = h * 64 + lane;
        unsigned char* pk = pack_ptr(F.ws, F.out, b, hc);
        const float kkc = args.in[22][ch], kac = args.in[23][ch], rkc = args.in[24][ch];
        const size_t tok0 = (size_t)b * S + (size_t)c * RWL;
        const int posj = 16 * (lane >> 4) + ((lane & 3) | ((lane & 4) << 1) | ((lane & 8) >> 1));
        float gam = 1.f, bon = 0.f;
#pragma unroll 1
        for (int blk = 0; blk < (DBGMODE == 1 ? 0 : 2); ++blk) {
            unsigned short rr[16], kr[16], ar[16]; float wv[16];
#pragma unroll
            for (int q = 0; q < 16; ++q) { const size_t off = (tok0 + 16 * blk + q) * D + ch; rr[q] = R[off]; kr[q] = Kt_[off]; ar[q] = AA[off]; wv[q] = WD[off]; }
#pragma unroll
            for (int q = 0; q < 16; ++q) { const int t = 16 * blk + q;
                const float rv = __builtin_bit_cast(float, (unsigned)rr[q] << 16), kv = __builtin_bit_cast(float, (unsigned)kr[q] << 16), al = __builtin_bit_cast(float, (unsigned)ar[q] << 16), w = wv[q];
                const float kkr = kv * kkc; const float ss = wave_sum_fast(kkr * kkr); const float kk = kkr / fmaxf(sqrtf(ss), 1e-12f);
                const float km = kv * (1.f + (al - 1.f) * kac);
                const float bs = wave_sum_fast(rv * km * rkc); bon = (lane == t) ? bs : bon;
                const float at = gam * (-kk); gam *= w; const float inv = 1.f / gam;
                const float bt = kk * al * inv, ktv = km * inv, rt = gam * rv;
                *(LAS bf16_t*)(wl + 0 + t * 144 + lane * 2) = (bf16_t)f2bf(at); *(LAS bf16_t*)(wl + 4608 + t * 144 + lane * 2) = (bf16_t)f2bf(bt);
                *(LAS bf16_t*)(wl + 9216 + t * 144 + lane * 2) = (bf16_t)f2bf(ktv); *(LAS bf16_t*)(wl + 13824 + t * 144 + lane * 2) = (bf16_t)f2bf(rt);
                *(bf16_t*)(pk + PK_RT + t * 128 + lane * 2) = (bf16_t)f2bf(rt);
            }
        }
        const float gamL = gam;
        *(float*)(pk + PK_GL + lane * 4) = gamL; if (lane < 32) *(float*)(pk + PK_BON + lane * 4) = bon;
#pragma unroll
        for (int m = 0; m < 4; ++m) { unsigned short e[8];
#pragma unroll
            for (int q = 0; q < 8; ++q) e[q] = Vt_[(tok0 + 8 * m + q) * D + ch];
            u32x4 o; o.x = e[0] | ((unsigned)e[1] << 16); o.y = e[2] | ((unsigned)e[3] << 16); o.z = e[4] | ((unsigned)e[5] << 16); o.w = e[6] | ((unsigned)e[7] << 16);
            *(u32x4*)(pk + PK_VT + lane * 64 + m * 16) = o; }
        LDS_WAIT(); asm volatile("" ::: "memory");
        bf16x8 idf[2];
#pragma unroll
        for (int s = 0; s < 2; ++s) { unsigned e[8];
#pragma unroll
            for (int j = 0; j < 8; ++j) e[j] = (r == 16 * s + 8 * hh + j) ? 0x3F80u : 0u;
            u32x4 w; w.x = e[0] | (e[1] << 16); w.y = e[2] | (e[3] << 16); w.z = e[4] | (e[5] << 16); w.w = e[6] | (e[7] << 16); idf[s] = __builtin_bit_cast(bf16x8, w); }
        bf16x8 xaf[2][2];
#pragma unroll
        for (int kt = 0; kt < 2; ++kt) {
            const int fo = r * 144 + (2 * kt) * 32 + hh * 16;
            f32x16 xb = F16ZERO, xk = F16ZERO, xa = F16ZERO;
            xb = mfma32(*(const LAS bf16x8*)(wl + 4608 + fo), idf[0], xb); xb = mfma32(*(const LAS bf16x8*)(wl + 4608 + fo + 32), idf[1], xb);
            xk = mfma32(*(const LAS bf16x8*)(wl + 9216 + fo), idf[0], xk); xk = mfma32(*(const LAS bf16x8*)(wl + 9216 + fo + 32), idf[1], xk);
            xa = mfma32(*(const LAS bf16x8*)(wl + 0 + fo), idf[0], xa); xa = mfma32(*(const LAS bf16x8*)(wl + 0 + fo + 32), idf[1], xa);
            xaf[kt][0] = frag_acc(xa, 0); xaf[kt][1] = frag_acc(xa, 1);
            const float gl = __shfl(gamL, 32 * kt + r);
#pragma unroll
            for (int g = 0; g < 4; ++g) {
                u32x2 w1; w1.x = pk2(xb[4 * g] * gl, xb[4 * g + 1] * gl); w1.y = pk2(xb[4 * g + 2] * gl, xb[4 * g + 3] * gl);
                *(u32x2*)(pk + PK_BH + kt * 2048 + (g * 64 + lane) * 8) = w1;
                u32x2 w2; w2.x = pk2(xk[4 * g] * gl, xk[4 * g + 1] * gl); w2.y = pk2(xk[4 * g + 2] * gl, xk[4 * g + 3] * gl);
                *(u32x2*)(pk + PK_KH + kt * 2048 + (g * 64 + lane) * 8) = w2; }
        }
        f32x16 pBA = F16ZERO, pBR = F16ZERO, pKR = F16ZERO, qAK = F16ZERO;
#pragma unroll
        for (int ks = 0; ks < 4; ++ks) {
            const int fo = r * 144 + ks * 32 + hh * 16;
            const bf16x8 fA = *(const LAS bf16x8*)(wl + 0 + fo), fB = *(const LAS bf16x8*)(wl + 4608 + fo), fK = *(const LAS bf16x8*)(wl + 9216 + fo), fR = *(const LAS bf16x8*)(wl + 13824 + fo);
            pBA = mfma32(fB, fA, pBA);
            pBR = mfma32(fB, fR, pBR);
            pKR = mfma32(fK, fR, pKR);
            qAK = mfma32(fA, fK, qAK);
        }
        LDS_WAIT(); asm volatile("" ::: "memory");
#pragma unroll
        for (int g = 0; g < 4; ++g) {
            float mb[4], mkv[4];
#pragma unroll
            for (int d = 0; d < 4; ++d) { const int reg = 4 * g + d, row = d + 8 * g + 4 * hh;
                *(LAS float*)(wl + 13824 + row * 144 + r * 4) = (row < r) ? pBA[reg] : 0.f;
                mb[d] = (row <= r) ? pBR[reg] : 0.f; mkv[d] = (row <= r) ? pKR[reg] : 0.f;
                qAK[reg] = (r < row) ? qAK[reg] : 0.f; }
            u32x2 w1; w1.x = pk2(mb[0], mb[1]); w1.y = pk2(mb[2], mb[3]); *(u32x2*)(pk + PK_MBR + (g * 64 + lane) * 8) = w1;
            u32x2 w2; w2.x = pk2(mkv[0], mkv[1]); w2.y = pk2(mkv[2], mkv[3]); *(u32x2*)(pk + PK_MKR + (g * 64 + lane) * 8) = w2;
        }
        *(LAS bf16x8*)(wl + lane * 96) = frag_acc(qAK, 0); *(LAS bf16x8*)(wl + lane * 96 + 16) = frag_acc(qAK, 1);
        *(LAS bf16x8*)(wl + lane * 96 + 32) = xaf[0][0]; *(LAS bf16x8*)(wl + lane * 96 + 48) = xaf[0][1]; *(LAS bf16x8*)(wl + lane * 96 + 64) = xaf[1][0]; *(LAS bf16x8*)(wl + lane * 96 + 80) = xaf[1][1];
        LDS_WAIT(); asm volatile("" ::: "memory");
        float tt[32]; if (DBGMODE == 2) {
#pragma unroll
            for (int i = 0; i < 32; ++i) tt[i] = 0.f; }
        int lmo = 13824;
#pragma unroll
        for (int cc = 31; cc >= (DBGMODE == 2 ? 31 : 0); --cc) { float acc = (r == cc) ? 1.f : 0.f;
            if (cc < 31 && (cc & 1)) asm volatile("" : "+v"(lmo) : "v"(tt[cc + 1]));
#pragma unroll
            for (int q4 = 0; q4 < 8; ++q4) { if (4 * q4 + 3 > cc) { const f32x4 lm = *(const LAS f32x4*)(wl + lmo + cc * 144 + q4 * 16);
#pragma unroll
                for (int d = 0; d < 4; ++d) { const int i = 4 * q4 + d; if (i > cc) acc += tt[i] * lm[d]; } } }
            tt[cc] = acc; }
        f32x16 a2t0 = F16ZERO, a2t1 = F16ZERO, n2t = F16ZERO;
#pragma unroll
        for (int s = 0; s < 2; ++s) {
            float p[8];
#pragma unroll
            for (int j = 0; j < 8; ++j) p[j] = hh ? tt[16 * s + 8 * (j >> 2) + 4 + (j & 3)] : tt[16 * s + 8 * (j >> 2) + (j & 3)];
            u32x4 wp; wp.x = pk2(p[0], p[1]); wp.y = pk2(p[2], p[3]); wp.z = pk2(p[4], p[5]); wp.w = pk2(p[6], p[7]);
            const bf16x8 fTp = __builtin_bit_cast(bf16x8, wp);
            a2t0 = mfma32(*(const LAS bf16x8*)(wl + lane * 96 + 32 + 16 * s), fTp, a2t0); a2t1 = mfma32(*(const LAS bf16x8*)(wl + lane * 96 + 64 + 16 * s), fTp, a2t1);
            n2t = mfma32(*(const LAS bf16x8*)(wl + lane * 96 + 16 * s), fTp, n2t);
        }
#pragma unroll
        for (int g = 0; g < 4; ++g) {
            u32x2 w0; w0.x = pk2(a2t0[4 * g], a2t0[4 * g + 1]); w0.y = pk2(a2t0[4 * g + 2], a2t0[4 * g + 3]);
            u32x2 w1; w1.x = pk2(a2t1[4 * g], a2t1[4 * g + 1]); w1.y = pk2(a2t1[4 * g + 2], a2t1[4 * g + 3]);
            *(u32x2*)(pk + PK_A2 + (g * 64 + lane) * 8) = w0;
            *(u32x2*)(pk + PK_A2 + 2048 + (g * 64 + lane) * 8) = w1;
            u32x2 w2; w2.x = pk2(n2t[4 * g], n2t[4 * g + 1]); w2.y = pk2(n2t[4 * g + 2], n2t[4 * g + 3]);
            *(u32x2*)(pk + PK_N2 + (g * 64 + lane) * 8) = w2;
        }
        LDS_WAIT(); asm volatile("" ::: "memory");
    }
}

constexpr int SC_OBUF = 4 * PK_BYTES, SC_BON = SC_OBUF + 2 * 8192;
template <int DBGMODE = 0> __device__ __forceinline__ void rwscan2_phase(Frame& F, const Args& args, bf16_t* OG, const int nbatch) {
    const int bx = F.bx;
    if (bx >= nbatch * NH) {
        if (bx >= 128) { const size_t w = (size_t)(bx - 128) * NTHREADS + F.tid, nw = (size_t)(F.G - 128) * NTHREADS;
            cvt_stream_fp8(args.in[30] + (size_t)16384 * D, F.ws + WS_UB1, (size_t)16384 * D / 16, w, nw, U_SCALE); cvt_stream_fp8(args.in[31] + (size_t)16384 * D, F.ws + WS_VB1, (size_t)16384 * D / 16, w, nw, V_SCALE); }
        return; }
    const int b = bx >> 4, h = bx & 15, lane = F.lane, r = lane & 31, hh = lane >> 5, wave = F.wave;
    const bf16_t* Vt_ = (const bf16_t*)(F.ws + WS_V); const bf16_t* G = (const bf16_t*)(F.ws + WS_G);
    const unsigned char* pk0 = pack_ptr(F.ws, F.out, b, h * RW_NCH);
    LAS unsigned char* lds = F.lds;
    const int dp0 = wave == 6 ? 0 : 14, dpn = wave == 6 ? 14 : 13;
#define SC_DMA(chunk) do { const unsigned char* src_ = pk0 + (size_t)(chunk) * PK_BYTES + lane * 16; LAS unsigned char* dst_ = lds + ((chunk) & 3) * PK_BYTES; \
        _Pragma("unroll") for (int p_ = 0; p_ < 14; ++p_) if (p_ < dpn) __builtin_amdgcn_global_load_lds((const unsigned*)(src_ + (dp0 + p_) * 1024), (LAS unsigned*)(dst_ + (dp0 + p_) * 1024), 16, 0, 0); } while (0)
#define SC_WAIT(k) do { if (wave == 6) { if ((k) == 2) asm volatile("s_waitcnt vmcnt(28)" ::: "memory"); else if ((k) == 1) asm volatile("s_waitcnt vmcnt(14)" ::: "memory"); else asm volatile("s_waitcnt vmcnt(0)" ::: "memory"); } \
        else { if ((k) == 2) asm volatile("s_waitcnt vmcnt(26)" ::: "memory"); else if ((k) == 1) asm volatile("s_waitcnt vmcnt(13)" ::: "memory"); else asm volatile("s_waitcnt vmcnt(0)" ::: "memory"); } } while (0)
    f32x16 Z0 = F16ZERO, Z1 = F16ZERO;
    const int eu0 = ((wave - 2) & 3) * 64 + lane, eu1 = eu0 + 256;
    u32x2 ev0 = {0u, 0u}, eg0 = ev0, ev1 = ev0, eg1 = ev0; f32x4 elg0 = {0.f, 0.f, 0.f, 0.f}, elb0 = elg0, elg1 = elg0, elb1 = elg0;
    if (wave >= 2 && wave < 6) { elg0 = *(const f32x4*)(args.in[25] + h * 64 + 4 * (eu0 & 15)); elb0 = *(const f32x4*)(args.in[26] + h * 64 + 4 * (eu0 & 15)); elg1 = *(const f32x4*)(args.in[25] + h * 64 + 4 * (eu1 & 15)); elb1 = *(const f32x4*)(args.in[26] + h * 64 + 4 * (eu1 & 15)); }
    if (wave >= 6) { SC_DMA(0); SC_DMA(1); SC_DMA(2); SC_WAIT(2); }
    asm volatile("" ::: "memory"); __builtin_amdgcn_s_barrier(); asm volatile("" ::: "memory");
    for (int c = 0; c <= RW_NCH; ++c) {
        if (wave >= 6) {
            if (DBGMODE == 1) {} else
            if (c + 3 < RW_NCH) { SC_DMA(c + 3); SC_WAIT(2); } else if (c + 2 < RW_NCH) { SC_WAIT(1); } else { SC_WAIT(0); }
        } else if (wave < 2) {
            if (c < RW_NCH && DBGMODE != 2) {
                const LAS unsigned char* sl = lds + (c & 3) * PK_BYTES; const int vh = wave;
                const bf16x8 zb0 = frag_acc(Z0, 0), zb1 = frag_acc(Z0, 1), zb2 = frag_acc(Z1, 0), zb3 = frag_acc(Z1, 1);
#define FR_ACC(off, s_) ({ const u32x2 lo_ = *(const LAS u32x2*)(sl + (off) + ((2 * (s_)) * 64 + lane) * 8), hi_ = *(const LAS u32x2*)(sl + (off) + ((2 * (s_) + 1) * 64 + lane) * 8); __builtin_bit_cast(bf16x8, (u32x4){lo_.x, lo_.y, hi_.x, hi_.y}); })
#define FR_NAT(off, rowbytes, row_, s_) ({ const u32x2 lo_ = *(const LAS u32x2*)(sl + (off) + (row_) * (rowbytes) + 2 * (16 * (s_) + 4 * hh)), hi_ = *(const LAS u32x2*)(sl + (off) + (row_) * (rowbytes) + 2 * (16 * (s_) + 8 + 4 * hh)); __builtin_bit_cast(bf16x8, (u32x4){lo_.x, lo_.y, hi_.x, hi_.y}); })
                const bf16x8 vt0 = FR_NAT(PK_VT, 64, 32 * vh + r, 0), vt1 = FR_NAT(PK_VT, 64, 32 * vh + r, 1);
                f32x16 U = F16ZERO, O = F16ZERO;
                U = mfma32(FR_ACC(PK_A2, 0), zb0, U); U = mfma32(FR_ACC(PK_A2, 1), zb1, U); U = mfma32(FR_ACC(PK_A2 + 2048, 0), zb2, U); U = mfma32(FR_ACC(PK_A2 + 2048, 1), zb3, U);
                U = mfma32(FR_ACC(PK_N2, 0), vt0, U); U = mfma32(FR_ACC(PK_N2, 1), vt1, U);
                O = mfma32(FR_NAT(PK_RT, 128, r, 0), zb0, O); O = mfma32(FR_NAT(PK_RT, 128, r, 1), zb1, O); O = mfma32(FR_NAT(PK_RT, 128, r, 2), zb2, O); O = mfma32(FR_NAT(PK_RT, 128, r, 3), zb3, O);
                O = mfma32(FR_ACC(PK_MKR, 0), vt0, O); O = mfma32(FR_ACC(PK_MKR, 1), vt1, O);
                const bf16x8 ub0 = frag_acc(U, 0), ub1 = frag_acc(U, 1);
                O = mfma32(FR_ACC(PK_MBR, 0), ub0, O); O = mfma32(FR_ACC(PK_MBR, 1), ub1, O);
#pragma unroll
                for (int g = 0; g < 4; ++g) { const f32x4 g0 = *(const LAS f32x4*)(sl + PK_GL + 4 * (8 * g + 4 * hh)), g1 = *(const LAS f32x4*)(sl + PK_GL + 4 * (32 + 8 * g + 4 * hh));
#pragma unroll
                    for (int d = 0; d < 4; ++d) { Z0[4 * g + d] *= g0[d]; Z1[4 * g + d] *= g1[d]; } }
                Z0 = mfma32(FR_ACC(PK_BH, 0), ub0, Z0); Z0 = mfma32(FR_ACC(PK_BH, 1), ub1, Z0); Z0 = mfma32(FR_ACC(PK_KH, 0), vt0, Z0); Z0 = mfma32(FR_ACC(PK_KH, 1), vt1, Z0);
                Z1 = mfma32(FR_ACC(PK_BH + 2048, 0), ub0, Z1); Z1 = mfma32(FR_ACC(PK_BH + 2048, 1), ub1, Z1); Z1 = mfma32(FR_ACC(PK_KH + 2048, 0), vt0, Z1); Z1 = mfma32(FR_ACC(PK_KH + 2048, 1), vt1, Z1);
#undef FR_ACC
#undef FR_NAT
                LAS float* ob = (LAS float*)(lds + SC_OBUF + (c & 1) * 8192);
#pragma unroll
                for (int reg = 0; reg < 16; ++reg) ob[((reg & 3) + 8 * (reg >> 2) + 4 * hh) * 64 + 32 * vh + r] = O[reg];
                if (vh == 0 && lane < 32) ((LAS float*)(lds + SC_BON))[(c & 1) * 32 + lane] = *(const LAS float*)(sl + PK_BON + lane * 4);
            }
        } else {
            u32x2 nv0 = ev0, ng0 = eg0, nv1 = ev1, ng1 = eg1;
            if (c < RW_NCH) { const size_t o0 = ((size_t)b * S + (size_t)c * RWL + (eu0 >> 4)) * D + h * 64 + 4 * (eu0 & 15), o1 = ((size_t)b * S + (size_t)c * RWL + (eu1 >> 4)) * D + h * 64 + 4 * (eu1 & 15);
                nv0 = *(const u32x2*)(Vt_ + o0); ng0 = *(const u32x2*)(G + o0); nv1 = *(const u32x2*)(Vt_ + o1); ng1 = *(const u32x2*)(G + o1); }
            if (c >= 1 && DBGMODE != 3) {
                const LAS float* ob = (const LAS float*)(lds + SC_OBUF + ((c - 1) & 1) * 8192); const LAS float* bn = (const LAS float*)(lds + SC_BON) + ((c - 1) & 1) * 32;
#pragma unroll
                for (int k2 = 0; k2 < 2; ++k2) { const int u = k2 ? eu1 : eu0, t = u >> 4, q = u & 15, c4 = h * 64 + 4 * q; const size_t off = ((size_t)b * S + (size_t)(c - 1) * RWL + t) * D + c4;
                    const f32x4 o4 = *(const LAS f32x4*)(ob + t * 64 + 4 * q); const float bs = bn[t];
                    const u32x2 vw = k2 ? ev1 : ev0, gw_ = k2 ? eg1 : eg0; const f32x4 lg4 = k2 ? elg1 : elg0, lb4 = k2 ? elb1 : elb0;
                    float sm = (o4.x + o4.y) + (o4.z + o4.w); sm = sum16(sm); const float mu = sm * (1.f / 64.f); const f32x4 dd = o4 - mu;
                    float vs = (dd.x * dd.x + dd.y * dd.y) + (dd.z * dd.z + dd.w * dd.w); vs = sum16(vs); const float rs = 1.f / sqrtf(vs * (1.f / 64.f) + 64e-5f);
                    const f32x4 v4 = {bf_lo(vw.x), bf_hi(vw.x), bf_lo(vw.y), bf_hi(vw.y)}, g4 = {bf_lo(gw_.x), bf_hi(gw_.x), bf_lo(gw_.y), bf_hi(gw_.y)};
                    const f32x4 res = (dd * rs * lg4 + lb4 + v4 * bs) * g4;
                    u32x2 w; w.x = pk2(res.x, res.y); w.y = pk2(res.z, res.w); *(u32x2*)(OG + off) = w; }
            }
            ev0 = nv0; eg0 = ng0; ev1 = nv1; eg1 = ng1;
        }
        asm volatile("s_waitcnt lgkmcnt(0)" ::: "memory");
        __builtin_amdgcn_s_barrier();
        asm volatile("" ::: "memory");
    }
#undef SC_DMA
#undef SC_WAIT
}
}
namespace mk {
constexpr int NPH = 26;
#ifndef MK_NBATCH
#define MK_NBATCH 8
#endif
#ifndef MK_MASK
#define MK_MASK 0xFFFFFFFFull
#endif
#ifndef MK_REP
#define MK_REP 0ull
#endif
#ifndef MK_NREP
#define MK_NREP 2
#endif
#ifndef MK_SCANDBG
#define MK_SCANDBG 0
#endif
__global__ void __launch_bounds__(NTHREADS, 2) mk_fwd(Args args) {
    extern __shared__ __attribute__((aligned(16))) unsigned char lds_raw[];
    { volatile LAS unsigned* M0 = (volatile LAS unsigned*)((LAS unsigned char*)lds_raw + MISC_OFF); if (threadIdx.x < 64) M0[threadIdx.x] = 0u; }
    __syncthreads();
    const int lo = args.ph_lo, hi = args.ph_hi;
    const int wave0 = __builtin_amdgcn_readfirstlane((int)threadIdx.x >> 6);
    if (hi - lo > 1) (void)xcd_barrier_post((unsigned*)(args.ws + WS_CTL) + CW_BAR, (volatile LAS unsigned*)((LAS unsigned char*)lds_raw + MISC_OFF) + 8);
#define MKFRAME() \
        int lane_ = lane_id(), bx_ = blockIdx.x; asm volatile("" : "+v"(lane_)); asm volatile("" : "+s"(bx_)); \
        Frame F; F.lds = (LAS unsigned char*)lds_raw; F.MISC = (volatile LAS unsigned*)(F.lds + MISC_OFF); \
        F.lane = lane_; F.wave = wave0; F.tid = wave0 * 64 + lane_; F.bx = bx_; \
        F.G = gridDim.x; F.vcu = (F.G % 8 == 0) ? (bx_ % 8) * (F.G / 8) + bx_ / 8 : bx_; \
        F.gw = F.vcu * NWAVES + F.wave; F.NGW = F.G * NWAVES; \
        F.ws = args.ws; F.ctl = (unsigned*)(args.ws + WS_CTL); F.out = args.out; unsigned char* ws = F.ws; (void)ws;
#define INP(k) (args.in[k])
#define IN(k) (((MK_MASK >> (k)) & 1) && lo <= (k) && (k) < hi)
#define FORCE_BAR() do { XcdBarrier bar; bar.bar = (unsigned*)(args.ws + WS_CTL) + CW_BAR; bar.x = xb_xcc_id(); bar.st = (volatile LAS unsigned*)((LAS unsigned char*)lds_raw + MISC_OFF) + 8; xcd_barrier(bar, wave0 == 0 && lane_id() == 0); } while (0)
#define SEAM(k) do { if (lo <= (k) && (k) + 1 < hi) FORCE_BAR(); } while (0)
    if (IN(0)) { MKFRAME() asm volatile("; PHASE_BEGIN 0"); p0_prologue(F, args); }
    SEAM(0);
    if (((MK_REP >> 0) & 1) && IN(0)) { for (int rep_ = 0; rep_ < MK_NREP; ++rep_) { { MKFRAME() p0_prologue(F, args); } FORCE_BAR(); } }
    if (IN(1)) { MKFRAME() asm volatile("; PHASE_BEGIN 1"); { ProbPlain P{(const char*)(ws + WS_X0B), (const char*)(ws + WS_WIN), (size_t)256 * D * 2, (size_t)256 * D * 2}; EpiWin E{(bf16_t*)(ws + WS_GATE), (bf16_t*)(ws + WS_H2)}; run_gemm(F, 64, 11, D, D, D, P, E); } }
    SEAM(1);
    if (((MK_REP >> 1) & 1) && IN(1)) { for (int rep_ = 0; rep_ < MK_NREP; ++rep_) { { MKFRAME() { ProbPlain P{(const char*)(ws + WS_X0B), (const char*)(ws + WS_WIN), (size_t)256 * D * 2, (size_t)256 * D * 2}; EpiWin E{(bf16_t*)(ws + WS_GATE), (bf16_t*)(ws + WS_H2)}; run_gemm(F, 64, 11, D, D, D, P, E); } } FORCE_BAR(); } }
    if (IN(2)) { MKFRAME() asm volatile("; PHASE_BEGIN 2"); conv_phase(F, INP(2), INP(3)); }
    SEAM(2);
    if (((MK_REP >> 2) & 1) && IN(2)) { for (int rep_ = 0; rep_ < MK_NREP; ++rep_) { { MKFRAME() conv_phase(F, INP(2), INP(3)); } FORCE_BAR(); } }
    if (IN(3)) { MKFRAME() asm volatile("; PHASE_BEGIN 3"); { ProbGates P{(const char*)(ws + WS_XC), (const char*)(ws + WS_WG)}; EpiGates E{(const bf16_t*)(ws + WS_XC), (const float*)(ws + WS_VEC), INP(5), INP(7), (bf16_t*)(ws + WS_A), (bf16_t*)(ws + WS_U)}; run_gemm(F, 64, 11, W, 384, 384, P, E); } }
    SEAM(3);
    if (((MK_REP >> 3) & 1) && IN(3)) { for (int rep_ = 0; rep_ < MK_NREP; ++rep_) { { MKFRAME() { ProbGates P{(const char*)(ws + WS_XC), (const char*)(ws + WS_WG)}; EpiGates E{(const bf16_t*)(ws + WS_XC), (const float*)(ws + WS_VEC), INP(5), INP(7), (bf16_t*)(ws + WS_A), (bf16_t*)(ws + WS_U)}; run_gemm(F, 64, 11, W, 384, 384, P, E); } } FORCE_BAR(); } }
    if (IN(4)) { MKFRAME() asm volatile("; PHASE_BEGIN 4"); rgscan1_phase(F); }
    SEAM(4);
    if (((MK_REP >> 4) & 1) && IN(4)) { for (int rep_ = 0; rep_ < MK_NREP; ++rep_) { { MKFRAME() rgscan1_phase(F); } FORCE_BAR(); } }
    if (IN(5)) { MKFRAME() asm volatile("; PHASE_BEGIN 5"); rgscan2_phase(F); }
    SEAM(5);
    if (((MK_REP >> 5) & 1) && IN(5)) { for (int rep_ = 0; rep_ < MK_NREP; ++rep_) { { MKFRAME() rgscan2_phase(F); } FORCE_BAR(); } }
    if (IN(6)) { MKFRAME() asm volatile("; PHASE_BEGIN 6"); { ProbPlain P{(const char*)(ws + WS_Y), (const char*)(ws + WS_WOUT), (size_t)256 * W * 2, (size_t)256 * W * 2}; EpiRes E{INP(0), (float*)(ws + WS_Z0)}; run_gemm(F, 64, 4, W, W, W, P, E); } }
    SEAM(6);
    if (((MK_REP >> 6) & 1) && IN(6)) { for (int rep_ = 0; rep_ < MK_NREP; ++rep_) { { MKFRAME() { ProbPlain P{(const char*)(ws + WS_Y), (const char*)(ws + WS_WOUT), (size_t)256 * W * 2, (size_t)256 * W * 2}; EpiRes E{INP(0), (float*)(ws + WS_Z0)}; run_gemm(F, 64, 4, W, W, W, P, E); } } FORCE_BAR(); } }
    if (IN(7)) { MKFRAME() asm volatile("; PHASE_BEGIN 7"); ln_phase(F, (const float*)(ws + WS_Z0), INP(32), INP(33), (float*)(ws + WS_XF), (bf16_t*)(ws + WS_XB0)); }
    SEAM(7);
    if (((MK_REP >> 7) & 1) && IN(7)) { for (int rep_ = 0; rep_ < MK_NREP; ++rep_) { { MKFRAME() ln_phase(F, (const float*)(ws + WS_Z0), INP(32), INP(33), (float*)(ws + WS_XF), (bf16_t*)(ws + WS_XB0)); } FORCE_BAR(); } }
    if (IN(8)) { MKFRAME() asm volatile("; PHASE_BEGIN 8"); { ProbPlain P{(const char*)(ws + WS_XB0), (const char*)(ws + WS_WPEER), (size_t)256 * D * 2, (size_t)256 * D * 2}; EpiScores E{(float*)(ws + WS_SC0)}; run_gemm(F, 64, 8, D, D, D, P, E); } }
    SEAM(8);
    if (((MK_REP >> 8) & 1) && IN(8)) { for (int rep_ = 0; rep_ < MK_NREP; ++rep_) { { MKFRAME() { ProbPlain P{(const char*)(ws + WS_XB0), (const char*)(ws + WS_WPEER), (size_t)256 * D * 2, (size_t)256 * D * 2}; EpiScores E{(float*)(ws + WS_SC0)}; run_gemm(F, 64, 8, D, D, D, P, E); } } FORCE_BAR(); } }
    if (IN(9)) { MKFRAME() asm volatile("; PHASE_BEGIN 9"); topk_phase(F, (const float*)(ws + WS_SC0), (int*)(ws + WS_EID0), (float*)(ws + WS_GW0)); }
    SEAM(9);
    if (((MK_REP >> 9) & 1) && IN(9)) { for (int rep_ = 0; rep_ < MK_NREP; ++rep_) { { MKFRAME() topk_phase(F, (const float*)(ws + WS_SC0), (int*)(ws + WS_EID0), (float*)(ws + WS_GW0)); } FORCE_BAR(); } }
    if (IN(10)) { MKFRAME() asm volatile("; PHASE_BEGIN 10"); gu_phase(F, (const float*)(ws + WS_XF), (const int*)(ws + WS_EID0), (float*)(ws + WS_PART0), ws + WS_UB); }
    SEAM(10);
    if (((MK_REP >> 10) & 1) && IN(10)) { for (int rep_ = 0; rep_ < MK_NREP; ++rep_) { { MKFRAME() gu_phase(F, (const float*)(ws + WS_XF), (const int*)(ws + WS_EID0), (float*)(ws + WS_PART0), ws + WS_UB); } FORCE_BAR(); } }
    if (IN(11)) { MKFRAME() asm volatile("; PHASE_BEGIN 11"); gr_phase(F, (const float*)(ws + WS_PART0), (float*)(ws + WS_GW0)); }
    SEAM(11);
    if (IN(12)) { MKFRAME() asm volatile("; PHASE_BEGIN 12"); gv_phase(F, (const float*)(ws + WS_XF), (const int*)(ws + WS_EID0), (const float*)(ws + WS_GW0), (float*)(ws + WS_ZP0), ws + WS_VB); }
    SEAM(12);
    if (((MK_REP >> 12) & 1) && IN(12)) { for (int rep_ = 0; rep_ < MK_NREP; ++rep_) { { MKFRAME() gv_phase(F, (const float*)(ws + WS_XF), (const int*)(ws + WS_EID0), (const float*)(ws + WS_GW0), (float*)(ws + WS_ZP0), ws + WS_VB); } FORCE_BAR(); } }
    if (IN(13)) { MKFRAME() asm volatile("; PHASE_BEGIN 13"); lnmix_phase(F, (const float*)(ws + WS_ZP0), INP(32) + D, INP(33) + D, (float*)(ws + WS_XF), INP(10), (bf16_t*)(ws + WS_MIX)); }
    SEAM(13);
    if (((MK_REP >> 13) & 1) && IN(13)) { for (int rep_ = 0; rep_ < MK_NREP; ++rep_) { { MKFRAME() lnmix_phase(F, (const float*)(ws + WS_ZP0), INP(32) + D, INP(33) + D, (float*)(ws + WS_XF), INP(10), (bf16_t*)(ws + WS_MIX)); } FORCE_BAR(); } }
    if (IN(14)) { MKFRAME() asm volatile("; PHASE_BEGIN 14"); { ProbRkv P{(const char*)(ws + WS_MIX), (const char*)(ws + WS_WRKV)}; EpiRkv E{(bf16_t*)(ws + WS_R), (bf16_t*)(ws + WS_LORA)}; run_gemm(F, 64, 15, D, D, D, P, E); } }
    SEAM(14);
    if (((MK_REP >> 14) & 1) && IN(14)) { for (int rep_ = 0; rep_ < MK_NREP; ++rep_) { { MKFRAME() { ProbRkv P{(const char*)(ws + WS_MIX), (const char*)(ws + WS_WRKV)}; EpiRkv E{(bf16_t*)(ws + WS_R), (bf16_t*)(ws + WS_LORA)}; run_gemm(F, 64, 15, D, D, D, P, E); } } FORCE_BAR(); } }
    if (IN(15)) { MKFRAME() asm volatile("; PHASE_BEGIN 15"); { ProbPlain P{(const char*)(ws + WS_LORA), (const char*)(ws + WS_WL2), (size_t)256 * 256 * 2, (size_t)256 * 256 * 2}; EpiLora2 E{(float*)(ws + WS_WDEC), (bf16_t*)(ws + WS_AA), INP(14), INP(17)}; static_assert(WS_G == WS_AA + (size_t)T * D * 2, "g follows aa"); run_gemm(F, 64, 12, 256, 256, 256, P, E); } }
    SEAM(15);
    if (((MK_REP >> 15) & 1) && IN(15)) { for (int rep_ = 0; rep_ < MK_NREP; ++rep_) { { MKFRAME() { ProbPlain P{(const char*)(ws + WS_LORA), (const char*)(ws + WS_WL2), (size_t)256 * 256 * 2, (size_t)256 * 256 * 2}; EpiLora2 E{(float*)(ws + WS_WDEC), (bf16_t*)(ws + WS_AA), INP(14), INP(17)}; static_assert(WS_G == WS_AA + (size_t)T * D * 2, "g follows aa"); run_gemm(F, 64, 12, 256, 256, 256, P, E); } } FORCE_BAR(); } }
    if (((MK_REP >> 16) & 1) && IN(16)) { for (int rep_ = 0; rep_ < MK_NREP; ++rep_) { { MKFRAME() rwprep_phase<MK_SCANDBG>(F, args, MK_NBATCH); } FORCE_BAR(); } }
    if (IN(16)) { MKFRAME() asm volatile("; PHASE_BEGIN 16"); rwprep_phase(F, args, MK_NBATCH); }
    SEAM(16);
    if (IN(17)) { MKFRAME() asm volatile("; PHASE_BEGIN 17"); rwscan2_phase(F, args, (bf16_t*)(ws + WS_OG), MK_NBATCH); }
    SEAM(17);
    if (((MK_REP >> 17) & 1) && IN(17)) { for (int rep_ = 0; rep_ < MK_NREP; ++rep_) { { MKFRAME() rwscan2_phase<MK_SCANDBG>(F, args, (bf16_t*)(ws + WS_XB1), MK_NBATCH); } FORCE_BAR(); } }
    if (IN(18)) { MKFRAME() asm volatile("; PHASE_BEGIN 18"); { ProbPlain P{(const char*)(ws + WS_OG), (const char*)(ws + WS_WO), (size_t)256 * D * 2, (size_t)256 * D * 2}; EpiRes E{(const float*)(ws + WS_XF), (float*)(ws + WS_Z1)}; run_gemm(F, 64, 4, D, D, D, P, E); } }
    SEAM(18);
    if (((MK_REP >> 18) & 1) && IN(18)) { for (int rep_ = 0; rep_ < MK_NREP; ++rep_) { { MKFRAME() { ProbPlain P{(const char*)(ws + WS_OG), (const char*)(ws + WS_WO), (size_t)256 * D * 2, (size_t)256 * D * 2}; EpiRes E{(const float*)(ws + WS_XF), (float*)(ws + WS_Z1)}; run_gemm(F, 64, 4, D, D, D, P, E); } } FORCE_BAR(); } }
    if (IN(19)) { MKFRAME() asm volatile("; PHASE_BEGIN 19"); ln_phase(F, (const float*)(ws + WS_Z1), INP(32) + 2 * D, INP(33) + 2 * D, (float*)(ws + WS_XF), (bf16_t*)(ws + WS_XB1)); }
    SEAM(19);
    if (((MK_REP >> 19) & 1) && IN(19)) { for (int rep_ = 0; rep_ < MK_NREP; ++rep_) { { MKFRAME() ln_phase(F, (const float*)(ws + WS_Z1), INP(32) + 2 * D, INP(33) + 2 * D, (float*)(ws + WS_XF), (bf16_t*)(ws + WS_XB1)); } FORCE_BAR(); } }
    if (IN(20)) { MKFRAME() asm volatile("; PHASE_BEGIN 20"); { ProbPlain P{(const char*)(ws + WS_XB1), (const char*)(ws + WS_WPEER + (size_t)2048 * D * 2), (size_t)256 * D * 2, (size_t)256 * D * 2}; EpiScores E{(float*)(ws + WS_SC1)}; run_gemm(F, 64, 8, D, D, D, P, E); } }
    SEAM(20);
    if (((MK_REP >> 20) & 1) && IN(20)) { for (int rep_ = 0; rep_ < MK_NREP; ++rep_) { { MKFRAME() { ProbPlain P{(const char*)(ws + WS_XB1), (const char*)(ws + WS_WPEER + (size_t)2048 * D * 2), (size_t)256 * D * 2, (size_t)256 * D * 2}; EpiScores E{(float*)(ws + WS_SC1)}; run_gemm(F, 64, 8, D, D, D, P, E); } } FORCE_BAR(); } }
    if (IN(21)) { MKFRAME() asm volatile("; PHASE_BEGIN 21"); topk_phase(F, (const float*)(ws + WS_SC1), (int*)(ws + WS_EID1), (float*)(ws + WS_GW1)); }
    SEAM(21);
    if (((MK_REP >> 21) & 1) && IN(21)) { for (int rep_ = 0; rep_ < MK_NREP; ++rep_) { { MKFRAME() topk_phase(F, (const float*)(ws + WS_SC1), (int*)(ws + WS_EID1), (float*)(ws + WS_GW1)); } FORCE_BAR(); } }
    if (IN(22)) { MKFRAME() asm volatile("; PHASE_BEGIN 22"); gu_phase(F, (const float*)(ws + WS_XF), (const int*)(ws + WS_EID1), (float*)(ws + WS_PART1), ws + WS_UB1); }
    SEAM(22);
    if (((MK_REP >> 22) & 1) && IN(22)) { for (int rep_ = 0; rep_ < MK_NREP; ++rep_) { { MKFRAME() gu_phase(F, (const float*)(ws + WS_XF), (const int*)(ws + WS_EID1), (float*)(ws + WS_PART1), ws + WS_UB1); } FORCE_BAR(); } }
    if (IN(23)) { MKFRAME() asm volatile("; PHASE_BEGIN 23"); gr_phase(F, (const float*)(ws + WS_PART1), (float*)(ws + WS_GW1)); }
    SEAM(23);
    if (IN(24)) { MKFRAME() asm volatile("; PHASE_BEGIN 24"); gv_phase(F, (const float*)(ws + WS_XF), (const int*)(ws + WS_EID1), (const float*)(ws + WS_GW1), (float*)(ws + WS_ZP1), ws + WS_VB1); }
    SEAM(24);
    if (((MK_REP >> 24) & 1) && IN(24)) { for (int rep_ = 0; rep_ < MK_NREP; ++rep_) { { MKFRAME() gv_phase(F, (const float*)(ws + WS_XF), (const int*)(ws + WS_EID1), (const float*)(ws + WS_GW1), (float*)(ws + WS_ZP1), ws + WS_VB1); } FORCE_BAR(); } }
    if (IN(25)) { MKFRAME() asm volatile("; PHASE_BEGIN 25"); ln_phase(F, (const float*)(ws + WS_ZP1), INP(32) + 3 * D, INP(33) + 3 * D, F.out, (bf16_t*)nullptr); }
    SEAM(25);
    if (((MK_REP >> 25) & 1) && IN(25)) { for (int rep_ = 0; rep_ < MK_NREP; ++rep_) { { MKFRAME() ln_phase(F, (const float*)(ws + WS_ZP1), INP(32) + 3 * D, INP(33) + 3 * D, F.out, (bf16_t*)nullptr); } FORCE_BAR(); } }
#undef INP
#undef IN
#undef SEAM
#undef FORCE_BAR
#undef MKFRAME
}

static int g_grid = 0;
static inline bool mk_setup() {
    if (g_grid == 0) {
        int dev = 0, cus = 0;
        if (hipGetDevice(&dev) != hipSuccess || hipDeviceGetAttribute(&cus, hipDeviceAttributeMultiprocessorCount, dev) != hipSuccess) { g_grid = -1; return false; }
        if (hipFuncSetAttribute((const void*)mk_fwd, hipFuncAttributeMaxDynamicSharedMemorySize, LDS_BYTES) != hipSuccess) { fprintf(stderr, "hipFuncSetAttribute failed\n"); g_grid = -1; return false; }
        (void)hipGetLastError();
        g_grid = cus;
        if (g_grid != 256) fprintf(stderr, "warning: %d CUs (kernel assumes 256 workgroups)\n", g_grid);
    }
    return g_grid > 0;
}
static inline void mk_launch(hipStream_t stream, void* const* d_in, void* d_out, void* d_ws, int lo, int hi) {
    Args a{};
    for (int i = 0; i < 34; ++i) a.in[i] = (const float*)d_in[i];
    a.out = (float*)d_out; a.ws = (unsigned char*)d_ws; a.ph_lo = lo; a.ph_hi = hi;
    hipLaunchKernelGGL(mk_fwd, dim3(g_grid), dim3(NTHREADS), LDS_BYTES, stream, a);
}
}
extern "C" void kernel_launch(void* const* d_in, const int* in_sizes, int n_in, void* d_out, int out_size, void* d_ws, size_t ws_size, hipStream_t stream) {
    (void)in_sizes; (void)n_in; (void)out_size;
    if (!mk::mk_setup()) return;
    if (ws_size < mk::WS_END) { fprintf(stderr, "workspace too small: %zu\n", ws_size); return; }
    (void)hipMemsetAsync((char*)d_ws + mk::WS_CTL, 0, mk::CTL_ZERO_BYTES, stream);
#if MK_PER_PHASE
    for (int p = 0; p < mk::NPH; ++p) mk::mk_launch(stream, d_in, d_out, d_ws, p, p + 1);
#else
    mk::mk_launch(stream, d_in, d_out, d_ws, 0, mk::NPH);
#endif
}
```

```cpp
#include <hip/hip_runtime.h>
#include <cstdio>
#include <cstdint>

#define LAS __attribute__((address_space(3)))
#define GAS __attribute__((address_space(1)))
typedef unsigned short bf16_t;
typedef short bf16x8 __attribute__((ext_vector_type(8)));
typedef float f32x4 __attribute__((ext_vector_type(4)));
typedef float f32x2 __attribute__((ext_vector_type(2)));
typedef unsigned u32x4 __attribute__((ext_vector_type(4)));
typedef unsigned u32x2 __attribute__((ext_vector_type(2)));
typedef __bf16 bf16x2_t __attribute__((ext_vector_type(2)));

typedef float f32x16 __attribute__((ext_vector_type(16)));
#define F16ZERO (f32x16){0.f,0.f,0.f,0.f,0.f,0.f,0.f,0.f,0.f,0.f,0.f,0.f,0.f,0.f,0.f,0.f}
namespace mk {
__device__ __forceinline__ f32x16 mfma32(bf16x8 a, bf16x8 b, f32x16 c) { return __builtin_amdgcn_mfma_f32_32x32x16_bf16(a, b, c, 0, 0, 0); }
constexpr int D = 1024, NB = 8, S = 2048, T = NB * S, W = 1408, NH = 16, HB = 88;
constexpr float ALPHA = 1.41421356237f, LN_EPS = 1e-5f;
constexpr int NWAVES = 8, NTHREADS = 512;

__device__ __forceinline__ unsigned f2bf(float f) { unsigned u = __builtin_bit_cast(unsigned, f); return (u + 0x7fffu + ((u >> 16) & 1u)) >> 16; }
__device__ __forceinline__ unsigned pk2(float lo, float hi) { return f2bf(lo) | (f2bf(hi) << 16); }
__device__ __forceinline__ float bf_lo(unsigned w) { return __builtin_bit_cast(float, w << 16); }
__device__ __forceinline__ float bf_hi(unsigned w) { return __builtin_bit_cast(float, w & 0xffff0000u); }
__device__ __forceinline__ float ldbf(const bf16_t* p) { return __builtin_bit_cast(float, ((unsigned)*p) << 16); }
__device__ __forceinline__ unsigned cvt_pk_bf16(float lo, float hi) { unsigned r; asm volatile("v_cvt_pk_bf16_f32 %0, %1, %2" : "=v"(r) : "v"(lo), "v"(hi)); return r; }
__device__ __forceinline__ unsigned cvt_pk_bf16_c(float lo, float hi) { f32x2 v = {lo, hi}; bf16x2_t b = __builtin_convertvector(v, bf16x2_t); return __builtin_bit_cast(unsigned, b); }
__device__ __forceinline__ float fast_exp(float x) { return __builtin_amdgcn_exp2f(x * 1.44269504089f); }
__device__ __forceinline__ float fast_rcp(float x) { return __builtin_amdgcn_rcpf(x); }
__device__ __forceinline__ float fast_sigmoid(float x) { return fast_rcp(1.f + fast_exp(-x)); }
__device__ __forceinline__ float fast_tanh(float x) { float e = fast_exp(-2.f * fabsf(x)); float t = (1.f - e) * fast_rcp(1.f + e); return x < 0.f ? -t : t; }
__device__ __forceinline__ float gelu_tanh(float x) { const float c = 0.7978845608028654f; float u = c * (x + 0.044715f * x * x * x); return x * fast_sigmoid(2.f * u); }
__device__ __forceinline__ float softplus_f(float x) { return x > 15.f ? x : __logf(1.f + fast_exp(x)); }
__device__ __forceinline__ int lane_id() { return (int)__builtin_amdgcn_mbcnt_hi(~0u, __builtin_amdgcn_mbcnt_lo(~0u, 0u)); }
__device__ __forceinline__ float wave_sum(float v) {
#pragma unroll
    for (int o = 1; o < 64; o <<= 1) v += __shfl_xor(v, o);
    return v;
}
template <int CTRL> __device__ __forceinline__ float dpp_f(float v) { return __builtin_bit_cast(float, __builtin_amdgcn_update_dpp(0, __builtin_bit_cast(int, v), CTRL, 0xf, 0xf, false)); }
#define DPP_QP_1032 0xB1
#define DPP_QP_2301 0x4E
#define DPP_ROW_HALF_MIRROR 0x141
#define DPP_ROW_MIRROR 0x140
#define DPP_ROW_ROR(n) (0x120 + (n))
__device__ __forceinline__ float sum8(float v) { v += dpp_f<DPP_QP_1032>(v); v += dpp_f<DPP_QP_2301>(v); v += dpp_f<DPP_ROW_HALF_MIRROR>(v); return v; }
__device__ __forceinline__ float sum16(float v) { v = sum8(v); v += dpp_f<DPP_ROW_ROR(8)>(v); return v; }

#define XB_TMO      128
#define XB_XCNT(j)  (256  + 64 * (j))
#define XB_XSUB(j)  (1280 + 64 * (j))
#define XB_XGEN(j)  (2304 + 64 * (j))
#define XB_TOP      3328
#define XB_TOPGEN   3392
#define XCD_BAR_WORDS 3456
#define XB_SPIN_CAP (1u << 20)
__device__ __forceinline__ unsigned xb_ld(unsigned* p)              { return __hip_atomic_load(p, __ATOMIC_RELAXED, __HIP_MEMORY_SCOPE_AGENT); }
__device__ __forceinline__ unsigned xb_add(unsigned* p, unsigned v) { return __hip_atomic_fetch_add(p, v, __ATOMIC_RELAXED, __HIP_MEMORY_SCOPE_AGENT); }
__device__ __forceinline__ unsigned xb_xcc_id() { return (unsigned)__builtin_amdgcn_s_getreg((3 << 11) | 20) & 0xFu; }
#define XB_SPIN(cond, bar) do { unsigned _sp = 0; while (cond) { __builtin_amdgcn_s_sleep(1); \
    if ((++_sp & 255u) == 0u) { if (xb_ld(&(bar)[XB_TMO])) break; if (_sp > XB_SPIN_CAP) { atomicAdd(&(bar)[XB_TMO], 1u); break; } } } } while (0)
struct XcdBarrier { unsigned* bar; unsigned x; volatile LAS unsigned* st; };
__device__ __forceinline__ XcdBarrier xcd_barrier_post(unsigned* bar, volatile LAS unsigned* st) {
    XcdBarrier b; b.bar = bar; b.x = xb_xcc_id(); b.st = st;
    if (threadIdx.x == 0) (void)xb_add(&bar[XB_XCNT(b.x)], 1u);
    return b;
}
__device__ __forceinline__ void xcd_barrier_complete(unsigned* bar, unsigned x, unsigned& nloc, unsigned& nx) {
    const unsigned G = gridDim.x * gridDim.y * gridDim.z;
    unsigned sum, cnt, mine, sp = 0u;
    for (;;) {
        sum = 0u; cnt = 0u; mine = 0u;
#pragma unroll
        for (unsigned j = 0; j < 16; ++j) { const unsigned c = xb_ld(&bar[XB_XCNT(j)]); sum += c; cnt += (c > 0u) ? 1u : 0u; mine = (j == x) ? c : mine; }
        if (sum == G) break;
        __builtin_amdgcn_s_sleep(1);
        if ((++sp & 255u) == 0u) { if (xb_ld(&bar[XB_TMO])) break; if (sp > XB_SPIN_CAP) { atomicAdd(&bar[XB_TMO], 1u); break; } }
    }
    nloc = mine > 0u ? mine : 1u; nx = cnt > 0u ? cnt : 1u;
}
__device__ __forceinline__ void xcd_barrier(const XcdBarrier& b, const bool leader) {
    asm volatile("s_waitcnt vmcnt(0)" ::: "memory");
    __syncthreads();
    if (leader) {
        unsigned* bar = b.bar;
        __builtin_amdgcn_s_waitcnt(0);
        unsigned nloc = b.st[0], nx = b.st[1];
        if (nloc == 0u) { xcd_barrier_complete(bar, b.x, nloc, nx); b.st[0] = nloc; b.st[1] = nx; }
        const unsigned old = xb_add(&bar[XB_XSUB(b.x)], 1u);
        const unsigned gen = old / nloc;
        if (old + 1u == (gen + 1u) * nloc) {
            __builtin_amdgcn_fence(__ATOMIC_RELEASE, "agent");
            asm volatile("s_waitcnt vmcnt(0)" ::: "memory");
            const unsigned og = xb_add(&bar[XB_TOP], 1u);
            const unsigned tg = og / nx;
            if (og + 1u == (tg + 1u) * nx) xb_add(&bar[XB_TOPGEN], 1u);
            else XB_SPIN(xb_ld(&bar[XB_TOPGEN]) == tg, bar);
            __builtin_amdgcn_fence(__ATOMIC_ACQUIRE, "agent");
            xb_add(&bar[XB_XGEN(b.x)], 1u);
            asm volatile("s_waitcnt vmcnt(0)" ::: "memory");
        } else {
            XB_SPIN(xb_ld(&bar[XB_XGEN(b.x)]) == gen, bar);
            __builtin_amdgcn_fence(__ATOMIC_ACQUIRE, "agent");
            asm volatile("s_waitcnt vmcnt(0)" ::: "memory");
        }
    }
    __syncthreads();
}

namespace pg8 {
constexpr int BM = 256, BK = 64, HALF = 128, HTB = HALF * BK * 2, STAGE_BYTES = 8 * HTB, NXCD = 8, WGM = 8;
__host__ __device__ __forceinline__ int lds_byte(int r, int c) { const int st = (r >> 4) * 2 + (c >> 5), rr = r & 15, cc = c & 31, ob = rr * 64 + cc * 2; return st * 1024 + (ob ^ (((ob >> 9) & 1) << 5)); }
__host__ __device__ __forceinline__ void stage_rc(int b, int& R, int& C) { const int st = b / 1024, sb = b % 1024, swz = sb ^ (((sb >> 9) & 1) << 5); R = (st >> 1) * 16 + swz / 64; C = (st & 1) * 32 + (swz % 64) / 2; }
__host__ __device__ __forceinline__ int perm32(int rho) { const int n = rho >> 4, i = rho & 15; return 8 * (i >> 2) + 4 * n + (i & 3); }

struct Unit { const char* A; const char* B; int pm, pn; };
template <class P> struct Order {
    int nM, nN, nwg, G, c; P p;
    __device__ __forceinline__ void init(int nM_, int nN_, int G_, int c_, const P& p_) { nM = nM_; nN = nN_; nwg = nM * nN; G = G_; c = c_; p = p_; }
    __device__ __forceinline__ bool next(int i, Unit& u) const {
        const long L = (long)i * G + c; if (L >= nwg) return false;
        int wgid = (int)L; { const int q = nwg / NXCD, r = nwg % NXCD, xcd = wgid % NXCD, off = wgid / NXCD; wgid = (xcd < r ? xcd * (q + 1) : r * (q + 1) + (xcd - r) * q) + off; }
        const int nig = WGM * nN, gid = wgid / nig, fm = gid * WGM, gsz = (nM - fm) < WGM ? (nM - fm) : WGM;
        u.pm = fm + ((wgid % nig) % gsz); u.pn = (wgid % nig) / gsz; p.locate(u); return true;
    }
};

template <class Epi, class Sched, bool ALIGN_EPI, bool SP2>
__device__ __forceinline__ void gemm_phase(LAS unsigned char* lds, const int tid, const int lda, const int ldb, const int K, const Sched& S, const Epi& E) {
    const int wid = __builtin_amdgcn_readfirstlane(tid >> 6), lane = tid & 63, wr = wid >> 2, wc = wid & 3, fr = lane & 15, fq = lane >> 4;
    const int nt = K / BK;
    unsigned voffA[2], voffB[2];
#pragma unroll
    for (int i = 0; i < 2; ++i) { int R, C; stage_rc(tid * 16 + i * 8192, R, C); const int Rb = Epi::PERM ? ((R & ~31) + perm32(R & 31)) : R;
        voffA[i] = (unsigned)(R * lda + C) * 2u; voffB[i] = (unsigned)(Rb * ldb + C) * 2u; }
    const size_t kstep = (size_t)(BK * 2);
    const size_t hstepA = (size_t)HALF * lda * 2, hstepB = (size_t)HALF * ldb * 2;
    const unsigned ldsw = (unsigned)wid * 1024u;
    const int aoff = lds_byte(wr * 64 + fr, fq * 8), boff = lds_byte(wc * 32 + fr, fq * 8);
#define PG8_SA(b, h) (((b) * 2 + (h)) * HTB)
#define PG8_SB(b, h) ((4 + (b) * 2 + (h)) * HTB)
#define PG8_STAGE(bufoff, gbase, voff) do { _Pragma("unroll") for (int _i = 0; _i < 2; ++_i) \
        __builtin_amdgcn_global_load_lds((const unsigned*)((const char*)(gbase) + (voff)[_i]), (LAS unsigned*)(lds + (bufoff) + ldsw + _i * 8192), 16, 0, 0); } while (0)
#define PG8_LDA(dst, b, h) do { _Pragma("unroll") for (int m = 0; m < 4; ++m) _Pragma("unroll") for (int k = 0; k < 2; ++k) dst[m][k] = *(const LAS bf16x8*)(lds + PG8_SA(b, h) + aoff + m * 2048 + k * 1024); } while (0)
#define PG8_LDB(dst, b, h) do { _Pragma("unroll") for (int n = 0; n < 2; ++n) _Pragma("unroll") for (int k = 0; k < 2; ++k) dst[n][k] = *(const LAS bf16x8*)(lds + PG8_SB(b, h) + boff + n * 2048 + k * 1024); } while (0)
#define PG8_MMA(ai, bj, At, Bt) do { __builtin_amdgcn_s_setprio(1); _Pragma("unroll") for (int m = 0; m < 4; ++m) _Pragma("unroll") for (int n = 0; n < 2; ++n) _Pragma("unroll") for (int k = 0; k < 2; ++k) \
        acc[ai][bj][m][n] = __builtin_amdgcn_mfma_f32_16x16x32_bf16(Bt[n][k], At[m][k], acc[ai][bj][m][n], 0, 0, 0); __builtin_amdgcn_s_setprio(0); } while (0)
#define PG8_WAIT_V(n) asm volatile("s_waitcnt vmcnt(" #n ")" ::: "memory")
#define PG8_WAIT_L(n) asm volatile("s_waitcnt lgkmcnt(" #n ")" ::: "memory")
#define PG8_BAR __builtin_amdgcn_s_barrier()
#define PG8_SCHED __builtin_amdgcn_sched_barrier(0)
    Unit cur, nxt; int ui = 0;
    if (!S.next(0, cur)) return;
    f32x4 acc[2][2][4][2];
#pragma unroll
    for (int a = 0; a < 2; ++a)
#pragma unroll
        for (int b = 0; b < 2; ++b)
#pragma unroll
            for (int m = 0; m < 4; ++m)
#pragma unroll
                for (int n = 0; n < 2; ++n) acc[a][b][m][n] = (f32x4){0.f, 0.f, 0.f, 0.f};
    bf16x8 At[4][2], B0[2][2], B1[2][2];
    const char* cA = cur.A; const char* cB = cur.B;
    if constexpr (SP2) {
        PG8_STAGE(PG8_SB(0, 0), cB, voffB); PG8_STAGE(PG8_SB(0, 1), cB + hstepB, voffB); PG8_STAGE(PG8_SA(0, 0), cA, voffA); PG8_STAGE(PG8_SA(0, 1), cA + hstepA, voffA);
        if (wr == 1) PG8_BAR;
        PG8_WAIT_V(2); PG8_BAR;
        PG8_STAGE(PG8_SB(1, 0), cB + kstep, voffB); PG8_STAGE(PG8_SA(1, 0), cA + kstep, voffA); PG8_STAGE(PG8_SB(1, 1), cB + hstepB + kstep, voffB);
        PG8_WAIT_V(6); PG8_BAR;
    } else {
        PG8_STAGE(PG8_SB(0, 0), cB, voffB); PG8_STAGE(PG8_SA(0, 0), cA, voffA); PG8_STAGE(PG8_SB(0, 1), cB + hstepB, voffB); PG8_STAGE(PG8_SA(0, 1), cA + hstepA, voffA);
        if (wr == 1) PG8_BAR;
        PG8_WAIT_V(4); PG8_BAR;
        PG8_STAGE(PG8_SB(1, 0), cB + kstep, voffB); PG8_STAGE(PG8_SA(1, 0), cA + kstep, voffA); PG8_STAGE(PG8_SB(1, 1), cB + hstepB + kstep, voffB);
        PG8_WAIT_V(6); PG8_BAR;
    }
    for (;;) {
        const bool has_next = S.next(ui + 1, nxt);
        const char* nA = has_next ? nxt.A : cA; const char* nB = has_next ? nxt.B : cB;
#pragma unroll 1
        for (int t = 0; t < nt; t += 2) {
            const bool last = (t == nt - 2);
            const char* a1 = cA + (size_t)(t + 1) * kstep;
            const char* a2 = last ? nA : cA + (size_t)(t + 2) * kstep; const char* b2 = last ? nB : cB + (size_t)(t + 2) * kstep;
            const char* a3 = a2 + kstep; const char* b3 = b2 + kstep;
            if constexpr (SP2) {
            PG8_LDB(B0, 0, 0); PG8_LDB(B1, 0, 1); PG8_SCHED; PG8_LDA(At, 0, 0); PG8_STAGE(PG8_SA(1, 1), a1 + hstepA, voffA);
            PG8_WAIT_V(8); PG8_WAIT_L(0); PG8_BAR; PG8_MMA(0, 0, At, B0); PG8_MMA(0, 1, At, B1); PG8_BAR; PG8_SCHED;
            PG8_LDA(At, 0, 1); PG8_STAGE(PG8_SB(0, 0), b2, voffB); PG8_STAGE(PG8_SB(0, 1), b2 + hstepB, voffB); PG8_STAGE(PG8_SA(0, 0), a2, voffA);
            PG8_WAIT_V(8); PG8_WAIT_L(0); PG8_BAR; PG8_MMA(1, 0, At, B0); PG8_MMA(1, 1, At, B1); PG8_BAR; PG8_SCHED;
            PG8_LDB(B0, 1, 0); PG8_LDB(B1, 1, 1); PG8_SCHED; PG8_LDA(At, 1, 0); PG8_STAGE(PG8_SA(0, 1), a2 + hstepA, voffA);
            PG8_WAIT_V(8); PG8_WAIT_L(0); PG8_BAR; PG8_MMA(0, 0, At, B0); PG8_MMA(0, 1, At, B1); PG8_BAR; PG8_SCHED;
            PG8_LDA(At, 1, 1); PG8_STAGE(PG8_SB(1, 0), b3, voffB); PG8_STAGE(PG8_SB(1, 1), b3 + hstepB, voffB); PG8_STAGE(PG8_SA(1, 0), a3, voffA);
            PG8_WAIT_V(8); PG8_WAIT_L(0); PG8_BAR; PG8_MMA(1, 0, At, B0); PG8_MMA(1, 1, At, B1); PG8_BAR; PG8_SCHED;
            } else {
            PG8_LDB(B0, 0, 0); PG8_SCHED; PG8_LDA(At, 0, 0); PG8_STAGE(PG8_SA(1, 1), a1 + hstepA, voffA);
            PG8_WAIT_L(8); PG8_BAR; PG8_WAIT_L(0); PG8_MMA(0, 0, At, B0); PG8_BAR; PG8_SCHED;
            PG8_LDB(B1, 0, 1); PG8_STAGE(PG8_SB(0, 0), b2, voffB);
            PG8_BAR; PG8_WAIT_L(0); PG8_MMA(0, 1, At, B1); PG8_BAR;
            PG8_LDA(At, 0, 1); PG8_STAGE(PG8_SA(0, 0), a2, voffA);
            PG8_BAR; PG8_WAIT_L(0); PG8_MMA(1, 0, At, B0); PG8_BAR; PG8_SCHED;
            PG8_STAGE(PG8_SB(0, 1), b2 + hstepB, voffB);
            PG8_WAIT_V(6); PG8_BAR; PG8_MMA(1, 1, At, B1); PG8_BAR;
            PG8_LDB(B0, 1, 0); PG8_SCHED; PG8_LDA(At, 1, 0); PG8_STAGE(PG8_SA(0, 1), a2 + hstepA, voffA);
            PG8_WAIT_L(8); PG8_BAR; PG8_WAIT_L(0); PG8_MMA(0, 0, At, B0); PG8_BAR; PG8_SCHED;
            PG8_LDB(B1, 1, 1); PG8_STAGE(PG8_SB(1, 0), b3, voffB);
            PG8_BAR; PG8_WAIT_L(0); PG8_MMA(0, 1, At, B1); PG8_BAR;
            PG8_LDA(At, 1, 1); PG8_STAGE(PG8_SA(1, 0), a3, voffA);
            PG8_BAR; PG8_WAIT_L(0); PG8_MMA(1, 0, At, B0); PG8_BAR; PG8_SCHED;
            PG8_STAGE(PG8_SB(1, 1), b3 + hstepB, voffB);
            PG8_WAIT_V(6); PG8_BAR; PG8_MMA(1, 1, At, B1); PG8_BAR;
            }
        }
        if constexpr (ALIGN_EPI) { if (wr == 0) PG8_BAR; }
        { int l_e = lane_id(); asm volatile("" : "+v"(l_e)); E(acc, cur, wr, wc, l_e & 15, l_e >> 4); }
        if (!has_next) break;
#pragma unroll
        for (int a = 0; a < 2; ++a)
#pragma unroll
            for (int b = 0; b < 2; ++b)
#pragma unroll
                for (int m = 0; m < 4; ++m)
#pragma unroll
                    for (int n = 0; n < 2; ++n) acc[a][b][m][n] = (f32x4){0.f, 0.f, 0.f, 0.f};
        cur = nxt; cA = nA; cB = nB; ++ui;
        if constexpr (ALIGN_EPI) { if (wr == 1) PG8_BAR; }
    }
    PG8_WAIT_V(0);
    if constexpr (!ALIGN_EPI) { if (wr == 0) PG8_BAR; }
    PG8_BAR;
#undef PG8_SA
#undef PG8_SB
#undef PG8_STAGE
#undef PG8_LDA
#undef PG8_LDB
#undef PG8_MMA
#undef PG8_WAIT_V
#undef PG8_WAIT_L
#undef PG8_BAR
#undef PG8_SCHED
}
}
}
namespace mk {
constexpr size_t MiB = 1u << 20;
constexpr size_t WS_CTL = 0, CTL_ZERO_BYTES = 65536;
constexpr size_t WS_WIN = 1 * MiB, WS_WG = 7 * MiB, WS_WOUT = 10 * MiB, WS_WPEER = 13 * MiB, WS_WRKV = 21 * MiB, WS_WL2 = 29 * MiB, WS_WO = 31 * MiB, WS_VEC = 33 * MiB;
constexpr size_t WS_UB = 34 * MiB, WS_VB = 66 * MiB;
constexpr size_t WS_X0B = 98 * MiB, WS_GATE = 130 * MiB, WS_H2 = 174 * MiB, WS_XC = 218 * MiB, WS_A = 262 * MiB, WS_U = 350 * MiB, WS_AGG = 438 * MiB;
constexpr size_t WS_Y = WS_H2, WS_Z0 = WS_A, WS_XF = 350 * MiB, WS_XB0 = 98 * MiB;
constexpr size_t WS_SC0 = 130 * MiB, WS_EID0 = 258 * MiB, WS_GW0 = 266 * MiB;
constexpr size_t WS_MIX = 34 * MiB, WS_R = 226 * MiB, WS_K = 258 * MiB, WS_V = 290 * MiB, WS_LORA = 322 * MiB, WS_WDEC = 98 * MiB, WS_AA = 162 * MiB, WS_G = 194 * MiB, WS_OG = WS_R;
constexpr size_t WS_Z1 = 98 * MiB, WS_XB1 = 34 * MiB, WS_UB1 = 162 * MiB, WS_VB1 = 178 * MiB;
constexpr size_t WS_SC1 = 194 * MiB, WS_EID1 = 322 * MiB, WS_GW1 = 330 * MiB;
constexpr size_t WS_PART0 = 130 * MiB, WS_ZP0 = 274 * MiB, WS_PART1 = 66 * MiB, WS_ZP1 = 194 * MiB;
constexpr size_t WS_DBG = 444 * MiB, WS_END = 512 * MiB;
constexpr int CW_BAR = 4096;
constexpr int LDS_BYTES = 163840, MISC_OFF = LDS_BYTES - 256;

struct Args { const float* in[34]; float* out; unsigned char* ws; int ph_lo, ph_hi; };

struct Frame {
    LAS unsigned char* lds; volatile LAS unsigned* MISC; unsigned* ctl; unsigned char* ws;
    int tid, lane, wave, vcu, G, gw, NGW, bx;
    float* out;
};
#define LDS_WAIT() asm volatile("s_waitcnt lgkmcnt(0)" ::: "memory")

__device__ __forceinline__ void transpose_item(const float* W, int K, int N, bf16_t* WT, int ldt, int row_off, int col_off, LAS float* scr, int item, int lane) {
    const int nblk = N / 32, kb = item / nblk, nb = item % nblk, k0 = 64 * kb, n0 = 32 * nb;
#pragma unroll 8
    for (int i = 0; i < 32; ++i) { const int kk = 2 * i + (lane >> 5); scr[kk * 33 + (lane & 31)] = W[(size_t)(k0 + kk) * N + n0 + (lane & 31)]; }
    LDS_WAIT(); asm volatile("" ::: "memory");
    const int c = lane & 7;
#pragma unroll
    for (int j = 0; j < 4; ++j) { const int n = (lane >> 3) + 8 * j; const LAS float* s = scr + (8 * c) * 33 + n;
        u32x4 o; o.x = pk2(s[0 * 33], s[1 * 33]); o.y = pk2(s[2 * 33], s[3 * 33]); o.z = pk2(s[4 * 33], s[5 * 33]); o.w = pk2(s[6 * 33], s[7 * 33]);
        *(u32x4*)(WT + (size_t)(row_off + n0 + n) * ldt + col_off + k0 + 8 * c) = o; }
    LDS_WAIT(); asm volatile("" ::: "memory");
    (void)K;
}
__device__ __forceinline__ int gates_koff(int q) { int s = 128 * (q > 0 ? q - 1 : 0); return s > 1024 ? 1024 : s; }

__device__ __forceinline__ void cvt_stream(const float* src, bf16_t* dst, size_t n8, size_t w, size_t nw) {
    for (size_t i = w; i < n8; i += nw) { const f32x4 a = *(const f32x4*)(src + i * 8), b = *(const f32x4*)(src + i * 8 + 4);
        u32x4 o; o.x = pk2(a.x, a.y); o.y = pk2(a.z, a.w); o.z = pk2(b.x, b.y); o.w = pk2(b.z, b.w); *(u32x4*)(dst + i * 8) = o; }
}

__device__ __forceinline__ void cvt_stream_fp8(const float* src, unsigned char* dst, size_t n16, size_t w, size_t nw, float scale) {
    for (size_t i = w; i < n16; i += nw) { const f32x4 a = *(const f32x4*)(src + i * 16) * scale, b = *(const f32x4*)(src + i * 16 + 4) * scale, c = *(const f32x4*)(src + i * 16 + 8) * scale, d = *(const f32x4*)(src + i * 16 + 12) * scale;
        u32x4 o; int t;
        t = __builtin_amdgcn_cvt_pk_fp8_f32(a.x, a.y, 0, false); o.x = (unsigned)__builtin_amdgcn_cvt_pk_fp8_f32(a.z, a.w, t, true);
        t = __builtin_amdgcn_cvt_pk_fp8_f32(b.x, b.y, 0, false); o.y = (unsigned)__builtin_amdgcn_cvt_pk_fp8_f32(b.z, b.w, t, true);
        t = __builtin_amdgcn_cvt_pk_fp8_f32(c.x, c.y, 0, false); o.z = (unsigned)__builtin_amdgcn_cvt_pk_fp8_f32(c.z, c.w, t, true);
        t = __builtin_amdgcn_cvt_pk_fp8_f32(d.x, d.y, 0, false); o.w = (unsigned)__builtin_amdgcn_cvt_pk_fp8_f32(d.z, d.w, t, true);
        *(u32x4*)(dst + ((i & 63) >> 3) * ((size_t)16384 * 128) + (i >> 6) * 128 + (i & 7) * 16) = o; }
}
constexpr float U_SCALE = 256.f, V_SCALE = 32.f;

__device__ __forceinline__ void p0_prologue(Frame& F, const Args& args) {
    LAS float* scr = (LAS float*)(F.lds + F.wave * 16384);
    const int gw = F.gw, NGW = F.NGW, lane = F.lane;
    bf16_t* Win_t = (bf16_t*)(F.ws + WS_WIN); bf16_t* Wout_t = (bf16_t*)(F.ws + WS_WOUT); bf16_t* Wrkv_t = (bf16_t*)(F.ws + WS_WRKV); bf16_t* Wl2_t = (bf16_t*)(F.ws + WS_WL2); bf16_t* Wo_t = (bf16_t*)(F.ws + WS_WO);
    for (int it = gw; it < 16 * 88; it += NGW) transpose_item(args.in[1], 1024, 2816, Win_t, 1024, 0, 0, scr, it, lane);
    for (int it = gw; it < 22 * 32; it += NGW) transpose_item(args.in[9], 1408, 1024, Wout_t, 1408, 0, 0, scr, it, lane);
    for (int it = gw; it < 512; it += NGW) transpose_item(args.in[11], 1024, 1024, Wrkv_t, 1024, 0, 0, scr, it, lane);
    for (int it = gw; it < 512; it += NGW) transpose_item(args.in[12], 1024, 1024, Wrkv_t, 1024, 1024, 0, scr, it, lane);
    for (int it = gw; it < 512; it += NGW) transpose_item(args.in[13], 1024, 1024, Wrkv_t, 1024, 2048, 0, scr, it, lane);
    for (int it = gw; it < 32; it += NGW) transpose_item(args.in[15], 1024, 64, Wrkv_t, 1024, 3072, 0, scr, it, lane);
    for (int it = gw; it < 32; it += NGW) transpose_item(args.in[18], 1024, 64, Wrkv_t, 1024, 3328, 0, scr, it, lane);
    for (int it = gw; it < 64; it += NGW) transpose_item(args.in[20], 1024, 128, Wrkv_t, 1024, 3584, 0, scr, it, lane);
    for (int it = gw; it < 512; it += NGW) transpose_item(args.in[27], 1024, 1024, Wo_t, 1024, 0, 0, scr, it, lane);
    for (int it = gw; it < 32; it += NGW) transpose_item(args.in[16], 64, 1024, Wl2_t, 256, 0, 0, scr, it, lane);
    for (int it = gw; it < 32; it += NGW) transpose_item(args.in[19], 64, 1024, Wl2_t, 256, 1024, 64, scr, it, lane);
    for (int it = gw; it < 64; it += NGW) transpose_item(args.in[21], 128, 1024, Wl2_t, 256, 2048, 128, scr, it, lane);
    const size_t gt = (size_t)gw * 64 + lane, NGT = (size_t)NGW * 64;
    const u32x4 z4 = {0u, 0u, 0u, 0u};
    for (size_t i = gt; i < (size_t)768 * 128; i += NGT) {
        const int row = 3072 + (int)(i / 128), r = row - 3072; const bool data = (r < 64) || (r >= 256 && r < 320) || (r >= 512 && r < 640);
        if (!data) *(u32x4*)(Wrkv_t + (size_t)row * 1024 + (i % 128) * 8) = z4; }
    for (size_t i = gt; i < (size_t)3072 * 32; i += NGT) {
        const int row = (int)(i / 32), c8 = (int)(i % 32) * 8, g = row >> 10; const int lo = g == 0 ? 0 : (g == 1 ? 64 : 128), hi = g == 0 ? 64 : (g == 1 ? 128 : 256);
        if (c8 < lo || c8 >= hi) *(u32x4*)(Wl2_t + (size_t)row * 256 + c8) = z4; }
    { bf16_t* Wg_t = (bf16_t*)(F.ws + WS_WG);
      for (size_t i = gt; i < (size_t)2816 * 48; i += NGT) {
          const int row = (int)(i / 48), k8 = (int)(i % 48) * 8, q = row >> 8, r = row & 255, gs = r >> 7, ch = 128 * q + (r & 127), h = ch / HB, j = ch % HB;
          const float* w = (gs ? args.in[6] : args.in[4]) + (size_t)h * HB * HB; const int kg0 = gates_koff(q) + k8;
          float v[8];
#pragma unroll
          for (int e = 0; e < 8; ++e) { const int kg = kg0 + e; v[e] = (kg / HB == h) ? w[(kg % HB) * HB + j] : 0.f; }
          u32x4 o; o.x = pk2(v[0], v[1]); o.y = pk2(v[2], v[3]); o.z = pk2(v[4], v[5]); o.w = pk2(v[6], v[7]);
          *(u32x4*)(Wg_t + (size_t)row * 384 + k8) = o; } }
    for (int it = gw; it < 4096; it += NGW) {
        const int layer = it >> 11, hp = (it >> 7) & 15, n0 = ((it >> 4) & 7) * 16, k0 = (it & 15) * 64;
        const float* keys = args.in[29] + ((size_t)layer * 16 + hp) * 128 * 128; const float* wq = args.in[28] + (size_t)layer * 1024 * 2048 + hp * 128;
        bf16_t* We = (bf16_t*)(F.ws + WS_WPEER) + (size_t)layer * 2048 * 1024;
        f32x4 acc[4];
#pragma unroll
        for (int s = 0; s < 4; ++s) acc[s] = (f32x4){0.f, 0.f, 0.f, 0.f};
        const int li = lane & 15, q = lane >> 4;
        for (int dc = 0; dc < 8; ++dc) {
            const int d = 16 * dc + 4 * q;
            const f32x4 a = *(const f32x4*)(keys + (size_t)(n0 + li) * 128 + d);
            f32x4 b[4];
#pragma unroll
            for (int s = 0; s < 4; ++s) b[s] = *(const f32x4*)(wq + (size_t)(k0 + 16 * s + li) * 2048 + d);
#pragma unroll
            for (int e = 0; e < 4; ++e)
#pragma unroll
                for (int s = 0; s < 4; ++s) acc[s] = __builtin_amdgcn_mfma_f32_16x16x4f32(a[e], b[s][e], acc[s], 0, 0, 0);
        }
#pragma unroll
        for (int s = 0; s < 4; ++s)
#pragma unroll
            for (int r = 0; r < 4; ++r) We[(size_t)(hp * 128 + n0 + 4 * q + r) * 1024 + k0 + 16 * s + li] = (bf16_t)f2bf(acc[s][r]);
    }
    cvt_stream(args.in[0], (bf16_t*)(F.ws + WS_X0B), (size_t)T * D / 8, gt, NGT);
    cvt_stream_fp8(args.in[30], F.ws + WS_UB, (size_t)16384 * D / 16, gt, NGT, U_SCALE);
    cvt_stream_fp8(args.in[31], F.ws + WS_VB, (size_t)16384 * D / 16, gt, NGT, V_SCALE);
    { float* sl = (float*)(F.ws + WS_VEC); for (size_t i = gt; i < (size_t)W; i += NGT) { const float l = args.in[8][i]; sl[i] = -8.f * (l < -15.f ? -l : log1pf(expf(-l))); } }
}

struct ProbPlain { const char* A; const char* B; size_t strideA, strideB;
    __device__ __forceinline__ void locate(pg8::Unit& u) const { u.A = A + (size_t)u.pm * strideA; u.B = B + (size_t)u.pn * strideB; } };
struct ProbGates { const char* A; const char* B;
    __device__ __forceinline__ void locate(pg8::Unit& u) const { u.A = A + (size_t)u.pm * (256 * W * 2) + gates_koff(u.pn) * 2; u.B = B + (size_t)u.pn * (256 * 384 * 2); } };
struct ProbRkv { const char* mix; const char* B;
    __device__ __forceinline__ void locate(pg8::Unit& u) const { const int pn = u.pn; const int j = pn < 4 ? 0 : (pn < 8 ? 2 : (pn < 12 ? 3 : (pn == 12 ? 1 : (pn == 13 ? 4 : 5))));
        u.A = mix + (size_t)j * ((size_t)T * D * 2) + (size_t)u.pm * (256 * D * 2); u.B = B + (size_t)pn * (256 * D * 2); } };

struct EpiWin { static constexpr bool PERM = true; bf16_t* gate; bf16_t* h2;
    __device__ __forceinline__ void operator()(const f32x4 (&acc)[2][2][4][2], const pg8::Unit& u, int wr, int wc, int fr, int fq) const {
        const int row0 = u.pm * 256 + wr * 64 + fr;
#pragma unroll
        for (int bj = 0; bj < 2; ++bj) { const int hb = 2 * u.pn + bj; const bool isg = hb < 11; bf16_t* base = isg ? gate : h2; const int col = 128 * (isg ? hb : hb - 11) + wc * 32 + 8 * fq;
#pragma unroll
            for (int ai = 0; ai < 2; ++ai)
#pragma unroll
                for (int m = 0; m < 4; ++m) { f32x4 v0 = acc[ai][bj][m][0], v1 = acc[ai][bj][m][1];
                    if (isg) {
#pragma unroll
                        for (int j = 0; j < 4; ++j) { v0[j] = gelu_tanh(v0[j]); v1[j] = gelu_tanh(v1[j]); } }
                    u32x4 w; w.x = cvt_pk_bf16(v0[0], v0[1]); w.y = cvt_pk_bf16(v0[2], v0[3]); w.z = cvt_pk_bf16(v1[0], v1[1]); w.w = cvt_pk_bf16(v1[2], v1[3]);
                    *(u32x4*)(base + (size_t)(row0 + ai * 128 + m * 16) * W + col) = w; } }
    } };
struct EpiGates { static constexpr bool PERM = false; const bf16_t* xc; const float* sl; const float* ba; const float* bx; bf16_t* a; bf16_t* uo;
    __device__ __forceinline__ void operator()(const f32x4 (&acc)[2][2][4][2], const pg8::Unit& u, int wr, int wc, int fr, int fq) const {
        const int row0 = u.pm * 256 + wr * 64 + fr;
#pragma unroll
        for (int ai = 0; ai < 2; ++ai)
#pragma unroll
            for (int m = 0; m < 4; ++m) {
#pragma unroll
                for (int n = 0; n < 2; ++n) { const int c = 128 * u.pn + wc * 32 + 16 * n + 4 * fq; const size_t off = (size_t)(row0 + ai * 128 + m * 16) * W + c;
                    const f32x4 s4 = *(const f32x4*)(sl + c), ba4 = *(const f32x4*)(ba + c), bx4 = *(const f32x4*)(bx + c);
                    const u32x2 xw = *(const u32x2*)(xc + off);
                    const f32x4 pa = acc[ai][0][m][n] + ba4, px = acc[ai][1][m][n] + bx4; f32x4 av, uv; const f32x4 xs = {bf_lo(xw.x), bf_hi(xw.x), bf_lo(xw.y), bf_hi(xw.y)};
#pragma unroll
                    for (int j = 0; j < 4; ++j) { const float r = fast_sigmoid(pa[j]), ig = fast_sigmoid(px[j]); const float la = s4[j] * r; const float aa = fast_exp(la);
                        av[j] = la; uv[j] = sqrtf(fmaxf(1.f - aa * aa, 0.f)) * ig * xs[j]; }
                    { u32x2 w1; w1.x = pk2(av[0], av[1]); w1.y = pk2(av[2], av[3]); *(u32x2*)(a + off) = w1; u32x2 w2; w2.x = pk2(uv[0], uv[1]); w2.y = pk2(uv[2], uv[3]); *(u32x2*)(uo + off) = w2; } }
                if (m == 3) asm volatile("" ::: "memory"); }
    } };
struct EpiRes { static constexpr bool PERM = false; const float* res; float* z;
    __device__ __forceinline__ void operator()(const f32x4 (&acc)[2][2][4][2], const pg8::Unit& u, int wr, int wc, int fr, int fq) const {
        const int row0 = u.pm * 256 + wr * 64 + fr, col0 = u.pn * 256 + wc * 32 + 4 * fq;
#pragma unroll
        for (int ai = 0; ai < 2; ++ai)
#pragma unroll
            for (int m = 0; m < 4; ++m) { const size_t off = (size_t)(row0 + ai * 128 + m * 16) * D + col0;
#pragma unroll
                for (int bj = 0; bj < 2; ++bj)
#pragma unroll
                    for (int n = 0; n < 2; ++n) { const f32x4 r4 = *(const f32x4*)(res + off + bj * 128 + n * 16); *(f32x4*)(z + off + bj * 128 + n * 16) = r4 * ALPHA + acc[ai][bj][m][n]; } }
    } };
struct EpiScores { static constexpr bool PERM = false; unsigned* sc;
    __device__ __forceinline__ void operator()(const f32x4 (&acc)[2][2][4][2], const pg8::Unit& u, int wr, int wc, int fr, int fq) const {
#pragma unroll
        for (int ai = 0; ai < 2; ++ai) { const int tb = 4 * u.pm + 2 * ai + wr;
#pragma unroll
            for (int bj = 0; bj < 2; ++bj) { const int hp = 2 * u.pn + bj; unsigned* base = sc + ((size_t)(tb * 16 + hp) * 64) * 64;
#pragma unroll
                for (int m = 0; m < 4; ++m) { const int tl = 16 * m + fr;
#pragma unroll
                    for (int n = 0; n < 2; ++n) { const int nn = 32 * wc + 16 * n + 4 * fq; const f32x4 v = acc[ai][bj][m][n];
                        base[(size_t)(nn / 2) * 64 + tl] = cvt_pk_bf16(v[0], v[1]); base[(size_t)(nn / 2 + 1) * 64 + tl] = cvt_pk_bf16(v[2], v[3]); } } } }
    } };
struct EpiRkv { static constexpr bool PERM = true; bf16_t* r; bf16_t* lora;
    __device__ __forceinline__ void operator()(const f32x4 (&acc)[2][2][4][2], const pg8::Unit& u, int wr, int wc, int fr, int fq) const {
        const int row0 = u.pm * 256 + wr * 64 + fr, pn = u.pn;
        if (pn < 12) { bf16_t* base = r + (size_t)(pn >> 2) * ((size_t)T * D); const int col0 = (pn & 3) * 256 + wc * 32 + 8 * fq;
#pragma unroll
            for (int ai = 0; ai < 2; ++ai)
#pragma unroll
                for (int m = 0; m < 4; ++m)
#pragma unroll
                    for (int bj = 0; bj < 2; ++bj) { const f32x4 v0 = acc[ai][bj][m][0], v1 = acc[ai][bj][m][1];
                        u32x4 w; w.x = cvt_pk_bf16(v0[0], v0[1]); w.y = cvt_pk_bf16(v0[2], v0[3]); w.z = cvt_pk_bf16(v1[0], v1[1]); w.w = cvt_pk_bf16(v1[2], v1[3]);
                        *(u32x4*)(base + (size_t)(row0 + ai * 128 + m * 16) * D + col0 + bj * 128) = w; }
        } else {
            const int kind = pn - 12;
            const int lim = kind == 2 ? 128 : 64, dst0 = kind == 0 ? 0 : (kind == 1 ? 64 : 128);
#pragma unroll
            for (int bj = 0; bj < 2; ++bj) { const int cl = 128 * bj + wc * 32 + 8 * fq; if (cl < lim) {
#pragma unroll
                for (int ai = 0; ai < 2; ++ai)
#pragma unroll
                    for (int m = 0; m < 4; ++m) { f32x4 v0 = acc[ai][bj][m][0], v1 = acc[ai][bj][m][1];
#pragma unroll
                        for (int j = 0; j < 4; ++j) { if (kind == 0) { v0[j] = fast_tanh(v0[j]); v1[j] = fast_tanh(v1[j]); } else if (kind == 2) { v0[j] = fast_sigmoid(v0[j]); v1[j] = fast_sigmoid(v1[j]); } }
                        u32x4 w; w.x = cvt_pk_bf16(v0[0], v0[1]); w.y = cvt_pk_bf16(v0[2], v0[3]); w.z = cvt_pk_bf16(v1[0], v1[1]); w.w = cvt_pk_bf16(v1[2], v1[3]);
                        *(u32x4*)(lora + (size_t)(row0 + ai * 128 + m * 16) * 256 + dst0 + cl) = w; } } }
        }
    } };
struct EpiLora2 { static constexpr bool PERM = true; float* wdec; bf16_t* aa; const float* w0; const float* a0; int dbg;
    __device__ __forceinline__ void operator()(const f32x4 (&acc)[2][2][4][2], const pg8::Unit& u, int wr, int wc, int fr, int fq) const {
        if (dbg == 5) { if (acc[0][0][0][0][0] == 12345.678f) wdec[0] = 1.f; return; }
        const int row0 = u.pm * 256 + wr * 64 + fr, pn = u.pn, kind = pn >> 2;
#pragma unroll
        for (int bj = 0; bj < 2; ++bj) { const int col = (pn & 3) * 256 + 128 * bj + wc * 32 + 8 * fq;
            f32x4 c0 = {0.f, 0.f, 0.f, 0.f}, c1 = c0;
            if (kind == 0) { c0 = *(const f32x4*)(w0 + col); c1 = *(const f32x4*)(w0 + col + 4); } else if (kind == 1) { c0 = *(const f32x4*)(a0 + col); c1 = *(const f32x4*)(a0 + col + 4); }
#pragma unroll
            for (int ai = 0; ai < 2; ++ai)
#pragma unroll
                for (int m = 0; m < 4; ++m) { f32x4 v0 = acc[ai][bj][m][0] + c0, v1 = acc[ai][bj][m][1] + c1; const size_t off = (size_t)(row0 + ai * 128 + m * 16) * D + col;
                    if (kind == 0) {
#pragma unroll
                        for (int j = 0; j < 4; ++j) { v0[j] = fast_exp(-0.60653066f * fast_sigmoid(v0[j])); v1[j] = fast_exp(-0.60653066f * fast_sigmoid(v1[j])); }
                        *(f32x4*)(wdec + off) = v0; *(f32x4*)(wdec + off + 4) = v1;
                    } else {
                        if (kind == 1) {
#pragma unroll
                            for (int j = 0; j < 4; ++j) { v0[j] = fast_sigmoid(v0[j]); v1[j] = fast_sigmoid(v1[j]); } }
                        u32x4 w; w.x = cvt_pk_bf16(v0[0], v0[1]); w.y = cvt_pk_bf16(v0[2], v0[3]); w.z = cvt_pk_bf16(v1[0], v1[1]); w.w = cvt_pk_bf16(v1[2], v1[3]);
                        *(u32x4*)(aa + (size_t)(kind - 1) * ((size_t)T * D) + off) = w; } } }
    } };

template <class Epi, class Prob>
__device__ __forceinline__ void run_gemm(Frame& F, int nM, int nN, int lda, int ldb, int K, const Prob& P, const Epi& E) {
    pg8::Order<Prob> S; S.init(nM, nN, F.G, F.bx, P);
    pg8::gemm_phase<Epi, pg8::Order<Prob>, true, true>(F.lds, F.tid, lda, ldb, K, S, E);
}

__device__ __forceinline__ void conv_phase(Frame& F, const float* cw, const float* cb) {
    const bf16_t* h2 = (const bf16_t*)(F.ws + WS_H2); bf16_t* xc = (bf16_t*)(F.ws + WS_XC);
    const size_t gt = (size_t)F.gw * 64 + F.lane, NGT = (size_t)F.NGW * 64;
    for (size_t i = gt; i < (size_t)T * (W / 8); i += NGT) {
        const int t = (int)(i / (W / 8)), c = (int)(i % (W / 8)) * 8, s = t & (S - 1);
        float acc[8];
        { const f32x4 b0 = *(const f32x4*)(cb + c), b1 = *(const f32x4*)(cb + c + 4); acc[0] = b0.x; acc[1] = b0.y; acc[2] = b0.z; acc[3] = b0.w; acc[4] = b1.x; acc[5] = b1.y; acc[6] = b1.z; acc[7] = b1.w; }
#pragma unroll
        for (int j = 0; j < 4; ++j) { if (s - 3 + j >= 0) {
            const u32x4 hv = *(const u32x4*)(h2 + (size_t)(t - 3 + j) * W + c); const f32x4 w0 = *(const f32x4*)(cw + j * W + c), w1 = *(const f32x4*)(cw + j * W + c + 4);
            acc[0] += w0.x * bf_lo(hv.x); acc[1] += w0.y * bf_hi(hv.x); acc[2] += w0.z * bf_lo(hv.y); acc[3] += w0.w * bf_hi(hv.y);
            acc[4] += w1.x * bf_lo(hv.z); acc[5] += w1.y * bf_hi(hv.z); acc[6] += w1.z * bf_lo(hv.w); acc[7] += w1.w * bf_hi(hv.w); } }
        u32x4 o; o.x = pk2(acc[0], acc[1]); o.y = pk2(acc[2], acc[3]); o.z = pk2(acc[4], acc[5]); o.w = pk2(acc[6], acc[7]);
        *(u32x4*)(xc + (size_t)t * W + c) = o;
    }
}
constexpr int RG_CH = 32, RG_NCH = S / RG_CH;
__device__ __forceinline__ void rgscan1_phase(Frame& F) {
    const bf16_t* a = (const bf16_t*)(F.ws + WS_A); const bf16_t* u = (const bf16_t*)(F.ws + WS_U); float* agg = (float*)(F.ws + WS_AGG);
    for (int it = F.gw; it < NB * RG_NCH * 11; it += F.NGW) {
        const int cg = it % 11, ch = (it / 11) % RG_NCH, b = it / (11 * RG_NCH), c = cg * 128 + 2 * F.lane; const size_t t0 = (size_t)b * S + (size_t)ch * RG_CH;
        f32x2 P = {0.f, 0.f}, H = {0.f, 0.f};
#pragma unroll 8
        for (int s = 0; s < RG_CH; ++s) { const unsigned aw = *(const unsigned*)(a + (t0 + s) * W + c), uw = *(const unsigned*)(u + (t0 + s) * W + c); const f32x2 la = {bf_lo(aw), bf_hi(aw)}, uv = {bf_lo(uw), bf_hi(uw)};
            const f32x2 av = {fast_exp(la.x), fast_exp(la.y)}; H = av * H + uv; P = P + la; }
        P = (f32x2){fast_exp(P.x), fast_exp(P.y)};
        const size_t o = (size_t)(b * RG_NCH + ch) * W + c; *(f32x2*)(agg + o) = P; *(f32x2*)(agg + o + (size_t)NB * RG_NCH * W) = H;
    }
}
__device__ __forceinline__ void rgscan2_phase(Frame& F) {
    const bf16_t* a = (const bf16_t*)(F.ws + WS_A); const bf16_t* u = (const bf16_t*)(F.ws + WS_U); const float* agg = (const float*)(F.ws + WS_AGG);
    const bf16_t* gate = (const bf16_t*)(F.ws + WS_GATE); bf16_t* y = (bf16_t*)(F.ws + WS_Y);
    for (int it = F.gw; it < NB * RG_NCH * 11; it += F.NGW) {
        const int cg = it % 11, ch = (it / 11) % RG_NCH, b = it / (11 * RG_NCH), c = cg * 128 + 2 * F.lane; const size_t t0 = (size_t)b * S + (size_t)ch * RG_CH;
        f32x2 H = {0.f, 0.f};
        for (int j = 0; j < ch; ++j) { const size_t o = (size_t)(b * RG_NCH + j) * W + c; const f32x2 Pj = *(const f32x2*)(agg + o), Hj = *(const f32x2*)(agg + o + (size_t)NB * RG_NCH * W); H = Pj * H + Hj; }
#pragma unroll 8
        for (int s = 0; s < RG_CH; ++s) { const size_t o = (t0 + s) * W + c; const unsigned aw = *(const unsigned*)(a + o), uw = *(const unsigned*)(u + o); const f32x2 av = {fast_exp(bf_lo(aw)), fast_exp(bf_hi(aw))}, uv = {bf_lo(uw), bf_hi(uw)}; H = av * H + uv;
            const unsigned gw_ = *(const unsigned*)(gate + o); *(unsigned*)(y + o) = pk2(H.x * bf_lo(gw_), H.y * bf_hi(gw_)); }
    }
}
__device__ __forceinline__ void ln_phase(Frame& F, const float* z, const float* g, const float* bb, float* xf, bf16_t* xb) {
    for (int m = F.gw; m < T; m += F.NGW) {
        const f32x4* zr = (const f32x4*)(z + (size_t)m * D) + F.lane; f32x4 v[4]; float s = 0.f;
#pragma unroll
        for (int j = 0; j < 4; ++j) { v[j] = zr[64 * j]; s += (v[j].x + v[j].y) + (v[j].z + v[j].w); }
        const float mean = wave_sum(s) * (1.f / D); float s2 = 0.f;
#pragma unroll
        for (int j = 0; j < 4; ++j) { v[j] = v[j] - mean; s2 += (v[j].x * v[j].x + v[j].y * v[j].y) + (v[j].z * v[j].z + v[j].w * v[j].w); }
        const float rstd = 1.f / sqrtf(wave_sum(s2) * (1.f / D) + LN_EPS);
#pragma unroll
        for (int j = 0; j < 4; ++j) { const int c = 4 * F.lane + 256 * j; const f32x4 o = v[j] * rstd * *(const f32x4*)(g + c) + *(const f32x4*)(bb + c);
            *(f32x4*)(xf + (size_t)m * D + c) = o; if (xb) { u32x2 w; w.x = pk2(o.x, o.y); w.y = pk2(o.z, o.w); *(u32x2*)(xb + (size_t)m * D + c) = w; } }
    }
}
__device__ __forceinline__ void ce_desc(float& a, float& b) { const float hi = fmaxf(a, b), lo = fminf(a, b); a = hi; b = lo; }
__device__ __forceinline__ void sort16_desc(float (&a)[16]) {
#pragma unroll
    for (int k = 2; k <= 16; k <<= 1)
#pragma unroll
        for (int j = k >> 1; j > 0; j >>= 1)
#pragma unroll
            for (int i = 0; i < 16; ++i) { const int l = i ^ j; if (l > i) { if ((i & k) == 0) ce_desc(a[i], a[l]); else ce_desc(a[l], a[i]); } }
}
__device__ __forceinline__ void merge_top16(float (&t)[16], const float (&b)[16]) {
#pragma unroll
    for (int i = 0; i < 16; ++i) t[i] = fmaxf(t[i], b[15 - i]);
#pragma unroll
    for (int j = 8; j > 0; j >>= 1)
#pragma unroll
        for (int i = 0; i < 16; ++i) { const int l = i ^ j; if (l > i) ce_desc(t[i], t[l]); }
}
__device__ __forceinline__ float pack_idx7(float v, int n) { return __builtin_bit_cast(float, (__builtin_bit_cast(unsigned, v) & ~127u) | (unsigned)(127 - n)); }
__device__ __forceinline__ void top16_of_128(float (&s)[16], const unsigned* p) {
    { float g[16];
#pragma unroll
      for (int i = 0; i < 8; ++i) { const unsigned w = p[(size_t)i * 64]; g[2 * i] = pack_idx7(bf_lo(w), 2 * i); g[2 * i + 1] = pack_idx7(bf_hi(w), 2 * i + 1); }
      sort16_desc(g);
#pragma unroll
      for (int i = 0; i < 16; ++i) s[i] = g[i]; }
#pragma unroll 1
    for (int grp = 1; grp < 8; ++grp) { float g[16];
#pragma unroll
        for (int i = 0; i < 8; ++i) { const unsigned w = p[(size_t)(8 * grp + i) * 64]; g[2 * i] = pack_idx7(bf_lo(w), 16 * grp + 2 * i); g[2 * i + 1] = pack_idx7(bf_hi(w), 16 * grp + 2 * i + 1); }
        sort16_desc(g); merge_top16(s, g); }
}
__device__ __forceinline__ void topk_phase(Frame& F, const unsigned* sc, int* eid, float* gwt) {
    for (int it = F.gw; it < (T / 64) * 8; it += F.NGW) {
        const int tb = it >> 3, h = it & 7, t = tb * 64 + F.lane;
        float s0[16], s1[16];
        const unsigned* p0 = sc + ((size_t)(tb * 16 + 2 * h) * 64) * 64 + F.lane;
        top16_of_128(s0, p0); top16_of_128(s1, p0 + 64 * 64);
        float tt[16];
        { float g[16];
#define PAIR(i, j) __builtin_bit_cast(float, (__builtin_bit_cast(unsigned, s0[i] + s1[j]) & ~255u) | (unsigned)(255 - ((i) * 16 + (j))))
          const float NI = -__builtin_inff();
          g[0] = PAIR(0,0); g[1] = PAIR(0,1); g[2] = PAIR(0,2); g[3] = PAIR(0,3); g[4] = PAIR(0,4); g[5] = PAIR(0,5); g[6] = PAIR(0,6); g[7] = PAIR(0,7);
          g[8] = PAIR(0,8); g[9] = PAIR(0,9); g[10] = PAIR(0,10); g[11] = PAIR(0,11); g[12] = PAIR(0,12); g[13] = PAIR(0,13); g[14] = PAIR(0,14); g[15] = PAIR(0,15);
          sort16_desc(g);
#pragma unroll
          for (int i = 0; i < 16; ++i) tt[i] = g[i];
          g[0] = PAIR(1,0); g[1] = PAIR(1,1); g[2] = PAIR(1,2); g[3] = PAIR(1,3); g[4] = PAIR(1,4); g[5] = PAIR(1,5); g[6] = PAIR(1,6); g[7] = PAIR(1,7);
          g[8] = PAIR(2,0); g[9] = PAIR(2,1); g[10] = PAIR(2,2); g[11] = PAIR(2,3); g[12] = PAIR(2,4); g[13] = PAIR(3,0); g[14] = PAIR(3,1); g[15] = PAIR(3,2);
          sort16_desc(g); merge_top16(tt, g);
          g[0] = PAIR(3,3); g[1] = PAIR(4,0); g[2] = PAIR(4,1); g[3] = PAIR(4,2); g[4] = PAIR(5,0); g[5] = PAIR(5,1); g[6] = PAIR(6,0); g[7] = PAIR(6,1);
          g[8] = PAIR(7,0); g[9] = PAIR(7,1); g[10] = PAIR(8,0); g[11] = PAIR(9,0); g[12] = PAIR(10,0); g[13] = PAIR(11,0); g[14] = PAIR(12,0); g[15] = PAIR(13,0);
          sort16_desc(g); merge_top16(tt, g);
          g[0] = PAIR(14,0); g[1] = PAIR(15,0); g[2] = NI; g[3] = NI; g[4] = NI; g[5] = NI; g[6] = NI; g[7] = NI; g[8] = NI; g[9] = NI; g[10] = NI; g[11] = NI; g[12] = NI; g[13] = NI; g[14] = NI; g[15] = NI;
          ce_desc(g[0], g[1]); merge_top16(tt, g);
#undef PAIR
        }
        float e[16], sum = 0.f;
#pragma unroll
        for (int r = 0; r < 16; ++r) { e[r] = fast_exp(tt[r] - tt[0]); sum += e[r]; }
        const float inv = 1.f / sum;
        int ids[16];
#pragma unroll
        for (int r = 0; r < 16; ++r) { const unsigned code = 255u - (__builtin_bit_cast(unsigned, tt[r]) & 255u); const unsigned ci = code >> 4, cj = code & 15u; unsigned i0 = 0, i1 = 0;
#pragma unroll
            for (int i = 0; i < 16; ++i) { i0 = (ci == (unsigned)i) ? (127u - (__builtin_bit_cast(unsigned, s0[i]) & 127u)) : i0; i1 = (cj == (unsigned)i) ? (127u - (__builtin_bit_cast(unsigned, s1[i]) & 127u)) : i1; }
            ids[r] = (int)(i0 * 128u + i1); }
        int* ep = eid + (size_t)t * 128 + h * 16; float* gp = gwt + (size_t)t * 128 + h * 16;
#pragma unroll
        for (int r = 0; r < 16; r += 4) { *(int4*)(ep + r) = make_int4(ids[r], ids[r + 1], ids[r + 2], ids[r + 3]); *(f32x4*)(gp + r) = (f32x4){e[r] * inv, e[r + 1] * inv, e[r + 2] * inv, e[r + 3] * inv}; }
    }
}
__device__ __forceinline__ f32x2 fp8lo(unsigned w) { return __builtin_amdgcn_cvt_pk_f32_fp8((int)w, false); }
__device__ __forceinline__ f32x2 fp8hi(unsigned w) { return __builtin_amdgcn_cvt_pk_f32_fp8((int)w, true); }
__device__ __forceinline__ float gu_dot(const u32x4& r, const f32x2 (&xs)[8]) { f32x2 d = fp8lo(r.x) * xs[0]; d += fp8hi(r.x) * xs[1]; d += fp8lo(r.y) * xs[2]; d += fp8hi(r.y) * xs[3];
    d += fp8lo(r.z) * xs[4]; d += fp8hi(r.z) * xs[5]; d += fp8lo(r.w) * xs[6]; d += fp8hi(r.w) * xs[7]; return sum8(d.x + d.y); }
__device__ __forceinline__ void gu_phase(Frame& F, const float* xf, const int* eid, float* part, const unsigned char* utab) {
    const int j = F.bx & 7, sg = F.bx >> 3, lane = F.lane, e8 = lane >> 3, dch = lane & 7;
    const unsigned char* Ub = utab + (size_t)j * ((size_t)16384 * 128); float* pj = part + (size_t)j * T * 128; const unsigned lo16 = 16u * dch;
    constexpr int TPW = T / (32 * NWAVES); const int tb = sg * (T / 32) + F.wave * TPW;
    int e0 = eid[(size_t)tb * 128 + lane], e1 = eid[(size_t)tb * 128 + 64 + lane];
    f32x4 xq[4];
#pragma unroll
    for (int q = 0; q < 4; ++q) xq[q] = *(const f32x4*)(xf + (size_t)tb * D + 128 * j + 16 * dch + 4 * q);
#pragma unroll 1
    for (int it = 0; it < TPW; ++it) { const int t = tb + it;
        u32x4 ra[16];
#pragma unroll
        for (int i = 0; i < 16; ++i) { const int ia = __shfl(i < 8 ? e0 : e1, (8 * i + e8) & 63); ra[i] = *(const u32x4*)(Ub + ((unsigned)ia * 128u + lo16)); }
        f32x2 xs[8];
#pragma unroll
        for (int q = 0; q < 4; ++q) { const f32x4 x0 = xq[q] * (1.f / U_SCALE); xs[2 * q] = (f32x2){x0.x, x0.y}; xs[2 * q + 1] = (f32x2){x0.z, x0.w}; }
        const int tn = (it + 1 < TPW) ? t + 1 : t;
        e0 = eid[(size_t)tn * 128 + lane]; e1 = eid[(size_t)tn * 128 + 64 + lane];
#pragma unroll
        for (int q = 0; q < 4; ++q) xq[q] = *(const f32x4*)(xf + (size_t)tn * D + 128 * j + 16 * dch + 4 * q);
        float a0 = 0.f, a1 = 0.f;
#pragma unroll
        for (int i = 0; i < 16; ++i) { const float sa = gu_dot(ra[i], xs); if ((i & 7) == dch) { if (i < 8) a0 = sa; else a1 = sa; } }
        pj[(size_t)t * 128 + 8 * dch + e8] = a0; pj[(size_t)t * 128 + 64 + 8 * dch + e8] = a1;
    }
}
__device__ __forceinline__ void gu2_phase(Frame& F, const float* xf, const int* eid, float* part) {
    const int j = F.bx & 7, sg = F.bx >> 3, lane = F.lane, e8 = lane >> 3, dch = lane & 7;
    const __amdgpu_buffer_rsrc_t ub = __builtin_amdgcn_make_buffer_rsrc((void*)(F.ws + WS_UB + (size_t)j * ((size_t)16384 * 128)), (short)0, 16384 * 128, 0x00020000);
    float* pj = part + (size_t)j * T * 128; const int lo16 = 16 * dch;
    constexpr int TPW = T / (32 * NWAVES); const int tb = sg * (T / 32) + F.wave * TPW;
    int ea0 = eid[(size_t)tb * 128 + lane], ea1 = eid[(size_t)tb * 128 + 64 + lane], eb0 = eid[(size_t)(tb + 1) * 128 + lane], eb1 = eid[(size_t)(tb + 1) * 128 + 64 + lane];
#pragma unroll 1
    for (int it = 0; it < TPW / 2; ++it) { const int t0 = tb + 2 * it, t1 = t0 + 1;
        u32x4 ra[16], rb[16];
#pragma unroll
        for (int i = 0; i < 16; ++i) { const int ia = __shfl(i < 8 ? ea0 : ea1, (8 * i + e8) & 63), ib = __shfl(i < 8 ? eb0 : eb1, (8 * i + e8) & 63);
            ra[i] = __builtin_bit_cast(u32x4, __builtin_amdgcn_raw_buffer_load_b128(ub, ia * 128 + lo16, 0, 0)); rb[i] = __builtin_bit_cast(u32x4, __builtin_amdgcn_raw_buffer_load_b128(ub, ib * 128 + lo16, 0, 0)); }
        const int tn = (it + 1 < TPW / 2) ? t0 + 2 : t0;
        ea0 = eid[(size_t)tn * 128 + lane]; ea1 = eid[(size_t)tn * 128 + 64 + lane]; eb0 = eid[(size_t)(tn + 1) * 128 + lane]; eb1 = eid[(size_t)(tn + 1) * 128 + 64 + lane];
        float a0 = 0.f, a1 = 0.f, b0 = 0.f, b1 = 0.f;
        { f32x2 xs[8];
#pragma unroll
          for (int q = 0; q < 4; ++q) { const f32x4 x0 = *(const f32x4*)(xf + (size_t)t0 * D + 128 * j + 16 * dch + 4 * q) * (1.f / U_SCALE); xs[2 * q] = (f32x2){x0.x, x0.y}; xs[2 * q + 1] = (f32x2){x0.z, x0.w}; }
#pragma unroll
          for (int i = 0; i < 16; ++i) { const float sa = gu_dot(ra[i], xs); if ((i & 7) == dch) { if (i < 8) a0 = sa; else a1 = sa; } } }
        { f32x2 xs[8];
#pragma unroll
          for (int q = 0; q < 4; ++q) { const f32x4 x0 = *(const f32x4*)(xf + (size_t)t1 * D + 128 * j + 16 * dch + 4 * q) * (1.f / U_SCALE); xs[2 * q] = (f32x2){x0.x, x0.y}; xs[2 * q + 1] = (f32x2){x0.z, x0.w}; }
#pragma unroll
          for (int i = 0; i < 16; ++i) { const float sb = gu_dot(rb[i], xs); if ((i & 7) == dch) { if (i < 8) b0 = sb; else b1 = sb; } } }
        pj[(size_t)t0 * 128 + 8 * dch + e8] = a0; pj[(size_t)t0 * 128 + 64 + 8 * dch + e8] = a1; pj[(size_t)t1 * 128 + 8 * dch + e8] = b0; pj[(size_t)t1 * 128 + 64 + 8 * dch + e8] = b1;
    }
}
__device__ __forceinline__ void gr_phase(Frame& F, const float* part, float* gwt) {
    const size_t gt = (size_t)F.gw * 64 + F.lane, NGT = (size_t)F.NGW * 64;
    for (size_t i = gt; i < (size_t)T * 32; i += NGT) { f32x4 a = *(const f32x4*)(part + 4 * i);
#pragma unroll
        for (int jj = 1; jj < 8; ++jj) a += *(const f32x4*)(part + (size_t)jj * T * 128 + 4 * i);
        f32x4 g = *(const f32x4*)(gwt + 4 * i);
        g.x *= gelu_tanh(a.x) * (1.f / V_SCALE); g.y *= gelu_tanh(a.y) * (1.f / V_SCALE); g.z *= gelu_tanh(a.z) * (1.f / V_SCALE); g.w *= gelu_tanh(a.w) * (1.f / V_SCALE);
        *(f32x4*)(gwt + 4 * i) = g; }
}
__device__ __forceinline__ void gv_acc(f32x2 (&acc)[8], const u32x4& r, const float c) { const f32x2 c2 = {c, c};
    acc[0] += c2 * fp8lo(r.x); acc[1] += c2 * fp8hi(r.x); acc[2] += c2 * fp8lo(r.y); acc[3] += c2 * fp8hi(r.y); acc[4] += c2 * fp8lo(r.z); acc[5] += c2 * fp8hi(r.z); acc[6] += c2 * fp8lo(r.w); acc[7] += c2 * fp8hi(r.w); }
__device__ __forceinline__ void gv_phase(Frame& F, const float* xf, const int* eid, const float* coef, float* z, const unsigned char* vtab) {
    const int j = F.bx & 7, sg = F.bx >> 3, lane = F.lane, e8 = lane >> 3, dch = lane & 7;
    const unsigned char* Vb = vtab + (size_t)j * ((size_t)16384 * 128); const unsigned lo16 = 16u * dch;
    const bool b3 = lane & 8, b4 = lane & 16, b5 = lane & 32;
    const int dd = 128 * j + 16 * dch + 2 * ((b3 ? 4 : 0) + (b4 ? 2 : 0) + (b5 ? 1 : 0));
    constexpr int TPW = T / (32 * NWAVES); const int tb = sg * (T / 32) + F.wave * TPW;
    int e0 = eid[(size_t)tb * 128 + lane], e1 = eid[(size_t)tb * 128 + 64 + lane]; float c0 = coef[(size_t)tb * 128 + lane], c1 = coef[(size_t)tb * 128 + 64 + lane];
    f32x2 xr = *(const f32x2*)(xf + (size_t)tb * D + dd);
#pragma unroll 1
    for (int it = 0; it < TPW; ++it) { const int t = tb + it;
        u32x4 ra[16]; float cf[16];
#pragma unroll
        for (int i = 0; i < 16; ++i) { const int ia = __shfl(i < 8 ? e0 : e1, (8 * i + e8) & 63); ra[i] = *(const u32x4*)(Vb + ((unsigned)ia * 128u + lo16)); cf[i] = __shfl(i < 8 ? c0 : c1, (8 * i + e8) & 63); }
        const f32x2 xcur = xr; const int tn = (it + 1 < TPW) ? t + 1 : t;
        e0 = eid[(size_t)tn * 128 + lane]; e1 = eid[(size_t)tn * 128 + 64 + lane]; c0 = coef[(size_t)tn * 128 + lane]; c1 = coef[(size_t)tn * 128 + 64 + lane];
        xr = *(const f32x2*)(xf + (size_t)tn * D + dd);
        f32x2 acc[8];
#pragma unroll
        for (int m = 0; m < 8; ++m) acc[m] = (f32x2){0.f, 0.f};
#pragma unroll
        for (int i = 0; i < 16; ++i) gv_acc(acc, ra[i], cf[i]);
        f32x2 q[4], p[2], v;
#pragma unroll
        for (int i = 0; i < 4; ++i) { const f32x2 keep = b3 ? acc[4 + i] : acc[i], send = b3 ? acc[i] : acc[4 + i]; q[i] = keep + (f32x2){dpp_f<DPP_ROW_ROR(8)>(send.x), dpp_f<DPP_ROW_ROR(8)>(send.y)}; }
#pragma unroll
        for (int i = 0; i < 2; ++i) { const f32x2 keep = b4 ? q[2 + i] : q[i], send = b4 ? q[i] : q[2 + i]; p[i] = keep + (f32x2){__shfl_xor(send.x, 16), __shfl_xor(send.y, 16)}; }
        { const f32x2 keep = b5 ? p[1] : p[0], send = b5 ? p[0] : p[1]; v = keep + (f32x2){__shfl_xor(send.x, 32), __shfl_xor(send.y, 32)}; }
        *(f32x2*)(z + (size_t)t * D + dd) = xcur * ALPHA + v;
    }
}
__device__ __forceinline__ void ld_row8(const float* zrow, int lane, f32x4 (&v)[4]) {
#pragma unroll
    for (int j = 0; j < 2; ++j) { v[2 * j] = *(const f32x4*)(zrow + 8 * lane + 512 * j); v[2 * j + 1] = *(const f32x4*)(zrow + 8 * lane + 512 * j + 4); }
}
__device__ __forceinline__ void ln_row8(const f32x4 (&vin)[4], const float* g, const float* bb, int lane, f32x4 (&o)[4]) {
    f32x4 v[4]; float s = 0.f;
#pragma unroll
    for (int q = 0; q < 4; ++q) { v[q] = vin[q]; s += (v[q].x + v[q].y) + (v[q].z + v[q].w); }
    const float mean = wave_sum(s) * (1.f / D); float s2 = 0.f;
#pragma unroll
    for (int q = 0; q < 4; ++q) { v[q] = v[q] - mean; s2 += (v[q].x * v[q].x + v[q].y * v[q].y) + (v[q].z * v[q].z + v[q].w * v[q].w); }
    const float rstd = 1.f / sqrtf(wave_sum(s2) * (1.f / D) + LN_EPS);
#pragma unroll
    for (int q = 0; q < 4; ++q) { const int c = 8 * lane + 512 * (q >> 1) + 4 * (q & 1); o[q] = v[q] * rstd * *(const f32x4*)(g + c) + *(const f32x4*)(bb + c); }
}
__device__ __forceinline__ void lnmix_phase(Frame& F, const float* z, const float* g, const float* bb, float* xf, const float* mix, bf16_t* mx) {
    const int lane = F.lane;
    for (int blk = F.gw; blk < T / 8; blk += F.NGW) { const int t0 = blk * 8;
        f32x4 xp[4], zc[4], zn[4];
        ld_row8(z + (size_t)t0 * D, lane, zn);
        if ((t0 & (S - 1)) == 0) {
#pragma unroll
            for (int q = 0; q < 4; ++q) xp[q] = (f32x4){0.f, 0.f, 0.f, 0.f};
        } else { ld_row8(z + (size_t)(t0 - 1) * D, lane, zc); ln_row8(zc, g, bb, lane, xp); }
#pragma unroll 1
        for (int rr = 0; rr < 8; ++rr) { const int t = t0 + rr; f32x4 x[4];
#pragma unroll
            for (int q = 0; q < 4; ++q) zc[q] = zn[q];
            ld_row8(z + (size_t)(rr < 7 ? t + 1 : t) * D, lane, zn);
            ln_row8(zc, g, bb, lane, x);
#pragma unroll
            for (int q = 0; q < 4; ++q) *(f32x4*)(xf + (size_t)t * D + 8 * lane + 512 * (q >> 1) + 4 * (q & 1)) = x[q];
#pragma unroll
            for (int m = 0; m < 6; ++m)
#pragma unroll
                for (int j = 0; j < 2; ++j) { const int c = 8 * lane + 512 * j; const f32x4 m0 = *(const f32x4*)(mix + m * D + c), m1 = *(const f32x4*)(mix + m * D + c + 4);
                    const f32x4 o0 = x[2 * j] + (xp[2 * j] - x[2 * j]) * m0, o1 = x[2 * j + 1] + (xp[2 * j + 1] - x[2 * j + 1]) * m1;
                    u32x4 o; o.x = pk2(o0.x, o0.y); o.y = pk2(o0.z, o0.w); o.z = pk2(o1.x, o1.y); o.w = pk2(o1.z, o1.w);
                    *(u32x4*)(mx + (size_t)m * ((size_t)T * D) + (size_t)t * D + c) = o; }
#pragma unroll
            for (int q = 0; q < 4; ++q) xp[q] = x[q];
        }
    }
}
__device__ __forceinline__ void mix_phase(Frame& F, const float* mix) {
    const float* xf = (const float*)(F.ws + WS_XF); bf16_t* mx = (bf16_t*)(F.ws + WS_MIX);
    const size_t gt = (size_t)F.gw * 64 + F.lane, NGT = (size_t)F.NGW * 64;
    for (size_t i = gt; i < (size_t)T * (D / 8); i += NGT) {
        const int t = (int)(i >> 7), c = (int)(i & 127) * 8, s = t & (S - 1);
        const f32x4 x0 = *(const f32x4*)(xf + (size_t)t * D + c), x1 = *(const f32x4*)(xf + (size_t)t * D + c + 4);
        f32x4 p0 = {0.f, 0.f, 0.f, 0.f}, p1 = p0;
        if (s > 0) { p0 = *(const f32x4*)(xf + (size_t)(t - 1) * D + c); p1 = *(const f32x4*)(xf + (size_t)(t - 1) * D + c + 4); }
        const f32x4 d0 = p0 - x0, d1 = p1 - x1;
#pragma unroll
        for (int m = 0; m < 6; ++m) { const f32x4 m0 = *(const f32x4*)(mix + m * D + c), m1 = *(const f32x4*)(mix + m * D + c + 4); const f32x4 o0 = x0 + d0 * m0, o1 = x1 + d1 * m1;
            u32x4 o; o.x = pk2(o0.x, o0.y); o.y = pk2(o0.z, o0.w); o.z = pk2(o1.x, o1.y); o.w = pk2(o1.z, o1.w);
            *(u32x4*)(mx + (size_t)m * ((size_t)T * D) + (size_t)t * D + c) = o; }
    }
}
constexpr int RWL = 32, RW_NCH = S / RWL;
constexpr int PK_A2 = 0, PK_RT = 4096, PK_MBR = 8192, PK_BH = 10240, PK_N2 = 14336, PK_MKR = 16384, PK_KH = 18432, PK_VT = 22528, PK_GL = 26624, PK_BON = 26880, PK_BYTES = 27648;
constexpr size_t PK_BATCH = (size_t)1024 * PK_BYTES;
__device__ __forceinline__ unsigned char* pack_ptr(unsigned char* ws, float* out, int b, int hc) {
    unsigned char* base = b < 2 ? ws + 34 * MiB + (size_t)b * PK_BATCH : (b == 2 ? ws + 322 * MiB : (b < 6 ? ws + 414 * MiB + (size_t)(b - 3) * PK_BATCH : (unsigned char*)out + (size_t)(b - 6) * PK_BATCH));
    return base + (size_t)hc * PK_BYTES;
}
__device__ __forceinline__ bf16x8 frag_acc(const f32x16& x, const int s) {
    u32x4 w; w.x = cvt_pk_bf16_c(x[8 * s + 0], x[8 * s + 1]); w.y = cvt_pk_bf16_c(x[8 * s + 2], x[8 * s + 3]); w.z = cvt_pk_bf16_c(x[8 * s + 4], x[8 * s + 5]); w.w = cvt_pk_bf16_c(x[8 * s + 6], x[8 * s + 7]);
    return __builtin_bit_cast(bf16x8, w);
}
__device__ __forceinline__ float wave_sum_fast(float v) { v = sum16(v); v += __shfl_xor(v, 16); v += __shfl_xor(v, 32); return v; }

template <int DBGMODE = 0> __device__ __forceinline__ void rwprep_phase(Frame& F, const Args& args, const int nbatch) {
    const int lane0 = F.lane;
    LAS unsigned char* wl = F.lds + F.wave * 18432;
    const bf16_t* R = (const bf16_t*)(F.ws + WS_R); const bf16_t* Kt_ = (const bf16_t*)(F.ws + WS_K); const bf16_t* Vt_ = (const bf16_t*)(F.ws + WS_V);
    const bf16_t* AA = (const bf16_t*)(F.ws + WS_AA); const float* WD = (const float*)(F.ws + WS_WDEC);
    for (int it = F.gw; it < nbatch * NH * RW_NCH; it += F.NGW) {
        int lane = lane0; asm volatile("" : "+v"(lane));
        const int r = lane & 31, hh = lane >> 5;
        const int b = it / (NH * RW_NCH), hc = it % (NH * RW_NCH), h = hc / RW_NCH, c = hc % RW_NCH, ch = h * 64 + lane;
        unsigned char* pk = pack_ptr(F.ws, F.out, b, hc);
        const float kkc = args.in[22][ch], kac = args.in[23][ch], rkc = args.in[24][ch];
        const size_t tok0 = (size_t)b * S + (size_t)c * RWL;
        const int posj = 16 * (lane >> 4) + ((lane & 3) | ((lane & 4) << 1) | ((lane & 8) >> 1));
        float gam = 1.f, bon = 0.f;
#pragma unroll 1
        for (int blk = 0; blk < (DBGMODE == 1 ? 0 : 2); ++blk) {
            unsigned short rr[16], kr[16], ar[16]; float wv[16];
#pragma unroll
            for (int q = 0; q < 16; ++q) { const size_t off = (tok0 + 16 * blk + q) * D + ch; rr[q] = R[off]; kr[q] = Kt_[off]; ar[q] = AA[off]; wv[q] = WD[off]; }
#pragma unroll
            for (int q = 0; q < 16; ++q) { const int t = 16 * blk + q;
                const float rv = __builtin_bit_cast(float, (unsigned)rr[q] << 16), kv = __builtin_bit_cast(float, (unsigned)kr[q] << 16), al = __builtin_bit_cast(float, (unsigned)ar[q] << 16), w = wv[q];
                const float kkr = kv * kkc; const float ss = wave_sum_fast(kkr * kkr); const float kk = kkr / fmaxf(sqrtf(ss), 1e-12f);
                const float km = kv * (1.f + (al - 1.f) * kac);
                const float bs = wave_sum_fast(rv * km * rkc); bon = (lane == t) ? bs : bon;
                const float at = gam * (-kk); gam *= w; const float inv = 1.f / gam;
                const float bt = kk * al * inv, ktv = km * inv, rt = gam * rv;
                *(LAS bf16_t*)(wl + 0 + t * 144 + lane * 2) = (bf16_t)f2bf(at); *(LAS bf16_t*)(wl + 4608 + t * 144 + lane * 2) = (bf16_t)f2bf(bt);
                *(LAS bf16_t*)(wl + 9216 + t * 144 + lane * 2) = (bf16_t)f2bf(ktv); *(LAS bf16_t*)(wl + 13824 + t * 144 + lane * 2) = (bf16_t)f2bf(rt);
                *(bf16_t*)(pk + PK_RT + t * 128 + lane * 2) = (bf16_t)f2bf(rt);
            }
        }
        const float gamL = gam;
        *(float*)(pk + PK_GL + lane * 4) = gamL; if (lane < 32) *(float*)(pk + PK_BON + lane * 4) = bon;
#pragma unroll
        for (int m = 0; m < 4; ++m) { unsigned short e[8];
#pragma unroll
            for (int q = 0; q < 8; ++q) e[q] = Vt_[(tok0 + 8 * m + q) * D + ch];
            u32x4 o; o.x = e[0] | ((unsigned)e[1] << 16); o.y = e[2] | ((unsigned)e[3] << 16); o.z = e[4] | ((unsigned)e[5] << 16); o.w = e[6] | ((unsigned)e[7] << 16);
            *(u32x4*)(pk + PK_VT + lane * 64 + m * 16) = o; }
        LDS_WAIT(); asm volatile("" ::: "memory");
        bf16x8 idf[2];
#pragma unroll
        for (int s = 0; s < 2; ++s) { unsigned e[8];
#pragma unroll
            for (int j = 0; j < 8; ++j) e[j] = (r == 16 * s + 8 * hh + j) ? 0x3F80u : 0u;
            u32x4 w; w.x = e[0] | (e[1] << 16); w.y = e[2] | (e[3] << 16); w.z = e[4] | (e[5] << 16); w.w = e[6] | (e[7] << 16); idf[s] = __builtin_bit_cast(bf16x8, w); }
        bf16x8 xaf[2][2];
#pragma unroll
        for (int kt = 0; kt < 2; ++kt) {
            const int fo = r * 144 + (2 * kt) * 32 + hh * 16;
            f32x16 xb = F16ZERO, xk = F16ZERO, xa = F16ZERO;
            xb = mfma32(*(const LAS bf16x8*)(wl + 4608 + fo), idf[0], xb); xb = mfma32(*(const LAS bf16x8*)(wl + 4608 + fo + 32), idf[1], xb);
            xk = mfma32(*(const LAS bf16x8*)(wl + 9216 + fo), idf[0], xk); xk = mfma32(*(const LAS bf16x8*)(wl + 9216 + fo + 32), idf[1], xk);
            xa = mfma32(*(const LAS bf16x8*)(wl + 0 + fo), idf[0], xa); xa = mfma32(*(const LAS bf16x8*)(wl + 0 + fo + 32), idf[1], xa);
            xaf[kt][0] = frag_acc(xa, 0); xaf[kt][1] = frag_acc(xa, 1);
            const float gl = __shfl(gamL, 32 * kt + r);
#pragma unroll
            for (int g = 0; g < 4; ++g) {
                u32x2 w1; w1.x = pk2(xb[4 * g] * gl, xb[4 * g + 1] * gl); w1.y = pk2(xb[4 * g + 2] * gl, xb[4 * g + 3] * gl);
                *(u32x2*)(pk + PK_BH + kt * 2048 + (g * 64 + lane) * 8) = w1;
                u32x2 w2; w2.x = pk2(xk[4 * g] * gl, xk[4 * g + 1] * gl); w2.y = pk2(xk[4 * g + 2] * gl, xk[4 * g + 3] * gl);
                *(u32x2*)(pk + PK_KH + kt * 2048 + (g * 64 + lane) * 8) = w2; }
        }
        f32x16 pBA = F16ZERO, pBR = F16ZERO, pKR = F16ZERO, qAK = F16ZERO;
#pragma unroll
        for (int ks = 0; ks < 4; ++ks) {
            const int fo = r * 144 + ks * 32 + hh * 16;
            const bf16x8 fA = *(const LAS bf16x8*)(wl + 0 + fo), fB = *(const LAS bf16x8*)(wl + 4608 + fo), fK = *(const LAS bf16x8*)(wl + 9216 + fo), fR = *(const LAS bf16x8*)(wl + 13824 + fo);
            pBA = mfma32(fB, fA, pBA);
            pBR = mfma32(fB, fR, pBR);
            pKR = mfma32(fK, fR, pKR);
            qAK = mfma32(fA, fK, qAK);
        }
        LDS_WAIT(); asm volatile("" ::: "memory");
#pragma unroll
        for (int g = 0; g < 4; ++g) {
            float mb[4], mkv[4];
#pragma unroll
            for (int d = 0; d < 4; ++d) { const int reg = 4 * g + d, row = d + 8 * g + 4 * hh;
                *(LAS float*)(wl + 13824 + row * 144 + r * 4) = (row < r) ? pBA[reg] : 0.f;
                mb[d] = (row <= r) ? pBR[reg] : 0.f; mkv[d] = (row <= r) ? pKR[reg] : 0.f;
                qAK[reg] = (r < row) ? qAK[reg] : 0.f; }
            u32x2 w1; w1.x = pk2(mb[0], mb[1]); w1.y = pk2(mb[2], mb[3]); *(u32x2*)(pk + PK_MBR + (g * 64 + lane) * 8) = w1;
            u32x2 w2; w2.x = pk2(mkv[0], mkv[1]); w2.y = pk2(mkv[2], mkv[3]); *(u32x2*)(pk + PK_MKR + (g * 64 + lane) * 8) = w2;
        }
        *(LAS bf16x8*)(wl + lane * 96) = frag_acc(qAK, 0); *(LAS bf16x8*)(wl + lane * 96 + 16) = frag_acc(qAK, 1);
        *(LAS bf16x8*)(wl + lane * 96 + 32) = xaf[0][0]; *(LAS bf16x8*)(wl + lane * 96 + 48) = xaf[0][1]; *(LAS bf16x8*)(wl + lane * 96 + 64) = xaf[1][0]; *(LAS bf16x8*)(wl + lane * 96 + 80) = xaf[1][1];
        LDS_WAIT(); asm volatile("" ::: "memory");
        float tt[32]; if (DBGMODE == 2) {
#pragma unroll
            for (int i = 0; i < 32; ++i) tt[i] = 0.f; }
        int lmo = 13824;
#pragma unroll
        for (int cc = 31; cc >= (DBGMODE == 2 ? 31 : 0); --cc) { float acc = (r == cc) ? 1.f : 0.f;
            if (cc < 31 && (cc & 1)) asm volatile("" : "+v"(lmo) : "v"(tt[cc + 1]));
#pragma unroll
            for (int q4 = 0; q4 < 8; ++q4) { if (4 * q4 + 3 > cc) { const f32x4 lm = *(const LAS f32x4*)(wl + lmo + cc * 144 + q4 * 16);
#pragma unroll
                for (int d = 0; d < 4; ++d) { const int i = 4 * q4 + d; if (i > cc) acc += tt[i] * lm[d]; } } }
            tt[cc] = acc; }
        f32x16 a2t0 = F16ZERO, a2t1 = F16ZERO, n2t = F16ZERO;
#pragma unroll
        for (int s = 0; s < 2; ++s) {
            float p[8];
#pragma unroll
            for (int j = 0; j < 8; ++j) p[j] = hh ? tt[16 * s + 8 * (j >> 2) + 4 + (j & 3)] : tt[16 * s + 8 * (j >> 2) + (j & 3)];
            u32x4 wp; wp.x = pk2(p[0], p[1]); wp.y = pk2(p[2], p[3]); wp.z = pk2(p[4], p[5]); wp.w = pk2(p[6], p[7]);
            const bf16x8 fTp = __builtin_bit_cast(bf16x8, wp);
            a2t0 = mfma32(*(const LAS bf16x8*)(wl + lane * 96 + 32 + 16 * s), fTp, a2t0); a2t1 = mfma32(*(const LAS bf16x8*)(wl + lane * 96 + 64 + 16 * s), fTp, a2t1);
            n2t = mfma32(*(const LAS bf16x8*)(wl + lane * 96 + 16 * s), fTp, n2t);
        }
#pragma unroll
        for (int g = 0; g < 4; ++g) {
            u32x2 w0; w0.x = pk2(a2t0[4 * g], a2t0[4 * g + 1]); w0.y = pk2(a2t0[4 * g + 2], a2t0[4 * g + 3]);
            u32x2 w1; w1.x = pk2(a2t1[4 * g], a2t1[4 * g + 1]); w1.y = pk2(a2t1[4 * g + 2], a2t1[4 * g + 3]);
            *(u32x2*)(pk + PK_A2 + (g * 64 + lane) * 8) = w0;
            *(u32x2*)(pk + PK_A2 + 2048 + (g * 64 + lane) * 8) = w1;
            u32x2 w2; w2.x = pk2(n2t[4 * g], n2t[4 * g + 1]); w2.y = pk2(n2t[4 * g + 2], n2t[4 * g + 3]);
            *(u32x2*)(pk + PK_N2 + (g * 64 + lane) * 8) = w2;
        }
        LDS_WAIT(); asm volatile("" ::: "memory");
    }
}

constexpr int SC_OBUF = 4 * PK_BYTES, SC_BON = SC_OBUF + 2 * 8192;
template <int DBGMODE = 0> __device__ __forceinline__ void rwscan2_phase(Frame& F, const Args& args, bf16_t* OG, const int nbatch) {
    const int bx = F.bx;
    if (bx >= nbatch * NH) {
        if (bx >= 128) { const size_t w = (size_t)(bx - 128) * NTHREADS + F.tid, nw = (size_t)(F.G - 128) * NTHREADS;
            cvt_stream_fp8(args.in[30] + (size_t)16384 * D, F.ws + WS_UB1, (size_t)16384 * D / 16, w, nw, U_SCALE); cvt_stream_fp8(args.in[31] + (size_t)16384 * D, F.ws + WS_VB1, (size_t)16384 * D / 16, w, nw, V_SCALE); }
        return; }
    const int b = bx >> 4, h = bx & 15, lane = F.lane, r = lane & 31, hh = lane >> 5, wave = F.wave;
    const bf16_t* Vt_ = (const bf16_t*)(F.ws + WS_V); const bf16_t* G = (const bf16_t*)(F.ws + WS_G);
    const unsigned char* pk0 = pack_ptr(F.ws, F.out, b, h * RW_NCH);
    LAS unsigned char* lds = F.lds;
    const int dp0 = wave == 6 ? 0 : 14, dpn = wave == 6 ? 14 : 13;
#define SC_DMA(chunk) do { const unsigned char* src_ = pk0 + (size_t)(chunk) * PK_BYTES + lane * 16; LAS unsigned char* dst_ = lds + ((chunk) & 3) * PK_BYTES; \
        _Pragma("unroll") for (int p_ = 0; p_ < 14; ++p_) if (p_ < dpn) __builtin_amdgcn_global_load_lds((const unsigned*)(src_ + (dp0 + p_) * 1024), (LAS unsigned*)(dst_ + (dp0 + p_) * 1024), 16, 0, 0); } while (0)
#define SC_WAIT(k) do { if (wave == 6) { if ((k) == 2) asm volatile("s_waitcnt vmcnt(28)" ::: "memory"); else if ((k) == 1) asm volatile("s_waitcnt vmcnt(14)" ::: "memory"); else asm volatile("s_waitcnt vmcnt(0)" ::: "memory"); } \
        else { if ((k) == 2) asm volatile("s_waitcnt vmcnt(26)" ::: "memory"); else if ((k) == 1) asm volatile("s_waitcnt vmcnt(13)" ::: "memory"); else asm volatile("s_waitcnt vmcnt(0)" ::: "memory"); } } while (0)
    f32x16 Z0 = F16ZERO, Z1 = F16ZERO;
    const int eu0 = ((wave - 2) & 3) * 64 + lane, eu1 = eu0 + 256;
    u32x2 ev0 = {0u, 0u}, eg0 = ev0, ev1 = ev0, eg1 = ev0; f32x4 elg0 = {0.f, 0.f, 0.f, 0.f}, elb0 = elg0, elg1 = elg0, elb1 = elg0;
    if (wave >= 2 && wave < 6) { elg0 = *(const f32x4*)(args.in[25] + h * 64 + 4 * (eu0 & 15)); elb0 = *(const f32x4*)(args.in[26] + h * 64 + 4 * (eu0 & 15)); elg1 = *(const f32x4*)(args.in[25] + h * 64 + 4 * (eu1 & 15)); elb1 = *(const f32x4*)(args.in[26] + h * 64 + 4 * (eu1 & 15)); }
    if (wave >= 6) { SC_DMA(0); SC_DMA(1); SC_DMA(2); SC_WAIT(2); }
    asm volatile("" ::: "memory"); __builtin_amdgcn_s_barrier(); asm volatile("" ::: "memory");
    for (int c = 0; c <= RW_NCH; ++c) {
        if (wave >= 6) {
            if (DBGMODE == 1) {} else
            if (c + 3 < RW_NCH) { SC_DMA(c + 3); SC_WAIT(2); } else if (c + 2 < RW_NCH) { SC_WAIT(1); } else { SC_WAIT(0); }
        } else if (wave < 2) {
            if (c < RW_NCH && DBGMODE != 2) {
                const LAS unsigned char* sl = lds + (c & 3) * PK_BYTES; const int vh = wave;
                const bf16x8 zb0 = frag_acc(Z0, 0), zb1 = frag_acc(Z0, 1), zb2 = frag_acc(Z1, 0), zb3 = frag_acc(Z1, 1);
#define FR_ACC(off, s_) ({ const u32x2 lo_ = *(const LAS u32x2*)(sl + (off) + ((2 * (s_)) * 64 + lane) * 8), hi_ = *(const LAS u32x2*)(sl + (off) + ((2 * (s_) + 1) * 64 + lane) * 8); __builtin_bit_cast(bf16x8, (u32x4){lo_.x, lo_.y, hi_.x, hi_.y}); })
#define FR_NAT(off, rowbytes, row_, s_) ({ const u32x2 lo_ = *(const LAS u32x2*)(sl + (off) + (row_) * (rowbytes) + 2 * (16 * (s_) + 4 * hh)), hi_ = *(const LAS u32x2*)(sl + (off) + (row_) * (rowbytes) + 2 * (16 * (s_) + 8 + 4 * hh)); __builtin_bit_cast(bf16x8, (u32x4){lo_.x, lo_.y, hi_.x, hi_.y}); })
                const bf16x8 vt0 = FR_NAT(PK_VT, 64, 32 * vh + r, 0), vt1 = FR_NAT(PK_VT, 64, 32 * vh + r, 1);
                f32x16 U = F16ZERO, O = F16ZERO;
                U = mfma32(FR_ACC(PK_A2, 0), zb0, U); U = mfma32(FR_ACC(PK_A2, 1), zb1, U); U = mfma32(FR_ACC(PK_A2 + 2048, 0), zb2, U); U = mfma32(FR_ACC(PK_A2 + 2048, 1), zb3, U);
                U = mfma32(FR_ACC(PK_N2, 0), vt0, U); U = mfma32(FR_ACC(PK_N2, 1), vt1, U);
                O = mfma32(FR_NAT(PK_RT, 128, r, 0), zb0, O); O = mfma32(FR_NAT(PK_RT, 128, r, 1), zb1, O); O = mfma32(FR_NAT(PK_RT, 128, r, 2), zb2, O); O = mfma32(FR_NAT(PK_RT, 128, r, 3), zb3, O);
                O = mfma32(FR_ACC(PK_MKR, 0), vt0, O); O = mfma32(FR_ACC(PK_MKR, 1), vt1, O);
                const bf16x8 ub0 = frag_acc(U, 0), ub1 = frag_acc(U, 1);
                O = mfma32(FR_ACC(PK_MBR, 0), ub0, O); O = mfma32(FR_ACC(PK_MBR, 1), ub1, O);
#pragma unroll
                for (int g = 0; g < 4; ++g) { const f32x4 g0 = *(const LAS f32x4*)(sl + PK_GL + 4 * (8 * g + 4 * hh)), g1 = *(const LAS f32x4*)(sl + PK_GL + 4 * (32 + 8 * g + 4 * hh));
#pragma unroll
                    for (int d = 0; d < 4; ++d) { Z0[4 * g + d] *= g0[d]; Z1[4 * g + d] *= g1[d]; } }
                Z0 = mfma32(FR_ACC(PK_BH, 0), ub0, Z0); Z0 = mfma32(FR_ACC(PK_BH, 1), ub1, Z0); Z0 = mfma32(FR_ACC(PK_KH, 0), vt0, Z0); Z0 = mfma32(FR_ACC(PK_KH, 1), vt1, Z0);
                Z1 = mfma32(FR_ACC(PK_BH + 2048, 0), ub0, Z1); Z1 = mfma32(FR_ACC(PK_BH + 2048, 1), ub1, Z1); Z1 = mfma32(FR_ACC(PK_KH + 2048, 0), vt0, Z1); Z1 = mfma32(FR_ACC(PK_KH + 2048, 1), vt1, Z1);
#undef FR_ACC
#undef FR_NAT
                LAS float* ob = (LAS float*)(lds + SC_OBUF + (c & 1) * 8192);
#pragma unroll
                for (int reg = 0; reg < 16; ++reg) ob[((reg & 3) + 8 * (reg >> 2) + 4 * hh) * 64 + 32 * vh + r] = O[reg];
                if (vh == 0 && lane < 32) ((LAS float*)(lds + SC_BON))[(c & 1) * 32 + lane] = *(const LAS float*)(sl + PK_BON + lane * 4);
            }
        } else {
            u32x2 nv0 = ev0, ng0 = eg0, nv1 = ev1, ng1 = eg1;
            if (c < RW_NCH) { const size_t o0 = ((size_t)b * S + (size_t)c * RWL + (eu0 >> 4)) * D + h * 64 + 4 * (eu0 & 15), o1 = ((size_t)b * S + (size_t)c * RWL + (eu1 >> 4)) * D + h * 64 + 4 * (eu1 & 15);
                nv0 = *(const u32x2*)(Vt_ + o0); ng0 = *(const u32x2*)(G + o0); nv1 = *(const u32x2*)(Vt_ + o1); ng1 = *(const u32x2*)(G + o1); }
            if (c >= 1 && DBGMODE != 3) {
                const LAS float* ob = (const LAS float*)(lds + SC_OBUF + ((c - 1) & 1) * 8192); const LAS float* bn = (const LAS float*)(lds + SC_BON) + ((c - 1) & 1) * 32;
#pragma unroll
                for (int k2 = 0; k2 < 2; ++k2) { const int u = k2 ? eu1 : eu0, t = u >> 4, q = u & 15, c4 = h * 64 + 4 * q; const size_t off = ((size_t)b * S + (size_t)(c - 1) * RWL + t) * D + c4;
                    const f32x4 o4 = *(const LAS f32x4*)(ob + t * 64 + 4 * q); const float bs = bn[t];
                    const u32x2 vw = k2 ? ev1 : ev0, gw_ = k2 ? eg1 : eg0; const f32x4 lg4 = k2 ? elg1 : elg0, lb4 = k2 ? elb1 : elb0;
                    float sm = (o4.x + o4.y) + (o4.z + o4.w); sm = sum16(sm); const float mu = sm * (1.f / 64.f); const f32x4 dd = o4 - mu;
                    float vs = (dd.x * dd.x + dd.y * dd.y) + (dd.z * dd.z + dd.w * dd.w); vs = sum16(vs); const float rs = 1.f / sqrtf(vs * (1.f / 64.f) + 64e-5f);
                    const f32x4 v4 = {bf_lo(vw.x), bf_hi(vw.x), bf_lo(vw.y), bf_hi(vw.y)}, g4 = {bf_lo(gw_.x), bf_hi(gw_.x), bf_lo(gw_.y), bf_hi(gw_.y)};
                    const f32x4 res = (dd * rs * lg4 + lb4 + v4 * bs) * g4;
                    u32x2 w; w.x = pk2(res.x, res.y); w.y = pk2(res.z, res.w); *(u32x2*)(OG + off) = w; }
            }
            ev0 = nv0; eg0 = ng0; ev1 = nv1; eg1 = ng1;
        }
        asm volatile("s_waitcnt lgkmcnt(0)" ::: "memory");
        __builtin_amdgcn_s_barrier();
        asm volatile("" ::: "memory");
    }
#undef SC_DMA
#undef SC_WAIT
}
}
namespace mk {
constexpr int NPH = 26;
#ifndef MK_NBATCH
#define MK_NBATCH 8
#endif
#ifndef MK_MASK
#define MK_MASK 0xFFFFFFFFull
#endif
#ifndef MK_REP
#define MK_REP 0ull
#endif
#ifndef MK_NREP
#define MK_NREP 2
#endif
#ifndef MK_SCANDBG
#define MK_SCANDBG 0
#endif
__global__ void __launch_bounds__(NTHREADS, 2) mk_fwd(Args args) {
    extern __shared__ __attribute__((aligned(16))) unsigned char lds_raw[];
    { volatile LAS unsigned* M0 = (volatile LAS unsigned*)((LAS unsigned char*)lds_raw + MISC_OFF); if (threadIdx.x < 64) M0[threadIdx.x] = 0u; }
    __syncthreads();
    const int lo = args.ph_lo, hi = args.ph_hi;
    const int wave0 = __builtin_amdgcn_readfirstlane((int)threadIdx.x >> 6);
    if (hi - lo > 1) (void)xcd_barrier_post((unsigned*)(args.ws + WS_CTL) + CW_BAR, (volatile LAS unsigned*)((LAS unsigned char*)lds_raw + MISC_OFF) + 8);
#define MKFRAME() \
        int lane_ = lane_id(), bx_ = blockIdx.x; asm volatile("" : "+v"(lane_)); asm volatile("" : "+s"(bx_)); \
        Frame F; F.lds = (LAS unsigned char*)lds_raw; F.MISC = (volatile LAS unsigned*)(F.lds + MISC_OFF); \
        F.lane = lane_; F.wave = wave0; F.tid = wave0 * 64 + lane_; F.bx = bx_; \
        F.G = gridDim.x; F.vcu = (F.G % 8 == 0) ? (bx_ % 8) * (F.G / 8) + bx_ / 8 : bx_; \
        F.gw = F.vcu * NWAVES + F.wave; F.NGW = F.G * NWAVES; \
        F.ws = args.ws; F.ctl = (unsigned*)(args.ws + WS_CTL); F.out = args.out; unsigned char* ws = F.ws; (void)ws;
#define INP(k) (args.in[k])
#define IN(k) (((MK_MASK >> (k)) & 1) && lo <= (k) && (k) < hi)
#define FORCE_BAR() do { XcdBarrier bar; bar.bar = (unsigned*)(args.ws + WS_CTL) + CW_BAR; bar.x = xb_xcc_id(); bar.st = (volatile LAS unsigned*)((LAS unsigned char*)lds_raw + MISC_OFF) + 8; xcd_barrier(bar, wave0 == 0 && lane_id() == 0); } while (0)
#define SEAM(k) do { if (lo <= (k) && (k) + 1 < hi) FORCE_BAR(); } while (0)
    if (IN(0)) { MKFRAME() asm volatile("; PHASE_BEGIN 0"); p0_prologue(F, args); }
    SEAM(0);
    if (((MK_REP >> 0) & 1) && IN(0)) { for (int rep_ = 0; rep_ < MK_NREP; ++rep_) { { MKFRAME() p0_prologue(F, args); } FORCE_BAR(); } }
    if (IN(1)) { MKFRAME() asm volatile("; PHASE_BEGIN 1"); { ProbPlain P{(const char*)(ws + WS_X0B), (const char*)(ws + WS_WIN), (size_t)256 * D * 2, (size_t)256 * D * 2}; EpiWin E{(bf16_t*)(ws + WS_GATE), (bf16_t*)(ws + WS_H2)}; run_gemm(F, 64, 11, D, D, D, P, E); } }
    SEAM(1);
    if (((MK_REP >> 1) & 1) && IN(1)) { for (int rep_ = 0; rep_ < MK_NREP; ++rep_) { { MKFRAME() { ProbPlain P{(const char*)(ws + WS_X0B), (const char*)(ws + WS_WIN), (size_t)256 * D * 2, (size_t)256 * D * 2}; EpiWin E{(bf16_t*)(ws + WS_GATE), (bf16_t*)(ws + WS_H2)}; run_gemm(F, 64, 11, D, D, D, P, E); } } FORCE_BAR(); } }
    if (IN(2)) { MKFRAME() asm volatile("; PHASE_BEGIN 2"); conv_phase(F, INP(2), INP(3)); }
    SEAM(2);
    if (((MK_REP >> 2) & 1) && IN(2)) { for (int rep_ = 0; rep_ < MK_NREP; ++rep_) { { MKFRAME() conv_phase(F, INP(2), INP(3)); } FORCE_BAR(); } }
    if (IN(3)) { MKFRAME() asm volatile("; PHASE_BEGIN 3"); { ProbGates P{(const char*)(ws + WS_XC), (const char*)(ws + WS_WG)}; EpiGates E{(const bf16_t*)(ws + WS_XC), (const float*)(ws + WS_VEC), INP(5), INP(7), (bf16_t*)(ws + WS_A), (bf16_t*)(ws + WS_U)}; run_gemm(F, 64, 11, W, 384, 384, P, E); } }
    SEAM(3);
    if (((MK_REP >> 3) & 1) && IN(3)) { for (int rep_ = 0; rep_ < MK_NREP; ++rep_) { { MKFRAME() { ProbGates P{(const char*)(ws + WS_XC), (const char*)(ws + WS_WG)}; EpiGates E{(const bf16_t*)(ws + WS_XC), (const float*)(ws + WS_VEC), INP(5), INP(7), (bf16_t*)(ws + WS_A), (bf16_t*)(ws + WS_U)}; run_gemm(F, 64, 11, W, 384, 384, P, E); } } FORCE_BAR(); } }
    if (IN(4)) { MKFRAME() asm volatile("; PHASE_BEGIN 4"); rgscan1_phase(F); }
    SEAM(4);
    if (((MK_REP >> 4) & 1) && IN(4)) { for (int rep_ = 0; rep_ < MK_NREP; ++rep_) { { MKFRAME() rgscan1_phase(F); } FORCE_BAR(); } }
    if (IN(5)) { MKFRAME() asm volatile("; PHASE_BEGIN 5"); rgscan2_phase(F); }
    SEAM(5);
    if (((MK_REP >> 5) & 1) && IN(5)) { for (int rep_ = 0; rep_ < MK_NREP; ++rep_) { { MKFRAME() rgscan2_phase(F); } FORCE_BAR(); } }
    if (IN(6)) { MKFRAME() asm volatile("; PHASE_BEGIN 6"); { ProbPlain P{(const char*)(ws + WS_Y), (const char*)(ws + WS_WOUT), (size_t)256 * W * 2, (size_t)256 * W * 2}; EpiRes E{INP(0), (float*)(ws + WS_Z0)}; run_gemm(F, 64, 4, W, W, W, P, E); } }
    SEAM(6);
    if (((MK_REP >> 6) & 1) && IN(6)) { for (int rep_ = 0; rep_ < MK_NREP; ++rep_) { { MKFRAME() { ProbPlain P{(const char*)(ws + WS_Y), (const char*)(ws + WS_WOUT), (size_t)256 * W * 2, (size_t)256 * W * 2}; EpiRes E{INP(0), (float*)(ws + WS_Z0)}; run_gemm(F, 64, 4, W, W, W, P, E); } } FORCE_BAR(); } }
    if (IN(7)) { MKFRAME() asm volatile("; PHASE_BEGIN 7"); ln_phase(F, (const float*)(ws + WS_Z0), INP(32), INP(33), (float*)(ws + WS_XF), (bf16_t*)(ws + WS_XB0)); }
    SEAM(7);
    if (((MK_REP >> 7) & 1) && IN(7)) { for (int rep_ = 0; rep_ < MK_NREP; ++rep_) { { MKFRAME() ln_phase(F, (const float*)(ws + WS_Z0), INP(32), INP(33), (float*)(ws + WS_XF), (bf16_t*)(ws + WS_XB0)); } FORCE_BAR(); } }
    if (IN(8)) { MKFRAME() asm volatile("; PHASE_BEGIN 8"); { ProbPlain P{(const char*)(ws + WS_XB0), (const char*)(ws + WS_WPEER), (size_t)256 * D * 2, (size_t)256 * D * 2}; EpiScores E{(unsigned*)(ws + WS_SC0)}; run_gemm(F, 64, 8, D, D, D, P, E); } }
    SEAM(8);
    if (((MK_REP >> 8) & 1) && IN(8)) { for (int rep_ = 0; rep_ < MK_NREP; ++rep_) { { MKFRAME() { ProbPlain P{(const char*)(ws + WS_XB0), (const char*)(ws + WS_WPEER), (size_t)256 * D * 2, (size_t)256 * D * 2}; EpiScores E{(unsigned*)(ws + WS_SC0)}; run_gemm(F, 64, 8, D, D, D, P, E); } } FORCE_BAR(); } }
    if (IN(9)) { MKFRAME() asm volatile("; PHASE_BEGIN 9"); topk_phase(F, (const unsigned*)(ws + WS_SC0), (int*)(ws + WS_EID0), (float*)(ws + WS_GW0)); }
    SEAM(9);
    if (((MK_REP >> 9) & 1) && IN(9)) { for (int rep_ = 0; rep_ < MK_NREP; ++rep_) { { MKFRAME() topk_phase(F, (const unsigned*)(ws + WS_SC0), (int*)(ws + WS_EID0), (float*)(ws + WS_GW0)); } FORCE_BAR(); } }
    if (IN(10)) { MKFRAME() asm volatile("; PHASE_BEGIN 10"); gu_phase(F, (const float*)(ws + WS_XF), (const int*)(ws + WS_EID0), (float*)(ws + WS_PART0), ws + WS_UB); }
    SEAM(10);
    if (((MK_REP >> 10) & 1) && IN(10)) { for (int rep_ = 0; rep_ < MK_NREP; ++rep_) { { MKFRAME() gu_phase(F, (const float*)(ws + WS_XF), (const int*)(ws + WS_EID0), (float*)(ws + WS_PART0), ws + WS_UB); } FORCE_BAR(); } }
    if (IN(11)) { MKFRAME() asm volatile("; PHASE_BEGIN 11"); gr_phase(F, (const float*)(ws + WS_PART0), (float*)(ws + WS_GW0)); }
    SEAM(11);
    if (IN(12)) { MKFRAME() asm volatile("; PHASE_BEGIN 12"); gv_phase(F, (const float*)(ws + WS_XF), (const int*)(ws + WS_EID0), (const float*)(ws + WS_GW0), (float*)(ws + WS_ZP0), ws + WS_VB); }
    SEAM(12);
    if (((MK_REP >> 12) & 1) && IN(12)) { for (int rep_ = 0; rep_ < MK_NREP; ++rep_) { { MKFRAME() gv_phase(F, (const float*)(ws + WS_XF), (const int*)(ws + WS_EID0), (const float*)(ws + WS_GW0), (float*)(ws + WS_ZP0), ws + WS_VB); } FORCE_BAR(); } }
    if (IN(13)) { MKFRAME() asm volatile("; PHASE_BEGIN 13"); lnmix_phase(F, (const float*)(ws + WS_ZP0), INP(32) + D, INP(33) + D, (float*)(ws + WS_XF), INP(10), (bf16_t*)(ws + WS_MIX)); }
    SEAM(13);
    if (((MK_REP >> 13) & 1) && IN(13)) { for (int rep_ = 0; rep_ < MK_NREP; ++rep_) { { MKFRAME() lnmix_phase(F, (const float*)(ws + WS_ZP0), INP(32) + D, INP(33) + D, (float*)(ws + WS_XF), INP(10), (bf16_t*)(ws + WS_MIX)); } FORCE_BAR(); } }
    if (IN(14)) { MKFRAME() asm volatile("; PHASE_BEGIN 14"); { ProbRkv P{(const char*)(ws + WS_MIX), (const char*)(ws + WS_WRKV)}; EpiRkv E{(bf16_t*)(ws + WS_R), (bf16_t*)(ws + WS_LORA)}; run_gemm(F, 64, 15, D, D, D, P, E); } }
    SEAM(14);
    if (((MK_REP >> 14) & 1) && IN(14)) { for (int rep_ = 0; rep_ < MK_NREP; ++rep_) { { MKFRAME() { ProbRkv P{(const char*)(ws + WS_MIX), (const char*)(ws + WS_WRKV)}; EpiRkv E{(bf16_t*)(ws + WS_R), (bf16_t*)(ws + WS_LORA)}; run_gemm(F, 64, 15, D, D, D, P, E); } } FORCE_BAR(); } }
    if (IN(15)) { MKFRAME() asm volatile("; PHASE_BEGIN 15"); { ProbPlain P{(const char*)(ws + WS_LORA), (const char*)(ws + WS_WL2), (size_t)256 * 256 * 2, (size_t)256 * 256 * 2}; EpiLora2 E{(float*)(ws + WS_WDEC), (bf16_t*)(ws + WS_AA), INP(14), INP(17), 0}; static_assert(WS_G == WS_AA + (size_t)T * D * 2, "g follows aa"); run_gemm(F, 64, 12, 256, 256, 256, P, E); } }
    SEAM(15);
    if (((MK_REP >> 15) & 1) && IN(15)) { for (int rep_ = 0; rep_ < MK_NREP; ++rep_) { { MKFRAME() { ProbPlain P{(const char*)(ws + WS_LORA), (const char*)(ws + WS_WL2), (size_t)256 * 256 * 2, (size_t)256 * 256 * 2}; EpiLora2 E{(float*)(ws + WS_WDEC), (bf16_t*)(ws + WS_AA), INP(14), INP(17), MK_SCANDBG}; run_gemm(F, 64, 12, 256, 256, 256, P, E); } } FORCE_BAR(); } }
    if (((MK_REP >> 16) & 1) && IN(16)) { for (int rep_ = 0; rep_ < MK_NREP; ++rep_) { { MKFRAME() rwprep_phase<MK_SCANDBG>(F, args, MK_NBATCH); } FORCE_BAR(); } }
    if (IN(16)) { MKFRAME() asm volatile("; PHASE_BEGIN 16"); rwprep_phase(F, args, MK_NBATCH); }
    SEAM(16);
    if (IN(17)) { MKFRAME() asm volatile("; PHASE_BEGIN 17"); rwscan2_phase(F, args, (bf16_t*)(ws + WS_OG), MK_NBATCH); }
    SEAM(17);
    if (((MK_REP >> 17) & 1) && IN(17)) { for (int rep_ = 0; rep_ < MK_NREP; ++rep_) { { MKFRAME() rwscan2_phase<MK_SCANDBG>(F, args, (bf16_t*)(ws + WS_XB1), MK_NBATCH); } FORCE_BAR(); } }
    if (IN(18)) { MKFRAME() asm volatile("; PHASE_BEGIN 18"); { ProbPlain P{(const char*)(ws + WS_OG), (const char*)(ws + WS_WO), (size_t)256 * D * 2, (size_t)256 * D * 2}; EpiRes E{(const float*)(ws + WS_XF), (float*)(ws + WS_Z1)}; run_gemm(F, 64, 4, D, D, D, P, E); } }
    SEAM(18);
    if (((MK_REP >> 18) & 1) && IN(18)) { for (int rep_ = 0; rep_ < MK_NREP; ++rep_) { { MKFRAME() { ProbPlain P{(const char*)(ws + WS_OG), (const char*)(ws + WS_WO), (size_t)256 * D * 2, (size_t)256 * D * 2}; EpiRes E{(const float*)(ws + WS_XF), (float*)(ws + WS_Z1)}; run_gemm(F, 64, 4, D, D, D, P, E); } } FORCE_BAR(); } }
    if (IN(19)) { MKFRAME() asm volatile("; PHASE_BEGIN 19"); ln_phase(F, (const float*)(ws + WS_Z1), INP(32) + 2 * D, INP(33) + 2 * D, (float*)(ws + WS_XF), (bf16_t*)(ws + WS_XB1)); }
    SEAM(19);
    if (((MK_REP >> 19) & 1) && IN(19)) { for (int rep_ = 0; rep_ < MK_NREP; ++rep_) { { MKFRAME() ln_phase(F, (const float*)(ws + WS_Z1), INP(32) + 2 * D, INP(33) + 2 * D, (float*)(ws + WS_XF), (bf16_t*)(ws + WS_XB1)); } FORCE_BAR(); } }
    if (IN(20)) { MKFRAME() asm volatile("; PHASE_BEGIN 20"); { ProbPlain P{(const char*)(ws + WS_XB1), (const char*)(ws + WS_WPEER + (size_t)2048 * D * 2), (size_t)256 * D * 2, (size_t)256 * D * 2}; EpiScores E{(unsigned*)(ws + WS_SC1)}; run_gemm(F, 64, 8, D, D, D, P, E); } }
    SEAM(20);
    if (((MK_REP >> 20) & 1) && IN(20)) { for (int rep_ = 0; rep_ < MK_NREP; ++rep_) { { MKFRAME() { ProbPlain P{(const char*)(ws + WS_XB1), (const char*)(ws + WS_WPEER + (size_t)2048 * D * 2), (size_t)256 * D * 2, (size_t)256 * D * 2}; EpiScores E{(unsigned*)(ws + WS_SC1)}; run_gemm(F, 64, 8, D, D, D, P, E); } } FORCE_BAR(); } }
    if (IN(21)) { MKFRAME() asm volatile("; PHASE_BEGIN 21"); topk_phase(F, (const unsigned*)(ws + WS_SC1), (int*)(ws + WS_EID1), (float*)(ws + WS_GW1)); }
    SEAM(21);
    if (((MK_REP >> 21) & 1) && IN(21)) { for (int rep_ = 0; rep_ < MK_NREP; ++rep_) { { MKFRAME() topk_phase(F, (const unsigned*)(ws + WS_SC1), (int*)(ws + WS_EID1), (float*)(ws + WS_GW1)); } FORCE_BAR(); } }
    if (IN(22)) { MKFRAME() asm volatile("; PHASE_BEGIN 22"); gu_phase(F, (const float*)(ws + WS_XF), (const int*)(ws + WS_EID1), (float*)(ws + WS_PART1), ws + WS_UB1); }
    SEAM(22);
    if (((MK_REP >> 22) & 1) && IN(22)) { for (int rep_ = 0; rep_ < MK_NREP; ++rep_) { { MKFRAME() gu_phase(F, (const float*)(ws + WS_XF), (const int*)(ws + WS_EID1), (float*)(ws + WS_PART1), ws + WS_UB1); } FORCE_BAR(); } }
    if (IN(23)) { MKFRAME() asm volatile("; PHASE_BEGIN 23"); gr_phase(F, (const float*)(ws + WS_PART1), (float*)(ws + WS_GW1)); }
    SEAM(23);
    if (IN(24)) { MKFRAME() asm volatile("; PHASE_BEGIN 24"); gv_phase(F, (const float*)(ws + WS_XF), (const int*)(ws + WS_EID1), (const float*)(ws + WS_GW1), (float*)(ws + WS_ZP1), ws + WS_VB1); }
    SEAM(24);
    if (((MK_REP >> 24) & 1) && IN(24)) { for (int rep_ = 0; rep_ < MK_NREP; ++rep_) { { MKFRAME() gv_phase(F, (const float*)(ws + WS_XF), (const int*)(ws + WS_EID1), (const float*)(ws + WS_GW1), (float*)(ws + WS_ZP1), ws + WS_VB1); } FORCE_BAR(); } }
    if (IN(25)) { MKFRAME() asm volatile("; PHASE_BEGIN 25"); ln_phase(F, (const float*)(ws + WS_ZP1), INP(32) + 3 * D, INP(33) + 3 * D, F.out, (bf16_t*)nullptr); }
    SEAM(25);
    if (((MK_REP >> 25) & 1) && IN(25)) { for (int rep_ = 0; rep_ < MK_NREP; ++rep_) { { MKFRAME() ln_phase(F, (const float*)(ws + WS_ZP1), INP(32) + 3 * D, INP(33) + 3 * D, F.out, (bf16_t*)nullptr); } FORCE_BAR(); } }
#undef INP
#undef IN
#undef SEAM
#undef FORCE_BAR
#undef MKFRAME
}

static int g_grid = 0;
static inline bool mk_setup() {
    if (g_grid == 0) {
        int dev = 0, cus = 0;
        if (hipGetDevice(&dev) != hipSuccess || hipDeviceGetAttribute(&cus, hipDeviceAttributeMultiprocessorCount, dev) != hipSuccess) { g_grid = -1; return false; }
        if (hipFuncSetAttribute((const void*)mk_fwd, hipFuncAttributeMaxDynamicSharedMemorySize, LDS_BYTES) != hipSuccess) { fprintf(stderr, "hipFuncSetAttribute failed\n"); g_grid = -1; return false; }
        (void)hipGetLastError();
        g_grid = cus;
        if (g_grid != 256) fprintf(stderr, "warning: %d CUs (kernel assumes 256 workgroups)\n", g_grid);
    }
    return g_grid > 0;
}
static inline void mk_launch(hipStream_t stream, void* const* d_in, void* d_out, void* d_ws, int lo, int hi) {
    Args a{};
    for (int i = 0; i < 34; ++i) a.in[i] = (const float*)d_in[i];
    a.out = (float*)d_out; a.ws = (unsigned char*)d_ws; a.ph_lo = lo; a.ph_hi = hi;
    hipLaunchKernelGGL(mk_fwd, dim3(g_grid), dim3(NTHREADS), LDS_BYTES, stream, a);
}
}
extern "C" void kernel_launch(void* const* d_in, const int* in_sizes, int n_in, void* d_out, int out_size, void* d_ws, size_t ws_size, hipStream_t stream) {
    (void)in_sizes; (void)n_in; (void)out_size;
    if (!mk::mk_setup()) return;
    if (ws_size < mk::WS_END) { fprintf(stderr, "workspace too small: %zu\n", ws_size); return; }
    (void)hipMemsetAsync((char*)d_ws + mk::WS_CTL, 0, mk::CTL_ZERO_BYTES, stream);
#if MK_PER_PHASE
    for (int p = 0; p < mk::NPH; ++p) mk::mk_launch(stream, d_in, d_out, d_ws, p, p + 1);
#else
    mk::mk_launch(stream, d_in, d_out, d_ws, 0, mk::NPH);
#endif
}
```
